# Optimizing an MI355X kernel written in HIP

```python
import jax, jax.numpy as jnp
from jax import lax
import numpy as np

D_MODEL = 1024
BATCH = 8
SEQ = 4096
DEPTH = 2

GRID_W = 64
CTX_LEN = 256
EPS = 1e-6
A_WIDTH = 384
A_HEADS = 8
A_HD = A_WIDTH // A_HEADS
CONV_W = 4
RG_C = 8.0
B_HEADS = 4
B_DK = 96
B_DV = 96
B_WIDTH = B_HEADS * B_DK
B_CHUNK = 64
C_WIDTH = 256
C_HEADS = 4
C_HD = C_WIDTH // C_HEADS
C_CHUNK = 128
MIX_WIDTH = A_WIDTH + B_WIDTH + C_WIDTH
IN_SIZES = (A_WIDTH, A_WIDTH, B_WIDTH, B_WIDTH, B_WIDTH, B_WIDTH, B_WIDTH, C_WIDTH, C_WIDTH, C_WIDTH)
IN_COLS = sum(IN_SIZES)

kernel_name = "hybrid_rglru_hgrn2_chunkmlp_prefix_dit"


def _rmsnorm(x, w):
    xf = x.astype(jnp.float32)
    return xf * lax.rsqrt(jnp.mean(xf * xf, axis=-1, keepdims=True) + EPS) * w.astype(jnp.float32)


def _sincos_2d(rows, dim, dtype):
    r, col = jnp.meshgrid(jnp.arange(rows, dtype=jnp.float32), jnp.arange(GRID_W, dtype=jnp.float32), indexing='ij')
    r = r.reshape(-1)
    col = col.reshape(-1)
    q = dim // 4
    omega = 1.0 / (10000.0 ** (jnp.arange(q, dtype=jnp.float32) / q))
    ar = r[:, None] * omega
    ac = col[:, None] * omega
    return jnp.concatenate([jnp.sin(ar), jnp.cos(ar), jnp.sin(ac), jnp.cos(ac)], axis=-1).astype(dtype)


def _dwconv(x, w, b):
    out = lax.conv_general_dilated(
        x, w[:, None, :].astype(jnp.float32), window_strides=(1,),
        padding=[(CONV_W // 2, CONV_W - 1 - CONV_W // 2)],
        dimension_numbers=('NWC', 'WIO', 'NWC'), feature_group_count=x.shape[-1])
    return out + b.astype(jnp.float32)


def _rglru_coeffs(x, w_r, b_r, w_i, b_i, lam):
    bn, L, C = x.shape
    xh = x.reshape(bn, L, A_HEADS, A_HD)
    r = jax.nn.sigmoid(jnp.einsum('blhi,hij->blhj', xh, w_r.astype(jnp.float32)).reshape(bn, L, C) + b_r.astype(jnp.float32))
    i = jax.nn.sigmoid(jnp.einsum('blhi,hij->blhj', xh, w_i.astype(jnp.float32)).reshape(bn, L, C) + b_i.astype(jnp.float32))
    log_a = -RG_C * r * jax.nn.softplus(-lam.astype(jnp.float32))
    a = jnp.exp(log_a)
    u = jnp.sqrt(-jnp.expm1(2.0 * log_a)) * (i * x)
    return a, u


def _linear_scan(a, u, h0):
    u = u.at[:, 0].add(a[:, 0] * h0)

    def comb(lhs, rhs):
        a1, b1 = lhs
        a2, b2 = rhs
        return a1 * a2, a2 * b1 + b2

    _, h = lax.associative_scan(comb, (a, u), axis=1)
    return h


def _rglru_direction(xc_ctx, xc_lat, w_r, b_r, w_i, b_i, lam):
    a, u = _rglru_coeffs(xc_ctx, w_r, b_r, w_i, b_i, lam)
    h_ctx = _linear_scan(a, u, jnp.zeros_like(u[:, 0]))
    a, u = _rglru_coeffs(xc_lat, w_r, b_r, w_i, b_i, lam)
    h_lat = _linear_scan(a, u, h_ctx[:, -1])
    return h_ctx, h_lat


def _rglru_mixer(xa_ctx, xa_lat, conv_w, conv_b, w_r, b_r, w_i, b_i, lam, need_ctx_out):
    xc_c = _dwconv(xa_ctx.astype(jnp.float32), conv_w, conv_b)
    xc_l = _dwconv(xa_lat.astype(jnp.float32), conv_w, conv_b)
    hc_f, hl_f = _rglru_direction(xc_c, xc_l, w_r[0], b_r[0], w_i[0], b_i[0], lam[0])
    hc_b, hl_b = _rglru_direction(jnp.flip(xc_c, 1), jnp.flip(xc_l, 1), w_r[1], b_r[1], w_i[1], b_i[1], lam[1])
    y_lat = hl_f + jnp.flip(hl_b, 1)
    y_ctx = hc_f + jnp.flip(hc_b, 1) if need_ctx_out else None
    return y_ctx, y_lat


def _gla_chunked(q, k, v, logf, s0, want_out):
    bn, L, H, DK = q.shape
    DV = v.shape[-1]
    n = L // B_CHUNK
    rs = lambda t: t.reshape(bn, n, B_CHUNK, H, t.shape[-1])
    q, k, v, logf = rs(q), rs(k), rs(v), rs(logf)
    G = jnp.cumsum(logf, axis=2)
    G_last = G[:, :, -1]
    k_end = k * jnp.exp(G_last[:, :, None] - G)
    chunk_kv = jnp.einsum('bnchd,bnchv->bnhdv', k_end, v)
    decay = jnp.exp(G_last)

    def step(S, inp):
        dec, kv = inp
        return dec[..., None] * S + kv, S

    S_fin, S_starts = lax.scan(step, s0, (jnp.moveaxis(decay, 1, 0), jnp.moveaxis(chunk_kv, 1, 0)))
    if not want_out:
        return None, S_fin
    S_starts = jnp.moveaxis(S_starts, 0, 1)
    qg = q * jnp.exp(G)
    kg = k * jnp.exp(-G)
    scores = jnp.einsum('bnchd,bnshd->bnhcs', qg, kg)
    mask = jnp.tril(jnp.ones((B_CHUNK, B_CHUNK), dtype=bool))
    scores = jnp.where(mask, scores, 0.0)
    o = jnp.einsum('bnhcs,bnshv->bnchv', scores, v) + jnp.einsum('bnchd,bnhdv->bnchv', qg, S_starts)
    return o.reshape(bn, L, H, DV), S_fin


def _hgrn2_feats(q_raw, ff_raw, fb_raw, i_raw, lb):
    heads = lambda t: t.astype(jnp.float32).reshape(t.shape[0], t.shape[1], B_HEADS, -1)
    lbh = lb.reshape(B_HEADS, B_DK)
    q = jax.nn.silu(heads(q_raw))
    v = heads(i_raw)
    dirs = []
    for fr in (ff_raw, fb_raw):
        f = lbh + (1.0 - lbh) * jax.nn.sigmoid(heads(fr))
        dirs.append((1.0 - f, jnp.log(f)))
    return q, v, dirs


def _hgrn2_mixer(feats_ctx, feats_lat, norm_w, need_ctx_out):
    qc, vc, dc = feats_ctx
    ql, vl, dl = feats_lat
    bn = ql.shape[0]
    s0 = jnp.zeros((bn, B_HEADS, B_DK, B_DV), jnp.float32)
    fl = lambda t: jnp.flip(t, 1)
    oc_f, sc_f = _gla_chunked(qc, dc[0][0], vc, dc[0][1], s0, need_ctx_out)
    ol_f, _ = _gla_chunked(ql, dl[0][0], vl, dl[0][1], sc_f, True)
    oc_b, sc_b = _gla_chunked(fl(qc), fl(dc[1][0]), fl(vc), fl(dc[1][1]), s0, need_ctx_out)
    ol_b, _ = _gla_chunked(fl(ql), fl(dl[1][0]), fl(vl), fl(dl[1][1]), sc_b, True)
    g = norm_w.astype(jnp.float32).reshape(B_HEADS, B_DV)

    def head_norm(o):
        o = o * lax.rsqrt(jnp.mean(o * o, axis=-1, keepdims=True) + EPS) * g
        return o.reshape(o.shape[0], o.shape[1], B_WIDTH)

    y_lat = head_norm(ol_f + fl(ol_b))
    y_ctx = head_norm(oc_f + fl(oc_b)) if need_ctx_out else None
    return y_ctx, y_lat


def _chunk_mlp(u_raw, v_raw, norm_w, ws, bs):
    u = jax.nn.gelu(u_raw.astype(jnp.float32))
    v = jax.nn.gelu(v_raw.astype(jnp.float32))
    mu = jnp.mean(v, axis=-1, keepdims=True)
    var = jnp.mean(jnp.square(v - mu), axis=-1, keepdims=True)
    v = (v - mu) * lax.rsqrt(var + EPS) * norm_w.astype(jnp.float32)
    bn, L, _ = v.shape
    n = L // C_CHUNK
    vh = v.reshape(bn, n, C_CHUNK, C_HEADS, C_HD)
    mixed = jnp.einsum('hst,bnthe->bnshe', ws.astype(jnp.float32), vh) + bs.astype(jnp.float32).T[None, None, :, :, None]
    return u * mixed.reshape(bn, L, C_WIDTH)


def setup_inputs(seed: int = 0) -> dict:
    key = jax.random.key(seed)
    ks = jax.random.split(key, 24)
    f32 = jnp.float32
    nrm = lambda k, shape, s: jax.random.normal(k, shape, f32) * s
    u = jax.random.uniform(ks[14], (DEPTH, 2, A_WIDTH), f32, 0.9, 0.999)
    p = u ** (1.0 / RG_C)
    a_lambda = jnp.log(p) - jnp.log1p(-p)
    return {
        "x": nrm(ks[0], (BATCH, SEQ, D_MODEL), 1.0),
        "c": nrm(ks[1], (BATCH, D_MODEL), 1.0),
        "ctx": nrm(ks[2], (BATCH, CTX_LEN, D_MODEL), 1.0),
        "c_ctx": nrm(ks[3], (D_MODEL,), 1.0),
        "norm_w": 1.0 + nrm(ks[4], (DEPTH, D_MODEL), 0.02),
        "w_mod": nrm(ks[5], (DEPTH, D_MODEL, 3 * D_MODEL), D_MODEL ** -0.5),
        "b_mod": nrm(ks[6], (DEPTH, 3 * D_MODEL), 0.02),
        "w_in": nrm(ks[7], (DEPTH, D_MODEL, IN_COLS), D_MODEL ** -0.5),
        "a_conv_w": nrm(ks[8], (DEPTH, CONV_W, A_WIDTH), CONV_W ** -0.5),
        "a_conv_b": nrm(ks[9], (DEPTH, A_WIDTH), 0.02),
        "a_wr": nrm(ks[10], (DEPTH, 2, A_HEADS, A_HD, A_HD), A_HD ** -0.5),
        "a_br": nrm(ks[11], (DEPTH, 2, A_WIDTH), 0.02),
        "a_wi": nrm(ks[12], (DEPTH, 2, A_HEADS, A_HD, A_HD), A_HD ** -0.5),
        "a_bi": nrm(ks[13], (DEPTH, 2, A_WIDTH), 0.02),
        "a_lambda": a_lambda,
        "b_lb_logits": nrm(ks[15], (DEPTH + 1, B_WIDTH), 0.1),
        "b_norm_w": 1.0 + nrm(ks[16], (DEPTH, B_WIDTH), 0.02),
        "c_norm_w": 1.0 + nrm(ks[17], (DEPTH, C_WIDTH), 0.02),
        "c_ws": nrm(ks[18], (DEPTH, C_HEADS, C_CHUNK, C_CHUNK), C_CHUNK ** -0.5),
        "c_bs": nrm(ks[19], (DEPTH, C_HEADS, C_CHUNK), 0.02),
        "w_out": nrm(ks[20], (DEPTH, MIX_WIDTH, D_MODEL), MIX_WIDTH ** -0.5),
        "final_norm_w": 1.0 + nrm(ks[21], (D_MODEL,), 0.02),
    }


def reference(x, c, ctx, c_ctx, norm_w, w_mod, b_mod, w_in, a_conv_w, a_conv_b, a_wr, a_br, a_wi, a_bi,
              a_lambda, b_lb_logits, b_norm_w, c_norm_w, c_ws, c_bs, w_out, final_norm_w):
    n_lat = x.shape[1]
    ROWS = n_lat // GRID_W
    x = x + _sincos_2d(ROWS, D_MODEL, x.dtype)[None]
    silu_c = jax.nn.silu(c.astype(jnp.float32))
    silu_cc = jax.nn.silu(c_ctx.astype(jnp.float32))
    lbs = jnp.cumsum(jax.nn.softmax(b_lb_logits.astype(jnp.float32), axis=0), axis=0)
    cuts = np.cumsum(IN_SIZES)[:-1].tolist()
    for l in range(DEPTH):
        need_ctx_out = l < DEPTH - 1
        mod = silu_c @ w_mod[l] + b_mod[l]
        mod_c = silu_cc @ w_mod[l] + b_mod[l]
        sh, sc, g = jnp.split(mod, 3, axis=-1)
        sh_c, sc_c, g_c = jnp.split(mod_c, 3, axis=-1)
        h = _rmsnorm(x, norm_w[l]) * (1.0 + sc[:, None]) + sh[:, None]
        hc = _rmsnorm(ctx, norm_w[l]) * (1.0 + sc_c) + sh_c
        p = jnp.split(h @ w_in[l], cuts, axis=-1)
        pc = jnp.split(hc @ w_in[l], cuts, axis=-1)
        ya_c, ya_l = _rglru_mixer(pc[0], p[0], a_conv_w[l], a_conv_b[l], a_wr[l], a_br[l], a_wi[l], a_bi[l],
                                  a_lambda[l], need_ctx_out)
        yb_c, yb_l = _hgrn2_mixer(_hgrn2_feats(pc[2], pc[3], pc[4], pc[5], lbs[l]),
                                  _hgrn2_feats(p[2], p[3], p[4], p[5], lbs[l]), b_norm_w[l], need_ctx_out)
        yc_l = _chunk_mlp(p[7], p[8], c_norm_w[l], c_ws[l], c_bs[l])
        y = jnp.concatenate([ya_l * jax.nn.silu(p[1]), yb_l * jax.nn.silu(p[6]), yc_l * jax.nn.silu(p[9])], axis=-1)
        x = x + (g[:, None] * (y.astype(x.dtype) @ w_out[l])).astype(x.dtype)
        if need_ctx_out:
            yc_c = _chunk_mlp(pc[7], pc[8], c_norm_w[l], c_ws[l], c_bs[l])
            yctx = jnp.concatenate([ya_c * jax.nn.silu(pc[1]), yb_c * jax.nn.silu(pc[6]), yc_c * jax.nn.silu(pc[9])], axis=-1)
            ctx = ctx + (g_c * (yctx.astype(ctx.dtype) @ w_out[l])).astype(ctx.dtype)
    return _rmsnorm(x, final_norm_w).astype(x.dtype)
```

```cpp
#include <hip/hip_runtime.h>
#include <hip/hip_cooperative_groups.h>
#include <cstdio>
namespace cg = cooperative_groups;

#ifndef MEGA
#define MEGA 1
#endif

#define DEV __device__ __forceinline__
typedef unsigned short bf16_t;
typedef short bf16x8 __attribute__((ext_vector_type(8)));
typedef float f32x4 __attribute__((ext_vector_type(4)));

constexpr int NB = 8, LSEQ = 4096, LCTX = 256, DM = 1024, NCOL = 3456;
constexpr int NLAT = NB * LSEQ, NCTXR = NB * LCTX, MROWS = NLAT + NCTXR;
constexpr int COL_AX = 0, COL_AG = 384, COL_BQ = 768, COL_BFF = 1152, COL_BFB = 1536, COL_BI = 1920, COL_BG = 2304,
              COL_CU = 2688, COL_CV = 2944, COL_CG = 3200;
constexpr int ACH = 136;
constexpr int BSL = 68;
constexpr int SMEM_BYTES = 76800;
constexpr float EPSV = 1e-6f;

constexpr size_t al256(size_t x) { return (x + 255) & ~(size_t)255; }
constexpr size_t OFF_WTIN = 0;
constexpr size_t OFF_WTOUT = OFF_WTIN + al256((size_t)2 * NCOL * 1024 * 2);
constexpr size_t OFF_GATEPACK = OFF_WTOUT + al256((size_t)2 * 1024 * 1024 * 2);
constexpr size_t OFF_HBUF = OFF_GATEPACK + al256((size_t)64 * 3072 * 2);
constexpr size_t OFF_PBUF = OFF_HBUF + al256((size_t)MROWS * 1024 * 2);
constexpr size_t OFF_KVBUF = OFF_PBUF + al256((size_t)MROWS * NCOL * 2);
constexpr size_t OFF_MOD = OFF_KVBUF + al256((size_t)64 * BSL * 9216 * 2);
constexpr size_t OFF_LBS = OFF_MOD + al256((size_t)2 * 9 * 3072 * 4);
constexpr size_t OFF_POSTAB = OFF_LBS + al256((size_t)3 * 384 * 4);
constexpr size_t OFF_CTXRES = OFF_POSTAB + al256((size_t)64 * 512 * 4);
constexpr size_t OFF_DECAY = OFF_CTXRES + al256((size_t)NCTXR * 1024 * 4);
constexpr size_t OFF_APH = OFF_DECAY + al256((size_t)64 * BSL * 96 * 4);
constexpr size_t OFF_ACARRY = OFF_APH + al256((size_t)NB * 2 * ACH * 384 * 2 * 4);
constexpr size_t OFF_SP = OFF_ACARRY + al256((size_t)NB * 2 * ACH * 384 * 4);
constexpr int SP_NORM_W = 0, SP_CONV_W = 2048, SP_CONV_B = 5120, SP_BR = 5888, SP_BI = 7424, SP_ASP = 8960, SP_BNW = 10496,
              SP_CNW = 11264, SP_CBS = 11776, SP_FNW = 12800, SP_TOTAL = 13824;
constexpr size_t OFF_CWS = OFF_SP + al256((size_t)SP_TOTAL * 4);
constexpr size_t WS_TOTAL = OFF_CWS + al256((size_t)2 * 4 * 128 * 128 * 2);

struct Params {
  const float *x, *c, *ctx, *c_ctx, *norm_w, *w_mod, *b_mod, *w_in, *a_conv_w, *a_conv_b, *a_wr, *a_br, *a_wi, *a_bi,
      *a_lambda, *b_lb_logits, *b_norm_w, *c_norm_w, *c_ws, *c_bs, *w_out, *final_norm_w;
  float* out;
  char* ws;
  DEV bf16_t* wtin() const { return (bf16_t*)(ws + OFF_WTIN); }
  DEV bf16_t* wtout() const { return (bf16_t*)(ws + OFF_WTOUT); }
  DEV bf16_t* gatepack() const { return (bf16_t*)(ws + OFF_GATEPACK); }
  DEV bf16_t* hbuf() const { return (bf16_t*)(ws + OFF_HBUF); }
  DEV bf16_t* pbuf() const { return (bf16_t*)(ws + OFF_PBUF); }
  DEV bf16_t* kvbuf() const { return (bf16_t*)(ws + OFF_KVBUF); }
  DEV float* mod() const { return (float*)(ws + OFF_MOD); }
  DEV float* lbs() const { return (float*)(ws + OFF_LBS); }
  DEV float* postab() const { return (float*)(ws + OFF_POSTAB); }
  DEV float* ctxres() const { return (float*)(ws + OFF_CTXRES); }
  DEV float* decay() const { return (float*)(ws + OFF_DECAY); }
  DEV float* aPH() const { return (float*)(ws + OFF_APH); }
  DEV float* aCarry() const { return (float*)(ws + OFF_ACARRY); }
  DEV float* sp() const { return (float*)(ws + OFF_SP); }
  DEV bf16_t* cws() const { return (bf16_t*)(ws + OFF_CWS); }
};

typedef __bf16 bf2_t __attribute__((ext_vector_type(2)));
typedef float f2_t __attribute__((ext_vector_type(2)));
DEV unsigned pack2(float lo, float hi) { f2_t v = {lo, hi}; bf2_t b = __builtin_convertvector(v, bf2_t); return __builtin_bit_cast(unsigned, b); }
DEV bf16_t f2bf(float f) { __bf16 b = (__bf16)f; return __builtin_bit_cast(unsigned short, b); }
DEV float bflo(unsigned u) { return __uint_as_float(u << 16); }
DEV float bfhi(unsigned u) { return __uint_as_float(u & 0xffff0000u); }
DEV float bf2f(bf16_t h) { return __uint_as_float(((unsigned)h) << 16); }
DEV void unpack8(const uint4& r, float* o) {
  o[0] = bflo(r.x); o[1] = bfhi(r.x); o[2] = bflo(r.y); o[3] = bfhi(r.y);
  o[4] = bflo(r.z); o[5] = bfhi(r.z); o[6] = bflo(r.w); o[7] = bfhi(r.w);
}
DEV float sigm(float x) { return 1.f / (1.f + __expf(-x)); }
DEV float siluf(float x) { return x / (1.f + __expf(-x)); }
DEV float geluf(float x) { float z = 1.5957691216f * (x + 0.044715f * x * x * x); return x / (1.f + __expf(-z)); }
DEV f32x4 mfma16(bf16x8 a, bf16x8 b, f32x4 c) { return __builtin_amdgcn_mfma_f32_16x16x32_bf16(a, b, c, 0, 0, 0); }
DEV int tidx() { int t = threadIdx.x; asm volatile("" : "+v"(t)); return t; }
DEV float wave_sum(float v) {
#pragma unroll
  for (int o = 32; o > 0; o >>= 1) v += __shfl_xor(v, o);
  return v;
}

DEV void prep_mod(const Params& p, int task, char* smem) {
  const int l = task / 96, j0 = (task % 96) * 32, tid = tidx();
  float* sv = (float*)smem;
  float* red = sv + 9 * 1024;
  for (int i = tid; i < 9 * 1024; i += 256) { int r = i >> 10, k = i & 1023; float v = (r < 8) ? p.c[r * 1024 + k] : p.c_ctx[k]; sv[i] = siluf(v); }
  __syncthreads();
  const int kg = tid >> 5, col = tid & 31;
  float acc[9];
#pragma unroll
  for (int r = 0; r < 9; ++r) acc[r] = 0.f;
  const float* w = p.w_mod + (size_t)l * 1024 * 3072 + j0 + col;
  for (int k = kg * 128; k < kg * 128 + 128; k += 8) {
    float wv[8];
#pragma unroll
    for (int u = 0; u < 8; ++u) wv[u] = w[(size_t)(k + u) * 3072];
#pragma unroll
    for (int u = 0; u < 8; ++u)
#pragma unroll
      for (int r = 0; r < 9; ++r) acc[r] += sv[r * 1024 + k + u] * wv[u];
  }
#pragma unroll
  for (int r = 0; r < 9; ++r) red[(kg * 9 + r) * 32 + col] = acc[r];
  __syncthreads();
  for (int i = tid; i < 288; i += 256) {
    int r = i >> 5, cc = i & 31; float s = 0.f;
#pragma unroll
    for (int g = 0; g < 8; ++g) s += red[(g * 9 + r) * 32 + cc];
    p.mod()[(l * 9 + r) * 3072 + j0 + cc] = s + p.b_mod[l * 3072 + j0 + cc];
  }
  __syncthreads();
}

DEV void prep_transpose(const float* __restrict__ src, bf16_t* __restrict__ dst, int N, int kt, int nt, char* smem) {
  float* tile = (float*)smem;
  const int tid = tidx(), r = tid >> 4, c4 = tid & 15;
#pragma unroll
  for (int i = 0; i < 4; ++i) {
    float4 v = *(const float4*)(src + (size_t)(kt * 64 + r + 16 * i) * N + nt * 64 + c4 * 4);
    float* t = tile + (r + 16 * i) * 65 + c4 * 4;
    t[0] = v.x; t[1] = v.y; t[2] = v.z; t[3] = v.w;
  }
  __syncthreads();
  const int n = tid >> 2, kq = tid & 3;
  unsigned o[8];
#pragma unroll
  for (int e = 0; e < 8; ++e) o[e] = pack2(tile[(kq * 16 + 2 * e) * 65 + n], tile[(kq * 16 + 2 * e + 1) * 65 + n]);
  uint4* d = (uint4*)(dst + (size_t)(nt * 64 + n) * 1024 + kt * 64 + kq * 16);
  d[0] = make_uint4(o[0], o[1], o[2], o[3]);
  d[1] = make_uint4(o[4], o[5], o[6], o[7]);
  __syncthreads();
}

DEV void phase_prep(const Params& p, int bid, int nblk, char* smem) {
  const int tid = tidx();
  constexpr int T_MOD = 192, T_LBS = 1, T_POS = 64, T_GP = 64, T_WIN = 2 * 16 * 54, T_WOUT = 2 * 16 * 16;
  constexpr int T_CP = 18;
  constexpr int NT = T_MOD + T_CP + T_LBS + T_POS + T_GP + T_WIN + T_WOUT;
  for (int task = bid; task < NT; task += nblk) {
    int t = task;
    if (t < T_MOD) { prep_mod(p, t, smem); continue; }
    t -= T_MOD;
    if (t < T_CP) {
      if (t >= 10) {
        const float* s = p.c_ws + (t - 10) * 16384; bf16_t* dd = p.cws() + (t - 10) * 16384;
        for (int i = tid; i < 16384; i += 256) dd[i] = f2bf(s[i]);
        continue;
      }
      const float* s; int off, n;
      switch (t) {
        case 0: s = p.norm_w; off = SP_NORM_W; n = 2048; break;
        case 1: s = p.a_conv_w; off = SP_CONV_W; n = 3072; break;
        case 2: s = p.a_conv_b; off = SP_CONV_B; n = 768; break;
        case 3: s = p.a_br; off = SP_BR; n = 1536; break;
        case 4: s = p.a_bi; off = SP_BI; n = 1536; break;
        case 5: s = p.a_lambda; off = SP_ASP; n = 1536; break;
        case 6: s = p.b_norm_w; off = SP_BNW; n = 768; break;
        case 7: s = p.c_norm_w; off = SP_CNW; n = 512; break;
        case 8: s = p.c_bs; off = SP_CBS; n = 1024; break;
        default: s = p.final_norm_w; off = SP_FNW; n = 1024; break;
      }
      float* dd = p.sp() + off;
      for (int i = tid; i < n; i += 256) { float v = s[i]; if (t == 5) v = 8.f * log1pf(expf(-v)); dd[i] = v; }
      continue;
    }
    t -= T_CP;
    if (t < T_LBS) {
      for (int i = tid; i < 384; i += 256) {
        float a = p.b_lb_logits[i], b = p.b_lb_logits[384 + i], cc = p.b_lb_logits[768 + i];
        float m = fmaxf(a, fmaxf(b, cc));
        float ea = expf(a - m), eb = expf(b - m), ec = expf(cc - m), inv = 1.f / (ea + eb + ec);
        p.lbs()[i] = ea * inv; p.lbs()[384 + i] = (ea + eb) * inv; p.lbs()[768 + i] = 1.f;
      }
      continue;
    }
    t -= T_LBS;
    if (t < T_POS) {
      int i = tid;
      float om = 1.0f / powf(10000.0f, (float)i / 256.0f);
      float ang = (float)t * om;
      p.postab()[t * 512 + i] = sinf(ang);
      p.postab()[t * 512 + 256 + i] = cosf(ang);
      continue;
    }
    t -= T_POS;
    if (t < T_GP) {
      const int mat = t & 1, ldh = t >> 1;
      const float* W = (mat ? p.a_wi : p.a_wr) + (size_t)ldh * 2304;
      bf16_t* dst = p.gatepack() + (size_t)t * 3072;
      for (int idx = tid; idx < 3072; idx += 256) {
        int jj = idx & 7, lane = (idx >> 3) & 63, nt = (idx >> 9) % 3, ks = idx / 1536;
        int k = ks * 32 + (lane >> 4) * 8 + jj, n = nt * 16 + (lane & 15);
        float v = (k < 48) ? W[k * 48 + n] : 0.f;
        dst[idx] = f2bf(v);
      }
      continue;
    }
    t -= T_GP;
    if (t < T_WIN) {
      int l = t / (16 * 54), r = t % (16 * 54);
      prep_transpose(p.w_in + (size_t)l * 1024 * NCOL, p.wtin() + (size_t)l * NCOL * 1024, NCOL, r / 54, r % 54, smem);
      continue;
    }
    t -= T_WIN;
    {
      int l = t / 256, r = t % 256;
      prep_transpose(p.w_out + (size_t)l * 1024 * 1024, p.wtout() + (size_t)l * 1024 * 1024, 1024, r / 16, r % 16, smem);
    }
  }
}

DEV void phase_norm(const Params& p, int layer, int bid, int nblk) {
  const int wave = tidx() >> 6, lane = tidx() & 63;
  const float* nw = p.sp() + SP_NORM_W + layer * 1024;
  for (int row = bid * 4 + wave; row < MROWS; row += nblk * 4) {
    const bool isctx = row >= NLAT;
    const float* src; float* res; int mrow, t = 0;
    if (!isctx) { t = row & 4095; src = (layer == 0 ? p.x : p.out) + (size_t)row * 1024; res = p.out + (size_t)row * 1024; mrow = row >> 12; }
    else { int r2 = row - NLAT; src = (layer == 0 ? p.ctx : p.ctxres()) + (size_t)r2 * 1024; res = p.ctxres() + (size_t)r2 * 1024; mrow = 8; }
    const float* modp = p.mod() + (layer * 9 + mrow) * 3072;
    float4 v[4]; float ss = 0.f;
#pragma unroll
    for (int i = 0; i < 4; ++i) {
      int col = i * 256 + lane * 4;
      float4 a = *(const float4*)(src + col);
      if (layer == 0) {
        if (!isctx) {
          const float* tp = p.postab() + ((i < 2) ? (t >> 6) : (t & 63)) * 512 + (col & 511);
          float4 q = *(const float4*)tp;
          a.x += q.x; a.y += q.y; a.z += q.z; a.w += q.w;
        }
        *(float4*)(res + col) = a;
      }
      v[i] = a;
      ss += a.x * a.x + a.y * a.y + a.z * a.z + a.w * a.w;
    }
    ss = wave_sum(ss);
    const float rstd = rsqrtf(ss * (1.f / 1024.f) + EPSV);
#pragma unroll
    for (int i = 0; i < 4; ++i) {
      int col = i * 256 + lane * 4;
      float4 w = *(const float4*)(nw + col), sh = *(const float4*)(modp + col), sc = *(const float4*)(modp + 1024 + col);
      float h0 = v[i].x * rstd * w.x * (1.f + sc.x) + sh.x;
      float h1 = v[i].y * rstd * w.y * (1.f + sc.y) + sh.y;
      float h2 = v[i].z * rstd * w.z * (1.f + sc.z) + sh.z;
      float h3 = v[i].w * rstd * w.w * (1.f + sc.w) + sh.w;
      *(uint2*)(p.hbuf() + (size_t)row * 1024 + col) = make_uint2(pack2(h0, h1), pack2(h2, h3));
    }
  }
}

DEV void phase_final(const Params& p, int bid, int nblk) {
  const int wave = tidx() >> 6, lane = tidx() & 63;
  for (int row = bid * 4 + wave; row < NLAT; row += nblk * 4) {
    float* src = p.out + (size_t)row * 1024;
    float4 v[4]; float ss = 0.f;
#pragma unroll
    for (int i = 0; i < 4; ++i) { v[i] = *(const float4*)(src + i * 256 + lane * 4); ss += v[i].x * v[i].x + v[i].y * v[i].y + v[i].z * v[i].z + v[i].w * v[i].w; }
    ss = wave_sum(ss);
    const float rstd = rsqrtf(ss * (1.f / 1024.f) + EPSV);
#pragma unroll
    for (int i = 0; i < 4; ++i) {
      int col = i * 256 + lane * 4;
      float4 w = *(const float4*)(p.sp() + SP_FNW + col);
      float4 o; o.x = v[i].x * rstd * w.x; o.y = v[i].y * rstd * w.y; o.z = v[i].z * rstd * w.z; o.w = v[i].w * rstd * w.w;
      *(float4*)(src + col) = o;
    }
  }
}

constexpr int GLD = 72;
template <int EPI>
DEV void phase_gemm(const Params& p, int layer, const bf16_t* __restrict__ A, const bf16_t* __restrict__ Bt, int M, int N, char* smem, int bid, int nblk) {
  constexpr int K = 1024;
  bf16_t* As = (bf16_t*)smem;
  bf16_t* Bs = As + 2 * 128 * GLD;
  const int tid = tidx(), lane = tid & 63, wave = tid >> 6, quad = lane >> 4, l15 = lane & 15;
  const int wm = wave >> 1, wn = wave & 1;
  const int nN = N / 128, ntiles = (M / 128) * nN;
  const int lrow = tid >> 3, lkc = tid & 7;
  for (int tile = bid; tile < ntiles; tile += nblk) {
    const int pm = tile / nN, pn = tile % nN;
    const bf16_t* Ag = A + (size_t)(pm * 128 + lrow) * K + lkc * 8;
    const bf16_t* Bg = Bt + (size_t)(pn * 128 + lrow) * K + lkc * 8;
    f32x4 acc[4][4];
#pragma unroll
    for (int i = 0; i < 4; ++i)
#pragma unroll
      for (int j = 0; j < 4; ++j) acc[i][j] = (f32x4){0.f, 0.f, 0.f, 0.f};
    uint4 ra[4], rb[4];
#pragma unroll
    for (int j = 0; j < 4; ++j) { ra[j] = *(const uint4*)(Ag + (size_t)(32 * j) * K); rb[j] = *(const uint4*)(Bg + (size_t)(32 * j) * K); }
#pragma unroll
    for (int j = 0; j < 4; ++j) { *(uint4*)(As + (lrow + 32 * j) * GLD + lkc * 8) = ra[j]; *(uint4*)(Bs + (lrow + 32 * j) * GLD + lkc * 8) = rb[j]; }
    __syncthreads();
    for (int kt = 0; kt < 16; ++kt) {
      const int buf = kt & 1;
      if (kt + 1 < 16) {
#pragma unroll
        for (int j = 0; j < 4; ++j) { ra[j] = *(const uint4*)(Ag + (size_t)(32 * j) * K + (kt + 1) * 64); rb[j] = *(const uint4*)(Bg + (size_t)(32 * j) * K + (kt + 1) * 64); }
      }
      const bf16_t* as = As + buf * 128 * GLD + (wm * 64 + l15) * GLD + quad * 8;
      const bf16_t* bs = Bs + buf * 128 * GLD + (wn * 64 + l15) * GLD + quad * 8;
#pragma unroll
      for (int ks = 0; ks < 2; ++ks) {
        bf16x8 af[4], bfr[4];
#pragma unroll
        for (int i = 0; i < 4; ++i) { af[i] = *(const bf16x8*)(as + i * 16 * GLD + ks * 32); bfr[i] = *(const bf16x8*)(bs + i * 16 * GLD + ks * 32); }
#pragma unroll
        for (int mi = 0; mi < 4; ++mi)
#pragma unroll
          for (int ni = 0; ni < 4; ++ni) acc[mi][ni] = mfma16(bfr[ni], af[mi], acc[mi][ni]);
      }
      if (kt + 1 < 16) {
        bf16_t* ad = As + (buf ^ 1) * 128 * GLD; bf16_t* bd = Bs + (buf ^ 1) * 128 * GLD;
#pragma unroll
        for (int j = 0; j < 4; ++j) { *(uint4*)(ad + (lrow + 32 * j) * GLD + lkc * 8) = ra[j]; *(uint4*)(bd + (lrow + 32 * j) * GLD + lkc * 8) = rb[j]; }
      }
      __syncthreads();
    }
#pragma unroll
    for (int mi = 0; mi < 4; ++mi) {
      const int row = pm * 128 + wm * 64 + mi * 16 + l15;
      if (EPI == 0) {
        bf16_t* dst = p.pbuf() + (size_t)row * NCOL + pn * 128 + wn * 64 + 4 * quad;
#pragma unroll
        for (int ni = 0; ni < 4; ++ni) *(uint2*)(dst + ni * 16) = make_uint2(pack2(acc[mi][ni][0], acc[mi][ni][1]), pack2(acc[mi][ni][2], acc[mi][ni][3]));
      } else {
        float* res; const float* g;
        if (row < NLAT) { res = p.out + (size_t)row * 1024; g = p.mod() + (layer * 9 + (row >> 12)) * 3072 + 2048; }
        else { res = p.ctxres() + (size_t)(row - NLAT) * 1024; g = p.mod() + (layer * 9 + 8) * 3072 + 2048; }
        const int c0 = pn * 128 + wn * 64 + 4 * quad;
#pragma unroll
        for (int ni = 0; ni < 4; ++ni) {
          float4 r = *(const float4*)(res + c0 + ni * 16), gg = *(const float4*)(g + c0 + ni * 16);
          r.x += gg.x * acc[mi][ni][0]; r.y += gg.y * acc[mi][ni][1]; r.z += gg.z * acc[mi][ni][2]; r.w += gg.w * acc[mi][ni][3];
          *(float4*)(res + c0 + ni * 16) = r;
        }
      }
    }
  }
}

DEV void a_chunk(const Params& p, int l, int b, int sc, bool fin, char* smem) {
  float* xcf = (float*)smem;
  bf16_t* xcb = (bf16_t*)(smem + 32 * 388 * 4);
  const int tid = tidx(), lane = tid & 63, wave = tid >> 6, quad = lane >> 4, l15 = lane & 15;
  int t0, Lseg; size_t rowbase;
  if (sc < 8) { t0 = sc * 32; Lseg = LCTX; rowbase = (size_t)NLAT + (size_t)b * LCTX; }
  else { t0 = (sc - 8) * 32; Lseg = LSEQ; rowbase = (size_t)b * LSEQ; }
  const float* cw = p.sp() + SP_CONV_W + l * 4 * 384;
  const float* cb = p.sp() + SP_CONV_B + l * 384;
  for (int idx = tid; idx < 32 * 48; idx += 256) {
    const int t = idx / 48, ch0 = (idx % 48) * 8;
    float acc[8];
    { float4 b0 = *(const float4*)(cb + ch0), b1 = *(const float4*)(cb + ch0 + 4);
      acc[0] = b0.x; acc[1] = b0.y; acc[2] = b0.z; acc[3] = b0.w; acc[4] = b1.x; acc[5] = b1.y; acc[6] = b1.z; acc[7] = b1.w; }
#pragma unroll
    for (int w = 0; w < 4; ++w) {
      const int tt = t0 + t + w - 2;
      if (tt >= 0 && tt < Lseg) {
        uint4 raw = *(const uint4*)(p.pbuf() + (rowbase + tt) * NCOL + COL_AX + ch0);
        float xs[8]; unpack8(raw, xs);
        float4 w0 = *(const float4*)(cw + w * 384 + ch0), w1 = *(const float4*)(cw + w * 384 + ch0 + 4);
        acc[0] += xs[0] * w0.x; acc[1] += xs[1] * w0.y; acc[2] += xs[2] * w0.z; acc[3] += xs[3] * w0.w;
        acc[4] += xs[4] * w1.x; acc[5] += xs[5] * w1.y; acc[6] += xs[6] * w1.z; acc[7] += xs[7] * w1.w;
      }
    }
    *(float4*)(xcf + t * 388 + ch0) = make_float4(acc[0], acc[1], acc[2], acc[3]);
    *(float4*)(xcf + t * 388 + ch0 + 4) = make_float4(acc[4], acc[5], acc[6], acc[7]);
    *(uint4*)(xcb + t * 392 + ch0) = make_uint4(pack2(acc[0], acc[1]), pack2(acc[2], acc[3]), pack2(acc[4], acc[5]), pack2(acc[6], acc[7]));
  }
  __syncthreads();
#pragma unroll 1
  for (int hn = 0; hn < 6; ++hn) {
    const int h = wave * 2 + hn / 3, nt = hn % 3;
    const int ch = h * 48 + nt * 16 + l15;
    f32x4 hf[2];
#pragma unroll
    for (int d = 0; d < 2; ++d) {
      const bf16x8* gp = (const bf16x8*)p.gatepack() + (size_t)(((l * 2 + d) * 8 + h) * 2) * 6 * 64 + lane;
      bf16x8 wr[2], wi[2];
#pragma unroll
      for (int ks = 0; ks < 2; ++ks) { wr[ks] = gp[(ks * 3 + nt) * 64]; wi[ks] = gp[(6 + ks * 3 + nt) * 64]; }
      const size_t cidx = ((size_t)(b * 2 + d) * ACH + sc) * 384;
      const float br = p.sp()[SP_BR + (l * 2 + d) * 384 + ch], bi = p.sp()[SP_BI + (l * 2 + d) * 384 + ch];
      const float sp = p.sp()[SP_ASP + (l * 2 + d) * 384 + ch];
      float hc = fin ? p.aCarry()[cidx + ch] : 0.f, Pc = 1.f;
      const int lq = d ? 3 - quad : quad;
      const int s1 = d ? ((lane + 16) & 63) : ((lane - 16) & 63), s2 = d ? ((lane + 32) & 63) : ((lane - 32) & 63);
      const int lastl = d ? l15 : 48 + l15;
#pragma unroll
      for (int mi = 0; mi < 2; ++mi) {
        const int mt = d ? 1 - mi : mi;
        bf16x8 a0 = *(const bf16x8*)(xcb + (mt * 16 + l15) * 392 + h * 48 + quad * 8);
        bf16x8 a1 = {0, 0, 0, 0, 0, 0, 0, 0};
        if (quad < 2) a1 = *(const bf16x8*)(xcb + (mt * 16 + l15) * 392 + h * 48 + 32 + quad * 8);
        f32x4 ra = {0.f, 0.f, 0.f, 0.f}, ia = {0.f, 0.f, 0.f, 0.f};
        ra = mfma16(a0, wr[0], ra); ra = mfma16(a1, wr[1], ra);
        ia = mfma16(a0, wi[0], ia); ia = mfma16(a1, wi[1], ia);
        float av[4], uv[4];
#pragma unroll
        for (int jj = 0; jj < 4; ++jj) {
          const int tok = mt * 16 + quad * 4 + jj;
          const float xv = xcf[tok * 388 + ch];
          const float r = sigm(ra[jj] + br), ig = sigm(ia[jj] + bi);
          const float la = -r * sp;
          av[jj] = __expf(la);
          uv[jj] = sqrtf(-expm1f(2.f * la)) * ig * xv;
        }
        float P = 1.f, H = 0.f, pl[4], hl[4];
#pragma unroll
        for (int q = 0; q < 4; ++q) { const int jj = d ? 3 - q : q; H = av[jj] * H + uv[jj]; P *= av[jj]; pl[jj] = P; hl[jj] = H; }
        float Pi = P, Hi = H;
        { float Ps = __shfl(Pi, s1), Hs = __shfl(Hi, s1); if (lq >= 1) { Hi = Pi * Hs + Hi; Pi = Pi * Ps; } }
        { float Ps = __shfl(Pi, s2), Hs = __shfl(Hi, s2); if (lq >= 2) { Hi = Pi * Hs + Hi; Pi = Pi * Ps; } }
        const float Pt = __shfl(Pi, lastl), Ht = __shfl(Hi, lastl);
        if (fin) {
          float Pe = __shfl(Pi, s1), He = __shfl(Hi, s1);
          if (lq == 0) { Pe = 1.f; He = 0.f; }
          const float hin = Pe * hc + He;
#pragma unroll
          for (int jj = 0; jj < 4; ++jj) {
            const float hv = pl[jj] * hin + hl[jj];
            if (d == 0) hf[mt][jj] = hv;
            else {
              const size_t row = rowbase + t0 + mt * 16 + quad * 4 + jj;
              const float gate = bf2f(p.pbuf()[row * NCOL + COL_AG + ch]);
              p.hbuf()[row * 1024 + ch] = f2bf((hf[mt][jj] + hv) * siluf(gate));
            }
          }
        }
        hc = Pt * hc + Ht; Pc *= Pt;
      }
      if (!fin && quad == 0) *(float2*)(p.aPH() + (cidx + ch) * 2) = make_float2(Pc, hc);
    }
  }
  __syncthreads();
}

DEV void b_logf_scan(const Params& p, int l, int h, int d, size_t rowbase, float* Lf, float* GL) {
  const int tid = tidx();
  const int fcol = (d ? COL_BFB : COL_BFF) + h * 96;
  const float* lbp = p.lbs() + l * 384 + h * 96;
  for (int idx = tid; idx < 64 * 12; idx += 256) {
    const int tok = idx / 12, g8 = idx % 12;
    uint4 raw = *(const uint4*)(p.pbuf() + (rowbase + tok) * NCOL + fcol + g8 * 8);
    float xs[8]; unpack8(raw, xs);
#pragma unroll
    for (int e = 0; e < 8; ++e) { const float lb = lbp[g8 * 8 + e]; const float f = lb + (1.f - lb) * sigm(xs[e]); Lf[tok * 97 + g8 * 8 + e] = __logf(f); }
  }
  __syncthreads();
  if (tid < 96) {
    float run = 0.f;
    if (!d) {
#pragma unroll 16
      for (int tok = 0; tok < 64; ++tok) { run += Lf[tok * 97 + tid]; Lf[tok * 97 + tid] = run; }
    } else {
#pragma unroll 16
      for (int tok = 63; tok >= 0; --tok) { run += Lf[tok * 97 + tid]; Lf[tok * 97 + tid] = run; }
    }
    GL[tid] = run;
  }
  __syncthreads();
}

DEV void b_kv_task(const Params& p, int l, int task, char* smem) {
  const int n = task % BSL, s = task / BSL, d = s & 1, h = (s >> 1) & 3, b = s >> 3;
  size_t rowbase;
  if (n < 4) { int cj = d ? 3 - n : n; rowbase = (size_t)NLAT + b * LCTX + cj * 64; }
  else { int cj = d ? 63 - (n - 4) : n - 4; rowbase = (size_t)b * LSEQ + cj * 64; }
  float* Lf = (float*)smem; float* GL = Lf + 64 * 97;
  bf16_t* Kt = (bf16_t*)(smem + 25600);
  bf16_t* Vt = Kt + 96 * 72;
  const int tid = tidx(), lane = tid & 63, wave = tid >> 6, quad = lane >> 4, l15 = lane & 15;
  b_logf_scan(p, l, h, d, rowbase, Lf, GL);
  const int fcol = (d ? COL_BFB : COL_BFF) + h * 96;
  const float* lbp = p.lbs() + l * 384 + h * 96;
  for (int idx = tid; idx < 64 * 12; idx += 256) {
    const int tok = idx / 12, g8 = idx % 12;
    uint4 raw = *(const uint4*)(p.pbuf() + (rowbase + tok) * NCOL + fcol + g8 * 8);
    uint4 rv = *(const uint4*)(p.pbuf() + (rowbase + tok) * NCOL + COL_BI + h * 96 + g8 * 8);
    float xs[8]; unpack8(raw, xs);
    const unsigned vv[4] = {rv.x, rv.y, rv.z, rv.w};
#pragma unroll
    for (int e = 0; e < 8; ++e) {
      const int dk = g8 * 8 + e;
      const float lb = lbp[dk];
      const float k = (1.f - lb) * (1.f - sigm(xs[e]));
      Kt[dk * 72 + tok] = f2bf(k * __expf(GL[dk] - Lf[tok * 97 + dk]));
      Vt[dk * 72 + tok] = (bf16_t)((e & 1) ? (vv[e >> 1] >> 16) : (vv[e >> 1] & 0xffffu));
    }
  }
  if (tid < 96) p.decay()[(size_t)task * 96 + tid] = __expf(GL[tid]);
  __syncthreads();
  bf16_t* dst = p.kvbuf() + (size_t)task * 9216;
  for (int i = 0; i < 9; ++i) {
    const int ti = wave * 9 + i, mt = ti / 6, nt = ti % 6;
    f32x4 acc = {0.f, 0.f, 0.f, 0.f};
#pragma unroll
    for (int ks = 0; ks < 2; ++ks) {
      bf16x8 ka = *(const bf16x8*)(Kt + (nt * 16 + l15) * 72 + ks * 32 + quad * 8);
      bf16x8 vb = *(const bf16x8*)(Vt + (mt * 16 + l15) * 72 + ks * 32 + quad * 8);
      acc = mfma16(ka, vb, acc);
    }
    *(uint2*)(dst + (mt * 16 + l15) * 96 + nt * 16 + 4 * quad) = make_uint2(pack2(acc[0], acc[1]), pack2(acc[2], acc[3]));
  }
  __syncthreads();
}

DEV void b_state_scan(const Params& p, int gidx) {
  const int dk8 = gidx % 12, dv = (gidx / 12) % 96, s = gidx / 1152;
  bf16_t* base = p.kvbuf() + (size_t)s * BSL * 9216 + dv * 96 + dk8 * 8;
  const float* dec = p.decay() + (size_t)s * BSL * 96 + dk8 * 8;
  float S[8];
#pragma unroll
  for (int e = 0; e < 8; ++e) S[e] = 0.f;
  for (int n0 = 0; n0 < BSL; n0 += 4) {
    uint4 kv[4]; float4 d0[4], d1[4];
#pragma unroll
    for (int i = 0; i < 4; ++i) { kv[i] = *(const uint4*)(base + (size_t)(n0 + i) * 9216); d0[i] = *(const float4*)(dec + (n0 + i) * 96); d1[i] = *(const float4*)(dec + (n0 + i) * 96 + 4); }
#pragma unroll
    for (int i = 0; i < 4; ++i) {
      *(uint4*)(base + (size_t)(n0 + i) * 9216) = make_uint4(pack2(S[0], S[1]), pack2(S[2], S[3]), pack2(S[4], S[5]), pack2(S[6], S[7]));
      float kf[8]; unpack8(kv[i], kf);
      S[0] = d0[i].x * S[0] + kf[0]; S[1] = d0[i].y * S[1] + kf[1]; S[2] = d0[i].z * S[2] + kf[2]; S[3] = d0[i].w * S[3] + kf[3];
      S[4] = d1[i].x * S[4] + kf[4]; S[5] = d1[i].y * S[5] + kf[5]; S[6] = d1[i].z * S[6] + kf[6]; S[7] = d1[i].w * S[7] + kf[7];
    }
  }
}

DEV void a_carry_scan(const Params& p, int gidx) {
  const int ch = gidx % 384, d = (gidx / 384) & 1, b = gidx / 768;
  const float2* ph = (const float2*)p.aPH() + (size_t)(b * 2 + d) * ACH * 384 + ch;
  float* cr = p.aCarry() + (size_t)(b * 2 + d) * ACH * 384 + ch;
  float hcur = 0.f;
  for (int s0 = 0; s0 < ACH; s0 += 8) {
    float2 v[8]; int scs[8];
#pragma unroll
    for (int i = 0; i < 8; ++i) { const int st = s0 + i; scs[i] = d ? (st < 8 ? 7 - st : ACH - 1 - (st - 8)) : st; v[i] = ph[(size_t)scs[i] * 384]; }
#pragma unroll
    for (int i = 0; i < 8; ++i) { cr[(size_t)scs[i] * 384] = hcur; hcur = v[i].x * hcur + v[i].y; }
  }
}

DEV void b_out_task(const Params& p, int l, int b, int h, int seg, int cj, char* smem) {
  const size_t rowbase = seg == 0 ? (size_t)NLAT + b * LCTX + cj * 64 : (size_t)b * LSEQ + cj * 64;
  float* Lf = (float*)smem; float* GL = Lf + 64 * 97;
  bf16_t* Qs = (bf16_t*)(smem + 25600);
  bf16_t* Ks = (bf16_t*)(smem + 38912);
  bf16_t* Vt = (bf16_t*)(smem + 52224);
  bf16_t* Sc = (bf16_t*)(smem + 66048);
  const int tid = tidx(), lane = tid & 63, wave = tid >> 6, quad = lane >> 4, l15 = lane & 15;
  for (int idx = tid; idx < 64 * 12; idx += 256) {
    const int tok = idx / 12, g8 = idx % 12;
    uint4 rv = *(const uint4*)(p.pbuf() + (rowbase + tok) * NCOL + COL_BI + h * 96 + g8 * 8);
    const unsigned vv[4] = {rv.x, rv.y, rv.z, rv.w};
#pragma unroll
    for (int e = 0; e < 8; ++e) Vt[(g8 * 8 + e) * 72 + tok] = (bf16_t)((e & 1) ? (vv[e >> 1] >> 16) : (vv[e >> 1] & 0xffffu));
  }
  f32x4 oacc[6];
#pragma unroll
  for (int nt = 0; nt < 6; ++nt) oacc[nt] = (f32x4){0.f, 0.f, 0.f, 0.f};
  const float* lbp = p.lbs() + l * 384 + h * 96;
  for (int d = 0; d < 2; ++d) {
    const int n = seg == 0 ? (d ? 3 - cj : cj) : 4 + (d ? 63 - cj : cj);
    const size_t stream = (size_t)(b * 4 + h) * 2 + d;
    b_logf_scan(p, l, h, d, rowbase, Lf, GL);
    const int fcol = (d ? COL_BFB : COL_BFF) + h * 96;
    for (int idx = tid; idx < 64 * 12; idx += 256) {
      const int tok = idx / 12, g8 = idx % 12;
      uint4 raw = *(const uint4*)(p.pbuf() + (rowbase + tok) * NCOL + fcol + g8 * 8);
      uint4 rq = *(const uint4*)(p.pbuf() + (rowbase + tok) * NCOL + COL_BQ + h * 96 + g8 * 8);
      float xs[8], qs[8], qg[8], kg[8]; unpack8(raw, xs); unpack8(rq, qs);
#pragma unroll
      for (int e = 0; e < 8; ++e) {
        const int dk = g8 * 8 + e;
        const float lb = lbp[dk];
        const float k = (1.f - lb) * (1.f - sigm(xs[e]));
        const float G = Lf[tok * 97 + dk];
        qg[e] = siluf(qs[e]) * __expf(G);
        kg[e] = k * __expf(-G);
      }
      *(uint4*)(Qs + tok * 104 + g8 * 8) = make_uint4(pack2(qg[0], qg[1]), pack2(qg[2], qg[3]), pack2(qg[4], qg[5]), pack2(qg[6], qg[7]));
      *(uint4*)(Ks + tok * 104 + g8 * 8) = make_uint4(pack2(kg[0], kg[1]), pack2(kg[2], kg[3]), pack2(kg[4], kg[5]), pack2(kg[6], kg[7]));
    }
    __syncthreads();
    bf16x8 qa[3];
#pragma unroll
    for (int ks = 0; ks < 3; ++ks) qa[ks] = *(const bf16x8*)(Qs + (wave * 16 + l15) * 104 + ks * 32 + quad * 8);
#pragma unroll
    for (int nt = 0; nt < 4; ++nt) {
      f32x4 acc = {0.f, 0.f, 0.f, 0.f};
#pragma unroll
      for (int ks = 0; ks < 3; ++ks) acc = mfma16(qa[ks], *(const bf16x8*)(Ks + (nt * 16 + l15) * 104 + ks * 32 + quad * 8), acc);
      int cb_ = wave * 16 + 4 * quad - nt * 16 - l15;
      asm volatile("" : "+v"(cb_));
      if (d) cb_ = -cb_;
#pragma unroll
      for (int jj = 0; jj < 4; ++jj) {
        const int cc = wave * 16 + 4 * quad + jj, ss = nt * 16 + l15;
        const int df = d ? cb_ - jj : cb_ + jj;
        Sc[cc * 72 + ss] = f2bf(df >= 0 ? acc[jj] : 0.f);
      }
    }
    __syncthreads();
    const bf16_t* St = p.kvbuf() + (stream * BSL + n) * 9216;
    bf16x8 sa[2];
#pragma unroll
    for (int ks = 0; ks < 2; ++ks) sa[ks] = *(const bf16x8*)(Sc + (wave * 16 + l15) * 72 + ks * 32 + quad * 8);
#pragma unroll
    for (int nt = 0; nt < 6; ++nt) {
#pragma unroll
      for (int ks = 0; ks < 2; ++ks) oacc[nt] = mfma16(sa[ks], *(const bf16x8*)(Vt + (nt * 16 + l15) * 72 + ks * 32 + quad * 8), oacc[nt]);
#pragma unroll
      for (int ks = 0; ks < 3; ++ks) oacc[nt] = mfma16(qa[ks], *(const bf16x8*)(St + (nt * 16 + l15) * 96 + ks * 32 + quad * 8), oacc[nt]);
    }
  }
  const float* gw = p.sp() + SP_BNW + l * 384 + h * 96;
#pragma unroll
  for (int jj = 0; jj < 4; ++jj) {
    float ss = 0.f;
#pragma unroll
    for (int nt = 0; nt < 6; ++nt) ss += oacc[nt][jj] * oacc[nt][jj];
    ss += __shfl_xor(ss, 1); ss += __shfl_xor(ss, 2); ss += __shfl_xor(ss, 4); ss += __shfl_xor(ss, 8);
    const float rstd = rsqrtf(ss * (1.f / 96.f) + EPSV);
    const size_t row = rowbase + wave * 16 + 4 * quad + jj;
#pragma unroll
    for (int nt = 0; nt < 6; ++nt) {
      const int dv = nt * 16 + l15;
      const float gate = bf2f(p.pbuf()[row * NCOL + COL_BG + h * 96 + dv]);
      p.hbuf()[row * 1024 + 384 + h * 96 + dv] = f2bf(oacc[nt][jj] * rstd * gw[dv] * siluf(gate));
    }
  }
  __syncthreads();
}

DEV void c_task(const Params& p, int l, size_t rowbase, char* smem) {
  bf16_t* Vt = (bf16_t*)smem;
  const int tid = tidx(), lane = tid & 63, wave = tid >> 6, quad = lane >> 4, l15 = lane & 15;
  const float* cnw = p.sp() + SP_CNW + l * 256;
  float nwv[4];
#pragma unroll
  for (int i = 0; i < 4; ++i) nwv[i] = cnw[lane + 64 * i];
  for (int tok = wave; tok < 128; tok += 4) {
    const bf16_t* src = p.pbuf() + (rowbase + tok) * NCOL + COL_CV;
    float v[4]; float s = 0.f;
#pragma unroll
    for (int i = 0; i < 4; ++i) { v[i] = geluf(bf2f(src[lane + 64 * i])); s += v[i]; }
    s = wave_sum(s);
    const float mu = s * (1.f / 256.f);
    float q = 0.f;
#pragma unroll
    for (int i = 0; i < 4; ++i) { v[i] -= mu; q += v[i] * v[i]; }
    q = wave_sum(q);
    const float rstd = rsqrtf(q * (1.f / 256.f) + EPSV);
#pragma unroll
    for (int i = 0; i < 4; ++i) Vt[(lane + 64 * i) * 136 + tok] = f2bf(v[i] * rstd * nwv[i]);
  }
  __syncthreads();
  const int h = wave;
  const bf16_t* ws = p.cws() + ((size_t)l * 4 + h) * 128 * 128;
  const float* bs = p.sp() + SP_CBS + (l * 4 + h) * 128;
  for (int mt = 0; mt < 8; ++mt) {
    f32x4 acc[4];
#pragma unroll
    for (int nt = 0; nt < 4; ++nt) acc[nt] = (f32x4){0.f, 0.f, 0.f, 0.f};
#pragma unroll
    for (int ks = 0; ks < 4; ++ks) {
      const bf16x8 wfrag = *(const bf16x8*)(ws + (mt * 16 + l15) * 128 + ks * 32 + quad * 8);
#pragma unroll
      for (int nt = 0; nt < 4; ++nt) acc[nt] = mfma16(wfrag, *(const bf16x8*)(Vt + (h * 64 + nt * 16 + l15) * 136 + ks * 32 + quad * 8), acc[nt]);
    }
#pragma unroll
    for (int jj = 0; jj < 4; ++jj) {
      const int s = mt * 16 + 4 * quad + jj;
      const size_t row = rowbase + s;
      const float bias = bs[s];
#pragma unroll
      for (int nt = 0; nt < 4; ++nt) {
        const int ch = h * 64 + nt * 16 + l15;
        const float u = geluf(bf2f(p.pbuf()[row * NCOL + COL_CU + ch]));
        const float gate = bf2f(p.pbuf()[row * NCOL + COL_CG + ch]);
        p.hbuf()[row * 1024 + 768 + ch] = f2bf(u * (acc[nt][jj] + bias) * siluf(gate));
      }
    }
  }
  __syncthreads();
}

#ifndef DBG_SUB
#define DBG_SUB 7
#endif
DEV void phase_m1(const Params& p, int l, int bid, int nblk, char* smem) {
  const int nC = (l == 0) ? 272 : 256;
  const int nBk = NB * 4 * 2 * BSL;
  const int nA = NB * ACH;
  const int NT = nC + nBk + nA;
  for (int task = bid; task < NT; task += nblk) {
    int t = task;
    if (t < nC) {
      size_t rowbase = (t < 256) ? (size_t)(t >> 5) * LSEQ + (t & 31) * 128 : (size_t)NLAT + ((t - 256) >> 1) * LCTX + ((t - 256) & 1) * 128;
      if (DBG_SUB & 1) c_task(p, l, rowbase, smem);
      continue;
    }
    t -= nC;
    if (t < nBk) { if (DBG_SUB & 2) b_kv_task(p, l, t, smem); continue; }
    t -= nBk;
    if (DBG_SUB & 4) a_chunk(p, l, t / ACH, t % ACH, false, smem);
  }
}

DEV void phase_m2(const Params& p, int bid, int nblk) {
  constexpr int NBB = 288, NAB = 24;
  for (int task = bid; task < NBB + NAB; task += nblk) {
    if (task < NBB) b_state_scan(p, task * 256 + tidx());
    else a_carry_scan(p, (task - NBB) * 256 + tidx());
  }
}

DEV void phase_m3(const Params& p, int l, int bid, int nblk, char* smem) {
  const int nB = (l == 0) ? 2048 + 128 : 2048;
  const int nA = (l == 0) ? 1024 + 64 : 1024;
  for (int task = bid; task < nB + nA; task += nblk) {
    int t = task;
    if (t < nB) {
      if (!(DBG_SUB & 2)) continue;
      if (t < 2048) b_out_task(p, l, t >> 8, (t >> 6) & 3, 1, t & 63, smem);
      else { int i2 = t - 2048; b_out_task(p, l, i2 >> 4, (i2 >> 2) & 3, 0, i2 & 3, smem); }
      continue;
    }
    t -= nB;
    if (!(DBG_SUB & 4)) continue;
    if (t < 1024) a_chunk(p, l, t >> 7, 8 + (t & 127), true, smem);
    else { int i2 = t - 1024; a_chunk(p, l, i2 >> 3, i2 & 7, true, smem); }
  }
}

#ifndef DBG_MASK
#define DBG_MASK 0xff
#endif
DEV void run_phase(const Params& p, int ph, int l, int bid, int nblk, char* smem) {
  if (!((DBG_MASK >> ph) & 1)) return;
  switch (ph) {
    case 0: phase_prep(p, bid, nblk, smem); break;
    case 1: phase_norm(p, l, bid, nblk); break;
    case 2: phase_gemm<0>(p, l, p.hbuf(), p.wtin() + (size_t)l * NCOL * 1024, MROWS, NCOL, smem, bid, nblk); break;
    case 3: phase_m1(p, l, bid, nblk, smem); break;
    case 4: phase_m2(p, bid, nblk); break;
    case 5: phase_m3(p, l, bid, nblk, smem); break;
    case 6: phase_gemm<1>(p, l, p.hbuf(), p.wtout() + (size_t)l * 1024 * 1024, (l == 0) ? MROWS : NLAT, 1024, smem, bid, nblk); break;
    default: phase_final(p, bid, nblk); break;
  }
}

#if MEGA
__global__ void __launch_bounds__(256, 2) mega_kernel(Params p) {
  __shared__ __attribute__((aligned(16))) char smem[SMEM_BYTES];
  cg::grid_group grid = cg::this_grid();
  const int bid = blockIdx.x, nblk = gridDim.x;
  run_phase(p, 0, 0, bid, nblk, smem);
  grid.sync();
#define PH(ph, l) run_phase(p, ph, l, bid, nblk, smem); grid.sync();
  PH(1, 0) PH(2, 0) PH(3, 0) PH(4, 0) PH(5, 0) PH(6, 0)
  PH(1, 1) PH(2, 1) PH(3, 1) PH(4, 1) PH(5, 1) PH(6, 1)
#undef PH
  run_phase(p, 7, 0, bid, nblk, smem);
}
#else
__global__ void __launch_bounds__(256, 2) phase_kernel(Params p, int ph, int l) {
  __shared__ __attribute__((aligned(16))) char smem[SMEM_BYTES];
  run_phase(p, ph, l, blockIdx.x, gridDim.x, smem);
}
#endif

extern "C" void kernel_launch(void* const* d_in, const int* in_sizes, int n_in, void* d_out, int out_size, void* d_ws, size_t ws_size,
                              hipStream_t stream) {
  Params p{};
  const float** f = (const float**)&p;
  for (int i = 0; i < 22; ++i) f[i] = (const float*)d_in[i];
  p.out = (float*)d_out;
  p.ws = (char*)d_ws;
  if (WS_TOTAL > ws_size) { fprintf(stderr, "workspace too small: need %zu have %zu\n", (size_t)WS_TOTAL, ws_size); return; }
#if MEGA
  static int grid_blocks = 0;
  if (!grid_blocks) {
    int dev = 0, cus = 0, per_cu = 0;
    hipGetDevice(&dev);
    hipDeviceGetAttribute(&cus, hipDeviceAttributeMultiprocessorCount, dev);
    hipOccupancyMaxActiveBlocksPerMultiprocessor(&per_cu, mega_kernel, 256, 0);
    if (per_cu > 2) per_cu = 2;
    if (per_cu < 1) per_cu = 1;
    grid_blocks = cus * per_cu;
  }
  void* args[] = {&p};
  hipError_t e = hipLaunchCooperativeKernel((void*)mega_kernel, dim3(grid_blocks), dim3(256), args, 0, stream);
  if (e != hipSuccess) fprintf(stderr, "cooperative launch failed: %s (grid %d)\n", hipGetErrorString(e), grid_blocks);
#else
  const int G = 1024;
  phase_kernel<<<G, 256, 0, stream>>>(p, 0, 0);
  for (int l = 0; l < 2; ++l)
    for (int ph = 1; ph <= 6; ++ph) phase_kernel<<<G, 256, 0, stream>>>(p, ph, l);
  phase_kernel<<<G, 256, 0, stream>>>(p, 7, 0);
#endif
}
```

```cpp
#include <hip/hip_runtime.h>
#include <hip/hip_cooperative_groups.h>
#include <cstdio>
namespace cg = cooperative_groups;

#ifndef MEGA
#define MEGA 1
#endif

#define DEV __device__ __forceinline__
typedef unsigned short bf16_t;
typedef short bf16x8 __attribute__((ext_vector_type(8)));
typedef float f32x4 __attribute__((ext_vector_type(4)));

constexpr int NB = 8, LSEQ = 4096, LCTX = 256, DM = 1024, NCOL = 3456;
constexpr int NLAT = NB * LSEQ, NCTXR = NB * LCTX, MROWS = NLAT + NCTXR;
constexpr int COL_AX = 0, COL_AG = 384, COL_BQ = 768, COL_BFF = 1152, COL_BFB = 1536, COL_BI = 1920, COL_BG = 2304,
              COL_CU = 2688, COL_CV = 2944, COL_CG = 3200;
constexpr int ACH = 136;
constexpr int BSL = 68;
constexpr int SMEM_BYTES = 76800;
constexpr float EPSV = 1e-6f;

constexpr size_t al256(size_t x) { return (x + 255) & ~(size_t)255; }
constexpr size_t OFF_WTIN = 0;
constexpr size_t OFF_WTOUT = OFF_WTIN + al256((size_t)2 * NCOL * 1024 * 2);
constexpr size_t OFF_GATEPACK = OFF_WTOUT + al256((size_t)2 * 1024 * 1024 * 2);
constexpr size_t OFF_HBUF = OFF_GATEPACK + al256((size_t)64 * 3072 * 2);
constexpr size_t OFF_PBUF = OFF_HBUF + al256((size_t)MROWS * 1024 * 2);
constexpr size_t OFF_KVBUF = OFF_PBUF + al256((size_t)MROWS * NCOL * 2);
constexpr size_t OFF_MOD = OFF_KVBUF + al256((size_t)64 * BSL * 9216 * 2);
constexpr size_t OFF_LBS = OFF_MOD + al256((size_t)2 * 9 * 3072 * 4);
constexpr size_t OFF_POSTAB = OFF_LBS + al256((size_t)3 * 384 * 4);
constexpr size_t OFF_CTXRES = OFF_POSTAB + al256((size_t)64 * 512 * 4);
constexpr size_t OFF_DECAY = OFF_CTXRES + al256((size_t)NCTXR * 1024 * 4);
constexpr size_t OFF_APH = OFF_DECAY + al256((size_t)64 * BSL * 96 * 4);
constexpr size_t OFF_ACARRY = OFF_APH + al256((size_t)NB * 2 * ACH * 384 * 2 * 4);
constexpr size_t OFF_SP = OFF_ACARRY + al256((size_t)NB * 2 * ACH * 384 * 4);
constexpr int SP_NORM_W = 0, SP_CONV_W = 2048, SP_CONV_B = 5120, SP_BR = 5888, SP_BI = 7424, SP_ASP = 8960, SP_BNW = 10496,
              SP_CNW = 11264, SP_CBS = 11776, SP_FNW = 12800, SP_TOTAL = 13824;
constexpr size_t OFF_CWS = OFF_SP + al256((size_t)SP_TOTAL * 4);
constexpr size_t OFF_BAR = OFF_CWS + al256((size_t)2 * 4 * 128 * 128 * 2);
constexpr size_t BAR_BYTES = 3456 * 4;
constexpr size_t WS_TOTAL = OFF_BAR + al256(BAR_BYTES);

struct Params {
  const float *x, *c, *ctx, *c_ctx, *norm_w, *w_mod, *b_mod, *w_in, *a_conv_w, *a_conv_b, *a_wr, *a_br, *a_wi, *a_bi,
      *a_lambda, *b_lb_logits, *b_norm_w, *c_norm_w, *c_ws, *c_bs, *w_out, *final_norm_w;
  float* out;
  char* ws;
  DEV bf16_t* wtin() const { return (bf16_t*)(ws + OFF_WTIN); }
  DEV bf16_t* wtout() const { return (bf16_t*)(ws + OFF_WTOUT); }
  DEV bf16_t* gatepack() const { return (bf16_t*)(ws + OFF_GATEPACK); }
  DEV bf16_t* hbuf() const { return (bf16_t*)(ws + OFF_HBUF); }
  DEV bf16_t* pbuf() const { return (bf16_t*)(ws + OFF_PBUF); }
  DEV bf16_t* kvbuf() const { return (bf16_t*)(ws + OFF_KVBUF); }
  DEV float* mod() const { return (float*)(ws + OFF_MOD); }
  DEV float* lbs() const { return (float*)(ws + OFF_LBS); }
  DEV float* postab() const { return (float*)(ws + OFF_POSTAB); }
  DEV float* ctxres() const { return (float*)(ws + OFF_CTXRES); }
  DEV float* decay() const { return (float*)(ws + OFF_DECAY); }
  DEV float* aPH() const { return (float*)(ws + OFF_APH); }
  DEV float* aCarry() const { return (float*)(ws + OFF_ACARRY); }
  DEV float* sp() const { return (float*)(ws + OFF_SP); }
  DEV bf16_t* cws() const { return (bf16_t*)(ws + OFF_CWS); }
};

typedef __bf16 bf2_t __attribute__((ext_vector_type(2)));
typedef float f2_t __attribute__((ext_vector_type(2)));
DEV unsigned pack2(float lo, float hi) { f2_t v = {lo, hi}; bf2_t b = __builtin_convertvector(v, bf2_t); return __builtin_bit_cast(unsigned, b); }
DEV bf16_t f2bf(float f) { __bf16 b = (__bf16)f; return __builtin_bit_cast(unsigned short, b); }
DEV float bflo(unsigned u) { return __uint_as_float(u << 16); }
DEV float bfhi(unsigned u) { return __uint_as_float(u & 0xffff0000u); }
DEV float bf2f(bf16_t h) { return __uint_as_float(((unsigned)h) << 16); }
DEV void unpack8(const uint4& r, float* o) {
  o[0] = bflo(r.x); o[1] = bfhi(r.x); o[2] = bflo(r.y); o[3] = bfhi(r.y);
  o[4] = bflo(r.z); o[5] = bfhi(r.z); o[6] = bflo(r.w); o[7] = bfhi(r.w);
}
DEV float frcp(float x) { return __builtin_amdgcn_rcpf(x); }
DEV float sigm(float x) { return frcp(1.f + __expf(-x)); }
DEV float siluf(float x) { return x * frcp(1.f + __expf(-x)); }
DEV float geluf(float x) { float z = 1.5957691216f * (x + 0.044715f * x * x * x); return x * frcp(1.f + __expf(-z)); }
DEV f32x4 mfma16(bf16x8 a, bf16x8 b, f32x4 c) { return __builtin_amdgcn_mfma_f32_16x16x32_bf16(a, b, c, 0, 0, 0); }
DEV float row_sum16(float v) {
  v += __builtin_bit_cast(float, __builtin_amdgcn_update_dpp(0, __builtin_bit_cast(int, v), 0xB1, 0xf, 0xf, false));
  v += __builtin_bit_cast(float, __builtin_amdgcn_update_dpp(0, __builtin_bit_cast(int, v), 0x4E, 0xf, 0xf, false));
  v += __builtin_bit_cast(float, __builtin_amdgcn_update_dpp(0, __builtin_bit_cast(int, v), 0x124, 0xf, 0xf, false));
  v += __builtin_bit_cast(float, __builtin_amdgcn_update_dpp(0, __builtin_bit_cast(int, v), 0x128, 0xf, 0xf, false));
  return v;
}
DEV int tidx() { int t = threadIdx.x; asm volatile("" : "+v"(t)); return t; }
DEV float wave_sum(float v) {
#pragma unroll
  for (int o = 32; o > 0; o >>= 1) v += __shfl_xor(v, o);
  return v;
}

DEV void prep_mod(const Params& p, int task, char* smem) {
  const int l = task / 192, j0 = (task % 192) * 16, tid = tidx();
  float* sv = (float*)smem;
  float* red = sv + 9 * 1024;
  for (int i = tid; i < 9 * 1024; i += 256) { int r = i >> 10, k = i & 1023; float v = (r < 8) ? p.c[r * 1024 + k] : p.c_ctx[k]; sv[i] = siluf(v); }
  __syncthreads();
  const int kg = tid >> 4, col = tid & 15;
  float acc[9];
#pragma unroll
  for (int r = 0; r < 9; ++r) acc[r] = 0.f;
  const float* w = p.w_mod + (size_t)l * 1024 * 3072 + j0 + col;
#pragma unroll 1
  for (int k = kg * 64; k < kg * 64 + 64; k += 16) {
    float wv[16];
#pragma unroll
    for (int u = 0; u < 16; ++u) wv[u] = w[(size_t)(k + u) * 3072];
#pragma unroll
    for (int u = 0; u < 16; ++u)
#pragma unroll
      for (int r = 0; r < 9; ++r) acc[r] += sv[r * 1024 + k + u] * wv[u];
  }
#pragma unroll
  for (int r = 0; r < 9; ++r) red[(kg * 9 + r) * 16 + col] = acc[r];
  __syncthreads();
  if (tid < 144) {
    int r = tid >> 4, cc = tid & 15; float s = 0.f;
#pragma unroll
    for (int g = 0; g < 16; ++g) s += red[(g * 9 + r) * 16 + cc];
    p.mod()[(l * 9 + r) * 3072 + j0 + cc] = s + p.b_mod[l * 3072 + j0 + cc];
  }
  __syncthreads();
}

DEV void prep_transpose(const float* __restrict__ src, bf16_t* __restrict__ dst, int N, int kt, int nt, char* smem) {
  float* tile = (float*)smem;
  const int tid = tidx(), r = tid >> 4, c4 = tid & 15;
#pragma unroll
  for (int i = 0; i < 4; ++i) {
    float4 v = *(const float4*)(src + (size_t)(kt * 64 + r + 16 * i) * N + nt * 64 + c4 * 4);
    float* t = tile + (r + 16 * i) * 65 + c4 * 4;
    t[0] = v.x; t[1] = v.y; t[2] = v.z; t[3] = v.w;
  }
  __syncthreads();
  const int n = tid >> 2, kq = tid & 3;
  unsigned o[8];
#pragma unroll
  for (int e = 0; e < 8; ++e) o[e] = pack2(tile[(kq * 16 + 2 * e) * 65 + n], tile[(kq * 16 + 2 * e + 1) * 65 + n]);
  uint4* d = (uint4*)(dst + (size_t)(nt * 64 + n) * 1024 + kt * 64 + kq * 16);
  d[0] = make_uint4(o[0], o[1], o[2], o[3]);
  d[1] = make_uint4(o[4], o[5], o[6], o[7]);
  __syncthreads();
}

DEV void phase_prep(const Params& p, int bid, int nblk, char* smem) {
  const int tid = tidx();
  constexpr int T_MOD = 384, T_LBS = 1, T_POS = 64, T_GP = 64, T_WIN = 2 * 16 * 54, T_WOUT = 2 * 16 * 16;
  constexpr int T_CP = 18;
  constexpr int NT = T_MOD + T_CP + T_LBS + T_POS + T_GP + T_WIN + T_WOUT;
  for (int task = bid; task < NT; task += nblk) {
    int t = task;
    if (t < T_MOD) { prep_mod(p, t, smem); continue; }
    t -= T_MOD;
    if (t < T_CP) {
      if (t >= 10) {
        const float* s = p.c_ws + (t - 10) * 16384; bf16_t* dd = p.cws() + (t - 10) * 16384;
        for (int i = tid; i < 16384; i += 256) dd[i] = f2bf(s[i]);
        continue;
      }
      const float* s; int off, n;
      switch (t) {
        case 0: s = p.norm_w; off = SP_NORM_W; n = 2048; break;
        case 1: s = p.a_conv_w; off = SP_CONV_W; n = 3072; break;
        case 2: s = p.a_conv_b; off = SP_CONV_B; n = 768; break;
        case 3: s = p.a_br; off = SP_BR; n = 1536; break;
        case 4: s = p.a_bi; off = SP_BI; n = 1536; break;
        case 5: s = p.a_lambda; off = SP_ASP; n = 1536; break;
        case 6: s = p.b_norm_w; off = SP_BNW; n = 768; break;
        case 7: s = p.c_norm_w; off = SP_CNW; n = 512; break;
        case 8: s = p.c_bs; off = SP_CBS; n = 1024; break;
        default: s = p.final_norm_w; off = SP_FNW; n = 1024; break;
      }
      float* dd = p.sp() + off;
      for (int i = tid; i < n; i += 256) { float v = s[i]; if (t == 5) v = 8.f * log1pf(expf(-v)); dd[i] = v; }
      continue;
    }
    t -= T_CP;
    if (t < T_LBS) {
      for (int i = tid; i < 384; i += 256) {
        float a = p.b_lb_logits[i], b = p.b_lb_logits[384 + i], cc = p.b_lb_logits[768 + i];
        float m = fmaxf(a, fmaxf(b, cc));
        float ea = expf(a - m), eb = expf(b - m), ec = expf(cc - m), inv = 1.f / (ea + eb + ec);
        p.lbs()[i] = ea * inv; p.lbs()[384 + i] = (ea + eb) * inv; p.lbs()[768 + i] = 1.f;
      }
      continue;
    }
    t -= T_LBS;
    if (t < T_POS) {
      int i = tid;
      float om = 1.0f / powf(10000.0f, (float)i / 256.0f);
      float ang = (float)t * om;
      p.postab()[t * 512 + i] = sinf(ang);
      p.postab()[t * 512 + 256 + i] = cosf(ang);
      continue;
    }
    t -= T_POS;
    if (t < T_GP) {
      const int mat = t & 1, ldh = t >> 1;
      const float* W = (mat ? p.a_wi : p.a_wr) + (size_t)ldh * 2304;
      bf16_t* dst = p.gatepack() + (size_t)t * 3072;
      for (int idx = tid; idx < 3072; idx += 256) {
        int jj = idx & 7, lane = (idx >> 3) & 63, nt = (idx >> 9) % 3, ks = idx / 1536;
        int k = ks * 32 + (lane >> 4) * 8 + jj, n = nt * 16 + (lane & 15);
        float v = (k < 48) ? W[k * 48 + n] : 0.f;
        dst[idx] = f2bf(v);
      }
      continue;
    }
    t -= T_GP;
    if (t < T_WIN) {
      int l = t / (16 * 54), r = t % (16 * 54);
      prep_transpose(p.w_in + (size_t)l * 1024 * NCOL, p.wtin() + (size_t)l * NCOL * 1024, NCOL, r / 54, r % 54, smem);
      continue;
    }
    t -= T_WIN;
    {
      int l = t / 256, r = t % 256;
      prep_transpose(p.w_out + (size_t)l * 1024 * 1024, p.wtout() + (size_t)l * 1024 * 1024, 1024, r / 16, r % 16, smem);
    }
  }
}

DEV void phase_norm(const Params& p, int layer, int bid, int nblk) {
  const int tid = tidx(), lane = tid & 63;
  const int wave = __builtin_amdgcn_readfirstlane(tid >> 6);
  const float* nwp = p.sp() + SP_NORM_W + layer * 1024;
  const int nwv = nblk * 4, per = (MROWS + nwv - 1) / nwv;
  const int r_begin = (bid * 4 + wave) * per;
  int r_end = r_begin + per; if (r_end > MROWS) r_end = MROWS;
  float4 nw[4], sh[4], sc[4];
#pragma unroll
  for (int i = 0; i < 4; ++i) { nw[i] = *(const float4*)(nwp + i * 256 + lane * 4); sh[i] = nw[i]; sc[i] = nw[i]; }
  int cur_m = -1;
  for (int row0 = r_begin; row0 < r_end; row0 += 2) {
    float4 v[2][4]; float ss[2]; int rows[2], mrows[2];
    const bool valid1 = row0 + 1 < r_end;
#pragma unroll
    for (int u = 0; u < 2; ++u) {
      const int row = (u == 1 && valid1) ? row0 + 1 : row0;
      rows[u] = row;
      const bool isctx = row >= NLAT;
      const float* src; float* res; int t = 0;
      if (!isctx) { t = row & 4095; src = (layer == 0 ? p.x : p.out) + (size_t)row * 1024; res = p.out + (size_t)row * 1024; mrows[u] = row >> 12; }
      else { int r2 = row - NLAT; src = (layer == 0 ? p.ctx : p.ctxres()) + (size_t)r2 * 1024; res = p.ctxres() + (size_t)r2 * 1024; mrows[u] = 8; }
      float s = 0.f;
#pragma unroll
      for (int i = 0; i < 4; ++i) {
        int col = i * 256 + lane * 4;
        float4 a = *(const float4*)(src + col);
        if (layer == 0) {
          if (!isctx) {
            const float* tp = p.postab() + ((i < 2) ? (t >> 6) : (t & 63)) * 512 + (col & 511);
            float4 q = *(const float4*)tp;
            a.x += q.x; a.y += q.y; a.z += q.z; a.w += q.w;
          }
        }
        v[u][i] = a;
        s += a.x * a.x + a.y * a.y + a.z * a.z + a.w * a.w;
      }
      ss[u] = s;
    }
#pragma unroll
    for (int u = 0; u < 2; ++u) {
      if (u == 1 && !valid1) break;
      if (mrows[u] != cur_m) {
        cur_m = mrows[u];
        const float* modp = p.mod() + (layer * 9 + cur_m) * 3072;
#pragma unroll
        for (int i = 0; i < 4; ++i) { sh[i] = *(const float4*)(modp + i * 256 + lane * 4); sc[i] = *(const float4*)(modp + 1024 + i * 256 + lane * 4); }
      }
      const float rstd = rsqrtf(wave_sum(ss[u]) * (1.f / 1024.f) + EPSV);
#pragma unroll
      for (int i = 0; i < 4; ++i) {
        int col = i * 256 + lane * 4;
        float h0 = v[u][i].x * rstd * nw[i].x * (1.f + sc[i].x) + sh[i].x;
        float h1 = v[u][i].y * rstd * nw[i].y * (1.f + sc[i].y) + sh[i].y;
        float h2 = v[u][i].z * rstd * nw[i].z * (1.f + sc[i].z) + sh[i].z;
        float h3 = v[u][i].w * rstd * nw[i].w * (1.f + sc[i].w) + sh[i].w;
        *(uint2*)(p.hbuf() + (size_t)rows[u] * 1024 + col) = make_uint2(pack2(h0, h1), pack2(h2, h3));
      }
    }
  }
}

DEV void phase_final(const Params& p, int bid, int nblk) {
  const int tid = tidx(), lane = tid & 63;
  const int wave = __builtin_amdgcn_readfirstlane(tid >> 6);
  const int nwv = nblk * 4, per = (NLAT + nwv - 1) / nwv;
  const int r_begin = (bid * 4 + wave) * per;
  int r_end = r_begin + per; if (r_end > NLAT) r_end = NLAT;
  const float* fwp = p.sp() + SP_FNW;
  float4 fw[4];
#pragma unroll
  for (int i = 0; i < 4; ++i) fw[i] = *(const float4*)(fwp + i * 256 + lane * 4);
  for (int row0 = r_begin; row0 < r_end; row0 += 2) {
    const bool valid1 = row0 + 1 < r_end;
    float4 v[2][4]; float ss[2];
#pragma unroll
    for (int u = 0; u < 2; ++u) {
      const float* src = p.out + (size_t)((u == 1 && valid1) ? row0 + 1 : row0) * 1024;
      float s = 0.f;
#pragma unroll
      for (int i = 0; i < 4; ++i) { v[u][i] = *(const float4*)(src + i * 256 + lane * 4); s += v[u][i].x * v[u][i].x + v[u][i].y * v[u][i].y + v[u][i].z * v[u][i].z + v[u][i].w * v[u][i].w; }
      ss[u] = s;
    }
#pragma unroll
    for (int u = 0; u < 2; ++u) {
      if (u == 1 && !valid1) break;
      float* dst = p.out + (size_t)(row0 + u) * 1024;
      const float rstd = rsqrtf(wave_sum(ss[u]) * (1.f / 1024.f) + EPSV);
#pragma unroll
      for (int i = 0; i < 4; ++i) {
        int col = i * 256 + lane * 4;
        float4 o; o.x = v[u][i].x * rstd * fw[i].x; o.y = v[u][i].y * rstd * fw[i].y; o.z = v[u][i].z * rstd * fw[i].z; o.w = v[u][i].w * rstd * fw[i].w;
        *(float4*)(dst + col) = o;
      }
    }
  }
}

constexpr int GLD = 72;
template <int EPI, int MODE = 0>
DEV void phase_gemm(const Params& p, int layer, const bf16_t* __restrict__ A, const bf16_t* __restrict__ Bt, int M, int N, char* smem, int bid, int nblk, int big_done = 0) {
  constexpr int K = 1024;
  bf16_t* As = (bf16_t*)smem;
  bf16_t* Bs = As + 2 * 128 * GLD;
  const int tid = tidx(), lane = tid & 63, wave = tid >> 6, quad = lane >> 4, l15 = lane & 15;
  const int wm = wave >> 1, wn = wave & 1;
  const int lrow = tid >> 3, lkc = tid & 7;
  const int nN = N / 128, T = (M / 128) * nN;
  const int xcd = bid & 7, jb = bid >> 3, per = nblk >> 3;
  const int Tx = (T + 7) >> 3;
  const int t_begin = xcd * Tx + jb;
  int t_end = (xcd + 1) * Tx; if (t_end > T) t_end = T;
  int ntl = (t_end - t_begin + per - 1) / per; if (t_end <= t_begin) ntl = 0;
  const int TxB = (((M / 256) * nN) + 7) >> 3;
  int tB_end = (xcd + 1) * TxB; if (tB_end > (M / 256) * nN) tB_end = (M / 256) * nN;
  const int tB_left0 = xcd * TxB + big_done * per;
  if (MODE == 1) ntl = (tB_left0 + (jb >> 1) < tB_end) ? 1 : 0;
  const int nsteps = ntl * 16;
#define G_TILE_OF(i, pm, pn) { if (MODE == 1) { const int t_ = tB_left0 + (jb >> 1); const int g_ = t_ / (8 * nN), r_ = t_ - g_ * 8 * nN; pn = r_ >> 3; pm = 2 * (g_ * 8 + (r_ & 7)) + (jb & 1); } \
    else { const int t_ = t_begin + per * (i); const int g_ = t_ / (8 * nN), r_ = t_ - g_ * 8 * nN; pn = r_ >> 3; pm = g_ * 8 + (r_ & 7); } }
#define G_LOAD(s, a, b) { int pm_, pn_; G_TILE_OF((s) >> 4, pm_, pn_); \
    const bf16_t* Ag_ = A + (size_t)(pm_ * 128 + lrow) * K + lkc * 8 + ((s) & 15) * 64; \
    const bf16_t* Bg_ = Bt + (size_t)(pn_ * 128 + lrow) * K + lkc * 8 + ((s) & 15) * 64; \
    a##0 = *(const uint4*)(Ag_); a##1 = *(const uint4*)(Ag_ + (size_t)32 * K); a##2 = *(const uint4*)(Ag_ + (size_t)64 * K); a##3 = *(const uint4*)(Ag_ + (size_t)96 * K); \
    b##0 = *(const uint4*)(Bg_); b##1 = *(const uint4*)(Bg_ + (size_t)32 * K); b##2 = *(const uint4*)(Bg_ + (size_t)64 * K); b##3 = *(const uint4*)(Bg_ + (size_t)96 * K); }
#define G_LSTORE(buf, a, b) { bf16_t* ad_ = As + (buf) * 128 * GLD + lrow * GLD + lkc * 8; bf16_t* bd_ = Bs + (buf) * 128 * GLD + lrow * GLD + lkc * 8; \
    *(uint4*)(ad_) = a##0; *(uint4*)(ad_ + 32 * GLD) = a##1; *(uint4*)(ad_ + 64 * GLD) = a##2; *(uint4*)(ad_ + 96 * GLD) = a##3; \
    *(uint4*)(bd_) = b##0; *(uint4*)(bd_ + 32 * GLD) = b##1; *(uint4*)(bd_ + 64 * GLD) = b##2; *(uint4*)(bd_ + 96 * GLD) = b##3; }
#define G_ZERO() { _Pragma("unroll") for (int i_ = 0; i_ < 4; ++i_) _Pragma("unroll") for (int j_ = 0; j_ < 4; ++j_) acc[i_][j_] = (f32x4){0.f, 0.f, 0.f, 0.f}; }
#define G_COMPUTE(buf) { \
    const bf16_t* as_ = As + (buf) * 128 * GLD + (wm * 64 + l15) * GLD + quad * 8; \
    const bf16_t* bs_ = Bs + (buf) * 128 * GLD + (wn * 64 + l15) * GLD + quad * 8; \
    _Pragma("unroll") for (int ks_ = 0; ks_ < 2; ++ks_) { \
      bf16x8 af_[4], bf_[4]; \
      _Pragma("unroll") for (int i_ = 0; i_ < 4; ++i_) { af_[i_] = *(const bf16x8*)(as_ + i_ * 16 * GLD + ks_ * 32); bf_[i_] = *(const bf16x8*)(bs_ + i_ * 16 * GLD + ks_ * 32); } \
      __builtin_amdgcn_s_setprio(1); \
      _Pragma("unroll") for (int mi_ = 0; mi_ < 4; ++mi_) _Pragma("unroll") for (int ni_ = 0; ni_ < 4; ++ni_) acc[mi_][ni_] = mfma16(bf_[ni_], af_[mi_], acc[mi_][ni_]); \
      __builtin_amdgcn_s_setprio(0); } }
  f32x4 acc[4][4];
  if (nsteps > 0) {
    uint4 ra00, ra01, ra02, ra03, rb00, rb01, rb02, rb03, ra10, ra11, ra12, ra13, rb10, rb11, rb12, rb13;
    G_LOAD(0, ra0, rb0); G_LOAD(1, ra1, rb1);
    G_LSTORE(0, ra0, rb0);
    __syncthreads();
    G_ZERO();
    for (int s = 0; s < nsteps; s += 2) {
      { const int s2_ = (s + 2 < nsteps) ? s + 2 : nsteps - 1; G_LOAD(s2_, ra0, rb0); }
      G_COMPUTE(0);
      G_LSTORE(1, ra1, rb1);
      __syncthreads();
      { const int s3_ = (s + 3 < nsteps) ? s + 3 : nsteps - 1; G_LOAD(s3_, ra1, rb1); }
      G_COMPUTE(1);
      if ((s & 15) == 14) {
        int pm, pn; G_TILE_OF(s >> 4, pm, pn);
        const int row0 = pm * 128 + wm * 64 + l15, c0 = pn * 128 + wn * 64 + 4 * quad;
        if (EPI == 0) {
#pragma unroll
          for (int mi = 0; mi < 4; ++mi) {
            bf16_t* dst = p.pbuf() + (size_t)(row0 + mi * 16) * NCOL + c0;
#pragma unroll
            for (int ni = 0; ni < 4; ++ni) *(uint2*)(dst + ni * 16) = make_uint2(pack2(acc[mi][ni][0], acc[mi][ni][1]), pack2(acc[mi][ni][2], acc[mi][ni][3]));
          }
        } else {
          const bool lat = pm * 128 < NLAT;
          float* res = lat ? p.out + (size_t)row0 * 1024 + c0 : p.ctxres() + (size_t)(row0 - NLAT) * 1024 + c0;
          const float* g = p.mod() + (layer * 9 + (lat ? (pm * 128) >> 12 : 8)) * 3072 + 2048 + c0;
          const float* rsrc = (layer == 0) ? (lat ? p.x + (size_t)row0 * 1024 + c0 : p.ctx + (size_t)(row0 - NLAT) * 1024 + c0) : (const float*)res;
          const bool addpos = (layer == 0) && lat;
          const float* ptab = p.postab() + (c0 & 511);
          const bool rowhalf = c0 < 512;
          float4 gg[4], r[4], rn[4];
#define G_RLOAD(dst, mi_) { _Pragma("unroll") for (int ni = 0; ni < 4; ++ni) { \
            float4 v_ = *(const float4*)(rsrc + (size_t)(mi_) * 16 * 1024 + ni * 16); \
            if (addpos) { const int t_ = (row0 + (mi_) * 16) & 4095; const float4 q_ = *(const float4*)(ptab + (rowhalf ? (t_ >> 6) : (t_ & 63)) * 512 + ni * 16); \
              v_.x += q_.x; v_.y += q_.y; v_.z += q_.z; v_.w += q_.w; } \
            dst[ni] = v_; } }
#pragma unroll
          for (int ni = 0; ni < 4; ++ni) gg[ni] = *(const float4*)(g + ni * 16);
          G_RLOAD(r, 0);
#pragma unroll
          for (int mi = 0; mi < 4; ++mi) {
            if (mi < 3) G_RLOAD(rn, mi + 1);
#pragma unroll
            for (int ni = 0; ni < 4; ++ni) {
              float4 o = r[ni];
              o.x += gg[ni].x * acc[mi][ni][0]; o.y += gg[ni].y * acc[mi][ni][1]; o.z += gg[ni].z * acc[mi][ni][2]; o.w += gg[ni].w * acc[mi][ni][3];
              *(float4*)(res + (size_t)mi * 16 * 1024 + ni * 16) = o;
            }
#pragma unroll
            for (int ni = 0; ni < 4; ++ni) r[ni] = rn[ni];
          }
#undef G_RLOAD
        }
        G_ZERO();
      }
      G_LSTORE(0, ra0, rb0);
      __syncthreads();
    }
  }
#undef G_TILE_OF
#undef G_LOAD
#undef G_LSTORE
#undef G_ZERO
#undef G_COMPUTE
}

DEV void phase_gemm_big(const Params& p, const bf16_t* __restrict__ A, const bf16_t* __restrict__ Bt, int M, int N, char* smem, int bid, int nblk, int max_tiles) {
  constexpr int K = 1024;
  bf16_t* As = (bf16_t*)smem;
  bf16_t* Bs = As + 256 * GLD;
  const int tid = tidx(), lane = tid & 63, wave = tid >> 6, quad = lane >> 4, l15 = lane & 15;
  const int wm = wave >> 1, wn = wave & 1;
  const int lrow = tid >> 3, lkc = tid & 7;
  const int nN = N / 128, T = (M / 256) * nN;
  const int xcd = bid & 7, jb = bid >> 3, per = nblk >> 3;
  const int Tx = (T + 7) >> 3;
  const int t_begin = xcd * Tx + jb;
  int t_end = (xcd + 1) * Tx; if (t_end > T) t_end = T;
  int ntl = (t_end - t_begin + per - 1) / per; if (t_end <= t_begin) ntl = 0;
  if (ntl > max_tiles) ntl = max_tiles;
  const int nsteps = ntl * 16;
#define GB_TILE_OF(i, pm, pn) { const int t_ = t_begin + per * (i); const int g_ = t_ / (8 * nN), r_ = t_ - g_ * 8 * nN; pn = r_ >> 3; pm = g_ * 8 + (r_ & 7); }
#define GB_LOAD(s) { int pm_, pn_; GB_TILE_OF((s) >> 4, pm_, pn_); \
    const bf16_t* Ag_ = A + (size_t)(pm_ * 256 + lrow) * K + lkc * 8 + ((s) & 15) * 64; \
    const bf16_t* Bg_ = Bt + (size_t)(pn_ * 128 + lrow) * K + lkc * 8 + ((s) & 15) * 64; \
    ra0 = *(const uint4*)(Ag_); ra1 = *(const uint4*)(Ag_ + (size_t)32 * K); ra2 = *(const uint4*)(Ag_ + (size_t)64 * K); ra3 = *(const uint4*)(Ag_ + (size_t)96 * K); \
    ra4 = *(const uint4*)(Ag_ + (size_t)128 * K); ra5 = *(const uint4*)(Ag_ + (size_t)160 * K); ra6 = *(const uint4*)(Ag_ + (size_t)192 * K); ra7 = *(const uint4*)(Ag_ + (size_t)224 * K); \
    rb0 = *(const uint4*)(Bg_); rb1 = *(const uint4*)(Bg_ + (size_t)32 * K); rb2 = *(const uint4*)(Bg_ + (size_t)64 * K); rb3 = *(const uint4*)(Bg_ + (size_t)96 * K); }
#define GB_LSTORE() { bf16_t* ad_ = As + lrow * GLD + lkc * 8; bf16_t* bd_ = Bs + lrow * GLD + lkc * 8; \
    *(uint4*)(ad_) = ra0; *(uint4*)(ad_ + 32 * GLD) = ra1; *(uint4*)(ad_ + 64 * GLD) = ra2; *(uint4*)(ad_ + 96 * GLD) = ra3; \
    *(uint4*)(ad_ + 128 * GLD) = ra4; *(uint4*)(ad_ + 160 * GLD) = ra5; *(uint4*)(ad_ + 192 * GLD) = ra6; *(uint4*)(ad_ + 224 * GLD) = ra7; \
    *(uint4*)(bd_) = rb0; *(uint4*)(bd_ + 32 * GLD) = rb1; *(uint4*)(bd_ + 64 * GLD) = rb2; *(uint4*)(bd_ + 96 * GLD) = rb3; }
  typedef float f32x16 __attribute__((ext_vector_type(16)));
  f32x16 acc[4][2];
  if (nsteps > 0) {
    uint4 ra0, ra1, ra2, ra3, ra4, ra5, ra6, ra7, rb0, rb1, rb2, rb3;
    GB_LOAD(0);
    GB_LSTORE();
    __syncthreads();
#pragma unroll
    for (int i = 0; i < 4; ++i)
#pragma unroll
      for (int j = 0; j < 2; ++j)
#pragma unroll
        for (int e = 0; e < 16; ++e) acc[i][j][e] = 0.f;
    const int l31 = lane & 31, hi = lane >> 5;
    const bf16_t* as_ = As + (wm * 128 + l31) * GLD + hi * 8;
    const bf16_t* bs_ = Bs + (wn * 64 + l31) * GLD + hi * 8;
    for (int s = 0; s < nsteps; ++s) {
      { const int s1_ = (s + 1 < nsteps) ? s + 1 : nsteps - 1; GB_LOAD(s1_); }
#pragma unroll
      for (int kk = 0; kk < 4; ++kk) {
        bf16x8 bf_[2], af_[4];
#pragma unroll
        for (int i = 0; i < 2; ++i) bf_[i] = *(const bf16x8*)(bs_ + i * 32 * GLD + kk * 16);
#pragma unroll
        for (int i = 0; i < 4; ++i) af_[i] = *(const bf16x8*)(as_ + i * 32 * GLD + kk * 16);
#pragma unroll
        for (int mi = 0; mi < 4; ++mi)
#pragma unroll
          for (int ni = 0; ni < 2; ++ni) acc[mi][ni] = __builtin_amdgcn_mfma_f32_32x32x16_bf16(bf_[ni], af_[mi], acc[mi][ni], 0, 0, 0);
      }
      if ((s & 15) == 15) {
        int pm, pn; GB_TILE_OF(s >> 4, pm, pn);
        const int row0 = pm * 256 + wm * 128 + l31, c0 = pn * 128 + wn * 64 + 4 * hi;
#pragma unroll
        for (int mi = 0; mi < 4; ++mi) {
          bf16_t* dst = p.pbuf() + (size_t)(row0 + mi * 32) * NCOL + c0;
#pragma unroll
          for (int ni = 0; ni < 2; ++ni)
#pragma unroll
            for (int g = 0; g < 4; ++g) {
              *(uint2*)(dst + ni * 32 + g * 8) = make_uint2(pack2(acc[mi][ni][4 * g], acc[mi][ni][4 * g + 1]), pack2(acc[mi][ni][4 * g + 2], acc[mi][ni][4 * g + 3]));
              acc[mi][ni][4 * g] = 0.f; acc[mi][ni][4 * g + 1] = 0.f; acc[mi][ni][4 * g + 2] = 0.f; acc[mi][ni][4 * g + 3] = 0.f;
            }
        }
      }
      __syncthreads();
      GB_LSTORE();
      __syncthreads();
    }
  }
#undef GB_TILE_OF
#undef GB_LOAD
#undef GB_LSTORE
}

DEV void a_chunk(const Params& p, int l, int b, int sc, bool fin, char* smem) {
  float* xcf = (float*)smem;
  bf16_t* xcb = (bf16_t*)(smem + 32 * 388 * 4);
  const int tid = tidx(), lane = tid & 63, wave = tid >> 6, quad = lane >> 4, l15 = lane & 15;
  int t0, Lseg; size_t rowbase;
  if (sc < 8) { t0 = sc * 32; Lseg = LCTX; rowbase = (size_t)NLAT + (size_t)b * LCTX; }
  else { t0 = (sc - 8) * 32; Lseg = LSEQ; rowbase = (size_t)b * LSEQ; }
  const float* cw = p.sp() + SP_CONV_W + l * 4 * 384;
  const float* cb = p.sp() + SP_CONV_B + l * 384;
  if (tid < 192) {
    const int cg = tid % 48, sg = tid / 48, ch0 = cg * 8, tb = sg * 8;
    uint4 rawr[11];
#pragma unroll
    for (int r = 0; r < 11; ++r) {
      const int tt = t0 + tb + r - 2;
      const int ttc = tt < 0 ? 0 : (tt >= Lseg ? Lseg - 1 : tt);
      rawr[r] = *(const uint4*)(p.pbuf() + (rowbase + ttc) * NCOL + COL_AX + ch0);
      if (tt != ttc) rawr[r] = make_uint4(0u, 0u, 0u, 0u);
    }
    float wv[4][8], bv[8];
    { const float4 b0 = *(const float4*)(cb + ch0), b1 = *(const float4*)(cb + ch0 + 4);
      bv[0] = b0.x; bv[1] = b0.y; bv[2] = b0.z; bv[3] = b0.w; bv[4] = b1.x; bv[5] = b1.y; bv[6] = b1.z; bv[7] = b1.w; }
#pragma unroll
    for (int w = 0; w < 4; ++w) {
      const float4 w0 = *(const float4*)(cw + w * 384 + ch0), w1 = *(const float4*)(cw + w * 384 + ch0 + 4);
      wv[w][0] = w0.x; wv[w][1] = w0.y; wv[w][2] = w0.z; wv[w][3] = w0.w; wv[w][4] = w1.x; wv[w][5] = w1.y; wv[w][6] = w1.z; wv[w][7] = w1.w;
    }
#pragma unroll
    for (int j = 0; j < 8; ++j) {
      float acc[8];
#pragma unroll
      for (int e = 0; e < 8; ++e) acc[e] = bv[e];
#pragma unroll
      for (int w = 0; w < 4; ++w) {
        float xs[8]; unpack8(rawr[j + w], xs);
#pragma unroll
        for (int e = 0; e < 8; ++e) acc[e] += xs[e] * wv[w][e];
      }
      const int t = tb + j;
      *(float4*)(xcf + t * 388 + ch0) = make_float4(acc[0], acc[1], acc[2], acc[3]);
      *(float4*)(xcf + t * 388 + ch0 + 4) = make_float4(acc[4], acc[5], acc[6], acc[7]);
      *(uint4*)(xcb + t * 392 + ch0) = make_uint4(pack2(acc[0], acc[1]), pack2(acc[2], acc[3]), pack2(acc[4], acc[5]), pack2(acc[6], acc[7]));
    }
  }
  __syncthreads();
  bf16x8 wrN[2][2], wiN[2][2]; float brN[2], biN[2], spN[2], hcN[2]; bf16_t gtN[2][4];
#define A_LOAD(HN) { \
    const int h_ = wave * 2 + (HN) / 3, nt_ = (HN) % 3, ch_ = h_ * 48 + nt_ * 16 + l15; \
    _Pragma("unroll") for (int d_ = 0; d_ < 2; ++d_) { \
      const bf16x8* gp_ = (const bf16x8*)p.gatepack() + (size_t)(((l * 2 + d_) * 8 + h_) * 2) * 6 * 64 + lane; \
      _Pragma("unroll") for (int ks_ = 0; ks_ < 2; ++ks_) { wrN[d_][ks_] = gp_[(ks_ * 3 + nt_) * 64]; wiN[d_][ks_] = gp_[(6 + ks_ * 3 + nt_) * 64]; } \
      brN[d_] = p.sp()[SP_BR + (l * 2 + d_) * 384 + ch_]; biN[d_] = p.sp()[SP_BI + (l * 2 + d_) * 384 + ch_]; \
      spN[d_] = p.sp()[SP_ASP + (l * 2 + d_) * 384 + ch_]; \
      hcN[d_] = fin ? p.aCarry()[((size_t)(b * 2 + d_) * ACH + sc) * 384 + ch_] : 0.f; } \
    if (fin) { _Pragma("unroll") for (int mt_ = 0; mt_ < 2; ++mt_) _Pragma("unroll") for (int jj_ = 0; jj_ < 4; ++jj_) \
      gtN[mt_][jj_] = p.pbuf()[(rowbase + t0 + mt_ * 16 + quad * 4 + jj_) * NCOL + COL_AG + ch_]; } }
  A_LOAD(0);
#pragma unroll 1
  for (int hn = 0; hn < 6; ++hn) {
    const int h = wave * 2 + hn / 3, nt = hn % 3;
    const int ch = h * 48 + nt * 16 + l15;
    f32x4 hf[2];
    bf16x8 wrA[2][2], wiA[2][2]; float brA[2], biA[2], spA[2], hcA[2]; bf16_t gtA[2][4];
#pragma unroll
    for (int d = 0; d < 2; ++d) {
#pragma unroll
      for (int ks = 0; ks < 2; ++ks) { wrA[d][ks] = wrN[d][ks]; wiA[d][ks] = wiN[d][ks]; }
      brA[d] = brN[d]; biA[d] = biN[d]; spA[d] = spN[d]; hcA[d] = hcN[d];
    }
#pragma unroll
    for (int mt = 0; mt < 2; ++mt)
#pragma unroll
      for (int jj = 0; jj < 4; ++jj) gtA[mt][jj] = gtN[mt][jj];
    { const int hn2 = hn < 5 ? hn + 1 : 5; A_LOAD(hn2); }
#pragma unroll
    for (int d = 0; d < 2; ++d) {
      const bf16x8 (&wr)[2] = wrA[d]; const bf16x8 (&wi)[2] = wiA[d];
      const size_t cidx = ((size_t)(b * 2 + d) * ACH + sc) * 384;
      const float br = brA[d], bi = biA[d], sp = spA[d];
      float hc = hcA[d], Pc = 1.f;
      const int lq = d ? 3 - quad : quad;
      const int s1 = d ? ((lane + 16) & 63) : ((lane - 16) & 63), s2 = d ? ((lane + 32) & 63) : ((lane - 32) & 63);
      const int lastl = d ? l15 : 48 + l15;
#pragma unroll
      for (int mi = 0; mi < 2; ++mi) {
        const int mt = d ? 1 - mi : mi;
        bf16x8 a0 = *(const bf16x8*)(xcb + (mt * 16 + l15) * 392 + h * 48 + quad * 8);
        bf16x8 a1 = {0, 0, 0, 0, 0, 0, 0, 0};
        if (quad < 2) a1 = *(const bf16x8*)(xcb + (mt * 16 + l15) * 392 + h * 48 + 32 + quad * 8);
        f32x4 ra = {0.f, 0.f, 0.f, 0.f}, ia = {0.f, 0.f, 0.f, 0.f};
        ra = mfma16(a0, wr[0], ra); ra = mfma16(a1, wr[1], ra);
        ia = mfma16(a0, wi[0], ia); ia = mfma16(a1, wi[1], ia);
        float av[4], uv[4];
#pragma unroll
        for (int jj = 0; jj < 4; ++jj) {
          const int tok = mt * 16 + quad * 4 + jj;
          const float xv = xcf[tok * 388 + ch];
          const float r = sigm(ra[jj] + br), ig = sigm(ia[jj] + bi);
          const float la = -r * sp;
          av[jj] = __expf(la);
          uv[jj] = __builtin_amdgcn_sqrtf(fmaxf(1.f - av[jj] * av[jj], 0.f)) * ig * xv;
        }
        float P = 1.f, H = 0.f, pl[4], hl[4];
#pragma unroll
        for (int q = 0; q < 4; ++q) { const int jj = d ? 3 - q : q; H = av[jj] * H + uv[jj]; P *= av[jj]; pl[jj] = P; hl[jj] = H; }
        float Pi = P, Hi = H;
        { float Ps = __shfl(Pi, s1), Hs = __shfl(Hi, s1); if (lq >= 1) { Hi = Pi * Hs + Hi; Pi = Pi * Ps; } }
        { float Ps = __shfl(Pi, s2), Hs = __shfl(Hi, s2); if (lq >= 2) { Hi = Pi * Hs + Hi; Pi = Pi * Ps; } }
        const float Pt = __shfl(Pi, lastl), Ht = __shfl(Hi, lastl);
        if (fin) {
          float Pe = __shfl(Pi, s1), He = __shfl(Hi, s1);
          if (lq == 0) { Pe = 1.f; He = 0.f; }
          const float hin = Pe * hc + He;
#pragma unroll
          for (int jj = 0; jj < 4; ++jj) {
            const float hv = pl[jj] * hin + hl[jj];
            if (d == 0) hf[mt][jj] = hv;
            else {
              const size_t row = rowbase + t0 + mt * 16 + quad * 4 + jj;
              p.hbuf()[row * 1024 + ch] = f2bf((hf[mt][jj] + hv) * siluf(bf2f(gtA[mt][jj])));
            }
          }
        }
        hc = Pt * hc + Ht; Pc *= Pt;
      }
      if (!fin && quad == 0) *(float2*)(p.aPH() + (cidx + ch) * 2) = make_float2(Pc, hc);
    }
  }
  __syncthreads();
}

#undef A_LOAD
DEV void b_logf_scan(const Params& p, int l, int h, int d, const uint4 (&rawf)[3], float* Lf, float* GL, float* OFFp) {
  const int tid = tidx();
  float* SEG = OFFp + 768;
  const float* lbp = p.lbs() + l * 384 + h * 96;
#pragma unroll
  for (int it = 0; it < 3; ++it) {
    const int idx = tid + 256 * it, tok = idx / 12, g8 = idx % 12;
    float xs[8]; unpack8(rawf[it], xs);
    const float4 lb0 = *(const float4*)(lbp + g8 * 8), lb1 = *(const float4*)(lbp + g8 * 8 + 4);
    const float lbv[8] = {lb0.x, lb0.y, lb0.z, lb0.w, lb1.x, lb1.y, lb1.z, lb1.w};
#pragma unroll
    for (int e = 0; e < 8; ++e) { const float lb = lbv[e]; const float f = lb + (1.f - lb) * sigm(xs[e]); Lf[tok * 97 + g8 * 8 + e] = __logf(f); }
  }
  __syncthreads();
#pragma unroll
  for (int it = 0; it < 3; ++it) {
    const int item = tid + 256 * it, c = item % 96, sg = item / 96;
    float run = 0.f;
#pragma unroll
    for (int j = 0; j < 8; ++j) { const int pp = sg * 8 + j, tok = d ? 63 - pp : pp; run += Lf[tok * 97 + c]; Lf[tok * 97 + c] = run; }
    SEG[sg * 96 + c] = run;
  }
  __syncthreads();
#pragma unroll
  for (int it = 0; it < 3; ++it) {
    const int item = tid + 256 * it, c = item % 96, sg = item / 96;
    float off = 0.f;
#pragma unroll
    for (int s = 0; s < 7; ++s) { const float t = SEG[s * 96 + c]; off += (s < sg) ? t : 0.f; }
    OFFp[sg * 96 + c] = off;
    if (sg == 7) GL[c] = off + SEG[7 * 96 + c];
  }
  __syncthreads();
}

DEV void b_kv_task(const Params& p, int l, int task, char* smem) {
  const int n = task % BSL, s = task / BSL, d = s & 1, h = (s >> 1) & 3, b = s >> 3;
  size_t rowbase;
  if (n < 4) { int cj = d ? 3 - n : n; rowbase = (size_t)NLAT + b * LCTX + cj * 64; }
  else { int cj = d ? 63 - (n - 4) : n - 4; rowbase = (size_t)b * LSEQ + cj * 64; }
  float* Lf = (float*)smem; float* GL = Lf + 64 * 97;
  bf16_t* Kt = (bf16_t*)(smem + 25600);
  bf16_t* Vt = Kt + 96 * 72;
  float* OFFp = (float*)(smem + 53248);
  const int tid = tidx(), lane = tid & 63, wave = tid >> 6, quad = lane >> 4, l15 = lane & 15;
  const int fcol = (d ? COL_BFB : COL_BFF) + h * 96;
  uint4 rawf[3], rawv[3];
#pragma unroll
  for (int it = 0; it < 3; ++it) {
    const int idx = tid + 256 * it, tok = idx / 12, g8 = idx % 12;
    rawf[it] = *(const uint4*)(p.pbuf() + (rowbase + tok) * NCOL + fcol + g8 * 8);
    rawv[it] = *(const uint4*)(p.pbuf() + (rowbase + tok) * NCOL + COL_BI + h * 96 + g8 * 8);
  }
  b_logf_scan(p, l, h, d, rawf, Lf, GL, OFFp);
  const float* lbp = p.lbs() + l * 384 + h * 96;
#pragma unroll
  for (int it = 0; it < 3; ++it) {
    const int idx = tid + 256 * it, tok = idx / 12, g8 = idx % 12;
    const int pp = d ? 63 - tok : tok;
    float xs[8]; unpack8(rawf[it], xs);
    const unsigned vv[4] = {rawv[it].x, rawv[it].y, rawv[it].z, rawv[it].w};
    float kend[8];
    const float4 lb0 = *(const float4*)(lbp + g8 * 8), lb1 = *(const float4*)(lbp + g8 * 8 + 4);
    const float lbv[8] = {lb0.x, lb0.y, lb0.z, lb0.w, lb1.x, lb1.y, lb1.z, lb1.w};
#pragma unroll
    for (int e = 0; e < 8; ++e) {
      const int dk = g8 * 8 + e;
      const float lb = lbv[e];
      const float k = (1.f - lb) * (1.f - sigm(xs[e]));
      const float G = Lf[tok * 97 + dk] + OFFp[(pp >> 3) * 96 + dk];
      kend[e] = k * __expf(GL[dk] - G);
    }
    const unsigned kp[4] = {pack2(kend[0], kend[1]), pack2(kend[2], kend[3]), pack2(kend[4], kend[5]), pack2(kend[6], kend[7])};
    bf16_t* kd = Kt + g8 * 8 * 72 + tok; bf16_t* vd = Vt + g8 * 8 * 72 + tok;
    const int rot = g8 & 7;
#pragma unroll
    for (int e0 = 0; e0 < 8; ++e0) {
      const int e = (e0 + rot) & 7;
      const unsigned kw = (e & 2) ? ((e & 4) ? kp[3] : kp[1]) : ((e & 4) ? kp[2] : kp[0]);
      const unsigned vw = (e & 2) ? ((e & 4) ? vv[3] : vv[1]) : ((e & 4) ? vv[2] : vv[0]);
      kd[e * 72] = (bf16_t)((e & 1) ? (kw >> 16) : (kw & 0xffffu));
      vd[e * 72] = (bf16_t)((e & 1) ? (vw >> 16) : (vw & 0xffffu));
    }
  }
  if (tid < 96) p.decay()[(size_t)task * 96 + tid] = __expf(GL[tid]);
  __syncthreads();
  bf16_t* dst = p.kvbuf() + (size_t)task * 9216;
  for (int i = 0; i < 9; ++i) {
    const int ti = wave * 9 + i, mt = ti / 6, nt = ti % 6;
    f32x4 acc = {0.f, 0.f, 0.f, 0.f};
#pragma unroll
    for (int ks = 0; ks < 2; ++ks) {
      bf16x8 ka = *(const bf16x8*)(Kt + (nt * 16 + l15) * 72 + ks * 32 + quad * 8);
      bf16x8 vb = *(const bf16x8*)(Vt + (mt * 16 + l15) * 72 + ks * 32 + quad * 8);
      acc = mfma16(ka, vb, acc);
    }
    *(uint2*)(dst + (mt * 16 + l15) * 96 + nt * 16 + 4 * quad) = make_uint2(pack2(acc[0], acc[1]), pack2(acc[2], acc[3]));
  }
  __syncthreads();
}

DEV void b_state_scan(const Params& p, int gidx) {
  const int dk8 = gidx % 12, dv = (gidx / 12) % 96, s = gidx / 1152;
  bf16_t* base = p.kvbuf() + (size_t)s * BSL * 9216 + dv * 96 + dk8 * 8;
  const float* dec = p.decay() + (size_t)s * BSL * 96 + dk8 * 8;
  float S[8];
#pragma unroll
  for (int e = 0; e < 8; ++e) S[e] = 0.f;
  uint4 kv[4];
#pragma unroll
  for (int i = 0; i < 4; ++i) kv[i] = *(const uint4*)(base + (size_t)i * 9216);
#pragma unroll 1
  for (int n0 = 0; n0 < BSL; n0 += 4) {
    uint4 kvn[4]; float4 d0[4], d1[4];
#pragma unroll
    for (int i = 0; i < 4; ++i) { d0[i] = *(const float4*)(dec + (n0 + i) * 96); d1[i] = *(const float4*)(dec + (n0 + i) * 96 + 4); }
    {
      const int nn = (n0 + 4 < BSL) ? n0 + 4 : n0;
#pragma unroll
      for (int i = 0; i < 4; ++i) kvn[i] = *(const uint4*)(base + (size_t)(nn + i) * 9216);
    }
#pragma unroll
    for (int i = 0; i < 4; ++i) {
      *(uint4*)(base + (size_t)(n0 + i) * 9216) = make_uint4(pack2(S[0], S[1]), pack2(S[2], S[3]), pack2(S[4], S[5]), pack2(S[6], S[7]));
      float kf[8]; unpack8(kv[i], kf);
      S[0] = d0[i].x * S[0] + kf[0]; S[1] = d0[i].y * S[1] + kf[1]; S[2] = d0[i].z * S[2] + kf[2]; S[3] = d0[i].w * S[3] + kf[3];
      S[4] = d1[i].x * S[4] + kf[4]; S[5] = d1[i].y * S[5] + kf[5]; S[6] = d1[i].z * S[6] + kf[6]; S[7] = d1[i].w * S[7] + kf[7];
    }
#pragma unroll
    for (int i = 0; i < 4; ++i) kv[i] = kvn[i];
  }
}

DEV void a_carry_wave(const Params& p, int widx) {
  const int lane = tidx() & 63;
  const int ch = widx % 384, d = (widx / 384) & 1, b = widx / 768;
  const float2* ph = (const float2*)p.aPH() + (size_t)(b * 2 + d) * ACH * 384 + ch;
  float* cr = p.aCarry() + (size_t)(b * 2 + d) * ACH * 384 + ch;
  float P[3], H[3]; int scv[3]; bool valid[3];
#pragma unroll
  for (int j = 0; j < 3; ++j) {
    const int pos = lane * 3 + j;
    valid[j] = pos < ACH;
    scv[j] = d ? (pos < 8 ? 7 - pos : ACH - 1 - (pos - 8)) : pos;
    float2 v = make_float2(1.f, 0.f);
    if (valid[j]) v = ph[(size_t)scv[j] * 384];
    P[j] = v.x; H[j] = v.y;
  }
  float Pi = P[0], Hi = H[0];
  Hi = P[1] * Hi + H[1]; Pi *= P[1];
  Hi = P[2] * Hi + H[2]; Pi *= P[2];
#pragma unroll
  for (int o = 1; o < 64; o <<= 1) {
    const float Ps = __shfl_up(Pi, o), Hs = __shfl_up(Hi, o);
    if (lane >= o) { Hi = Pi * Hs + Hi; Pi = Pi * Ps; }
  }
  float He = __shfl_up(Hi, 1);
  if (lane == 0) He = 0.f;
  const float c0 = He, c1 = P[0] * c0 + H[0], c2 = P[1] * c1 + H[1];
  if (valid[0]) cr[(size_t)scv[0] * 384] = c0;
  if (valid[1]) cr[(size_t)scv[1] * 384] = c1;
  if (valid[2]) cr[(size_t)scv[2] * 384] = c2;
}

DEV void b_out_task(const Params& p, int l, int b, int h, int seg, int cj, char* smem) {
  const size_t rowbase = seg == 0 ? (size_t)NLAT + b * LCTX + cj * 64 : (size_t)b * LSEQ + cj * 64;
  float* Lf = (float*)smem; float* GL = Lf + 64 * 97;
  bf16_t* Qs = (bf16_t*)(smem + 25600);
  bf16_t* Ks = (bf16_t*)(smem + 38912);
  bf16_t* Vt = (bf16_t*)(smem + 52224);
  bf16_t* Sc = (bf16_t*)(smem + 66048);
  float* OFFp = (float*)(smem + 66048);
  const int tid = tidx(), lane = tid & 63, wave = tid >> 6, quad = lane >> 4, l15 = lane & 15;
  uint4 rawv[3], rawq[3], rawf0[3], rawf1[3];
#pragma unroll
  for (int it = 0; it < 3; ++it) {
    const int idx = tid + 256 * it, tok = idx / 12, g8 = idx % 12;
    const bf16_t* rp = p.pbuf() + (rowbase + tok) * NCOL + h * 96 + g8 * 8;
    rawv[it] = *(const uint4*)(rp + COL_BI); rawq[it] = *(const uint4*)(rp + COL_BQ);
    rawf0[it] = *(const uint4*)(rp + COL_BFF); rawf1[it] = *(const uint4*)(rp + COL_BFB);
  }
  bf16_t gt[4][6];
#pragma unroll
  for (int jj = 0; jj < 4; ++jj)
#pragma unroll
    for (int nt = 0; nt < 6; ++nt) gt[jj][nt] = p.pbuf()[(rowbase + wave * 16 + 4 * quad + jj) * NCOL + COL_BG + h * 96 + nt * 16 + l15];
#pragma unroll
  for (int it = 0; it < 3; ++it) {
    const int idx = tid + 256 * it, tok = idx / 12, g8 = idx % 12;
    const unsigned vv[4] = {rawv[it].x, rawv[it].y, rawv[it].z, rawv[it].w};
    bf16_t* vd = Vt + g8 * 8 * 72 + tok;
    const int rot = g8 & 7;
#pragma unroll
    for (int e0 = 0; e0 < 8; ++e0) {
      const int e = (e0 + rot) & 7;
      const unsigned vw = (e & 2) ? ((e & 4) ? vv[3] : vv[1]) : ((e & 4) ? vv[2] : vv[0]);
      vd[e * 72] = (bf16_t)((e & 1) ? (vw >> 16) : (vw & 0xffffu));
    }
  }
  f32x4 oacc[6];
#pragma unroll
  for (int nt = 0; nt < 6; ++nt) oacc[nt] = (f32x4){0.f, 0.f, 0.f, 0.f};
  const float* lbp = p.lbs() + l * 384 + h * 96;
#pragma unroll
  for (int d = 0; d < 2; ++d) {
    const int n = seg == 0 ? (d ? 3 - cj : cj) : 4 + (d ? 63 - cj : cj);
    const size_t stream = (size_t)(b * 4 + h) * 2 + d;
    const bf16_t* St = p.kvbuf() + (stream * BSL + n) * 9216;
    b_logf_scan(p, l, h, d, d ? rawf1 : rawf0, Lf, GL, OFFp);
#pragma unroll
    for (int it = 0; it < 3; ++it) {
      const int idx = tid + 256 * it, tok = idx / 12, g8 = idx % 12;
      const int pp = d ? 63 - tok : tok;
      float xs[8], qs[8], qg[8], kg[8]; unpack8(d ? rawf1[it] : rawf0[it], xs); unpack8(rawq[it], qs);
      const float4 lb0 = *(const float4*)(lbp + g8 * 8), lb1 = *(const float4*)(lbp + g8 * 8 + 4);
      const float lbv[8] = {lb0.x, lb0.y, lb0.z, lb0.w, lb1.x, lb1.y, lb1.z, lb1.w};
#pragma unroll
      for (int e = 0; e < 8; ++e) {
        const int dk = g8 * 8 + e;
        const float lb = lbv[e];
        const float k = (1.f - lb) * (1.f - sigm(xs[e]));
        const float G = Lf[tok * 97 + dk] + OFFp[(pp >> 3) * 96 + dk];
        qg[e] = siluf(qs[e]) * __expf(G);
        kg[e] = k * __expf(-G);
      }
      *(uint4*)(Qs + tok * 104 + g8 * 8) = make_uint4(pack2(qg[0], qg[1]), pack2(qg[2], qg[3]), pack2(qg[4], qg[5]), pack2(qg[6], qg[7]));
      *(uint4*)(Ks + tok * 104 + g8 * 8) = make_uint4(pack2(kg[0], kg[1]), pack2(kg[2], kg[3]), pack2(kg[4], kg[5]), pack2(kg[6], kg[7]));
    }
    __syncthreads();
    bf16x8 qa[3];
#pragma unroll
    for (int ks = 0; ks < 3; ++ks) qa[ks] = *(const bf16x8*)(Qs + (wave * 16 + l15) * 104 + ks * 32 + quad * 8);
    bf16x8 sfr[6][3];
#pragma unroll
    for (int nt = 0; nt < 6; ++nt)
#pragma unroll
      for (int ks = 0; ks < 3; ++ks) sfr[nt][ks] = *(const bf16x8*)(St + (nt * 16 + l15) * 96 + ks * 32 + quad * 8);
#pragma unroll
    for (int nt = 0; nt < 4; ++nt) {
      f32x4 acc = {0.f, 0.f, 0.f, 0.f};
#pragma unroll
      for (int ks = 0; ks < 3; ++ks) acc = mfma16(qa[ks], *(const bf16x8*)(Ks + (nt * 16 + l15) * 104 + ks * 32 + quad * 8), acc);
      int cb_ = wave * 16 + 4 * quad - nt * 16 - l15;
      asm volatile("" : "+v"(cb_));
      if (d) cb_ = -cb_;
#pragma unroll
      for (int jj = 0; jj < 4; ++jj) {
        const int cc = wave * 16 + 4 * quad + jj, ss = nt * 16 + l15;
        const int df = d ? cb_ - jj : cb_ + jj;
        Sc[cc * 72 + ss] = f2bf(df >= 0 ? acc[jj] : 0.f);
      }
    }
    __syncthreads();
    bf16x8 sa[2];
#pragma unroll
    for (int ks = 0; ks < 2; ++ks) sa[ks] = *(const bf16x8*)(Sc + (wave * 16 + l15) * 72 + ks * 32 + quad * 8);
#pragma unroll
    for (int nt = 0; nt < 6; ++nt) {
#pragma unroll
      for (int ks = 0; ks < 2; ++ks) oacc[nt] = mfma16(sa[ks], *(const bf16x8*)(Vt + (nt * 16 + l15) * 72 + ks * 32 + quad * 8), oacc[nt]);
#pragma unroll
      for (int ks = 0; ks < 3; ++ks) oacc[nt] = mfma16(qa[ks], sfr[nt][ks], oacc[nt]);
    }
  }
  const float* gw = p.sp() + SP_BNW + l * 384 + h * 96;
  float gwv[6];
#pragma unroll
  for (int nt = 0; nt < 6; ++nt) gwv[nt] = gw[nt * 16 + l15];
#pragma unroll
  for (int jj = 0; jj < 4; ++jj) {
    float ss = 0.f;
#pragma unroll
    for (int nt = 0; nt < 6; ++nt) ss += oacc[nt][jj] * oacc[nt][jj];
    ss = row_sum16(ss);
    const float rstd = rsqrtf(ss * (1.f / 96.f) + EPSV);
    const size_t row = rowbase + wave * 16 + 4 * quad + jj;
#pragma unroll
    for (int nt = 0; nt < 6; ++nt) {
      const int dv = nt * 16 + l15;
      p.hbuf()[row * 1024 + 384 + h * 96 + dv] = f2bf(oacc[nt][jj] * rstd * gwv[nt] * siluf(bf2f(gt[jj][nt])));
    }
  }
  __syncthreads();
}

DEV void c_task(const Params& p, int l, size_t rowbase, char* smem) {
  bf16_t* Vt = (bf16_t*)smem;
  const int tid = tidx(), lane = tid & 63, wave = tid >> 6, quad = lane >> 4, l15 = lane & 15;
  {
    const float* cnw = p.sp() + SP_CNW + l * 256 + l15 * 16;
    const int sub = lane >> 4;
    float nwv[16];
#pragma unroll
    for (int i = 0; i < 4; ++i) { const float4 t = *(const float4*)(cnw + 4 * i); nwv[4 * i] = t.x; nwv[4 * i + 1] = t.y; nwv[4 * i + 2] = t.z; nwv[4 * i + 3] = t.w; }
#pragma unroll 1
    for (int g0 = 0; g0 < 8; g0 += 4) {
      uint4 r0[4], r1[4];
#pragma unroll
      for (int g = 0; g < 4; ++g) {
        const bf16_t* src = p.pbuf() + (rowbase + wave * 32 + (g0 + g) * 4 + sub) * NCOL + COL_CV + l15 * 16;
        r0[g] = *(const uint4*)src; r1[g] = *(const uint4*)(src + 8);
      }
#pragma unroll
      for (int g = 0; g < 4; ++g) {
        const int tok = wave * 32 + (g0 + g) * 4 + sub;
        float v[16]; unpack8(r0[g], v); unpack8(r1[g], v + 8);
        float s = 0.f;
#pragma unroll
        for (int i = 0; i < 16; ++i) { v[i] = geluf(v[i]); s += v[i]; }
        s = row_sum16(s);
        const float mu = s * (1.f / 256.f);
        float q = 0.f;
#pragma unroll
        for (int i = 0; i < 16; ++i) { v[i] -= mu; q += v[i] * v[i]; }
        q = row_sum16(q);
        const float rstd = rsqrtf(q * (1.f / 256.f) + EPSV);
        bf16_t* dstp = Vt + (l15 * 16) * 136 + ((((tok >> 3) ^ l15) & 15) << 3) + (tok & 7);
#pragma unroll
        for (int i = 0; i < 16; ++i) dstp[i * 136] = f2bf(v[i] * rstd * nwv[i]);
      }
    }
  }
  __syncthreads();
  const int h = wave;
  const bf16_t* ws = p.cws() + ((size_t)l * 4 + h) * 128 * 128;
  const float* bs = p.sp() + SP_CBS + (l * 4 + h) * 128;
  for (int mt = 0; mt < 8; ++mt) {
    bf16_t ur[4][4], gr[4][4]; float bias[4];
#pragma unroll
    for (int jj = 0; jj < 4; ++jj) {
      const size_t row = rowbase + mt * 16 + 4 * quad + jj;
      bias[jj] = bs[mt * 16 + 4 * quad + jj];
#pragma unroll
      for (int nt = 0; nt < 4; ++nt) {
        const int ch = h * 64 + nt * 16 + l15;
        ur[jj][nt] = p.pbuf()[row * NCOL + COL_CU + ch];
        gr[jj][nt] = p.pbuf()[row * NCOL + COL_CG + ch];
      }
    }
    f32x4 acc[4];
#pragma unroll
    for (int nt = 0; nt < 4; ++nt) acc[nt] = (f32x4){0.f, 0.f, 0.f, 0.f};
#pragma unroll
    for (int ks = 0; ks < 4; ++ks) {
      const bf16x8 wfrag = *(const bf16x8*)(ws + (mt * 16 + l15) * 128 + ks * 32 + quad * 8);
#pragma unroll
      for (int nt = 0; nt < 4; ++nt) acc[nt] = mfma16(wfrag, *(const bf16x8*)(Vt + (h * 64 + nt * 16 + l15) * 136 + ((((ks * 4 + quad) ^ (h * 4 + nt)) & 15) << 3)), acc[nt]);
    }
#pragma unroll
    for (int jj = 0; jj < 4; ++jj) {
      const size_t row = rowbase + mt * 16 + 4 * quad + jj;
#pragma unroll
      for (int nt = 0; nt < 4; ++nt) {
        const int ch = h * 64 + nt * 16 + l15;
        p.hbuf()[row * 1024 + 768 + ch] = f2bf(geluf(bf2f(ur[jj][nt])) * (acc[nt][jj] + bias[jj]) * siluf(bf2f(gr[jj][nt])));
      }
    }
  }
  __syncthreads();
}

#ifndef TIMING
#define TIMING 0
#endif
#if TIMING
#define TSH ((unsigned long long*)(smem + 76000))
#define TT_BEGIN() unsigned long long tt0_ = 0; if (bid == 0 && tidx() == 0) tt0_ = __builtin_amdgcn_s_memrealtime();
#define TT_END(code) if (bid == 0 && tidx() == 0) { unsigned long long d_ = __builtin_amdgcn_s_memrealtime() - tt0_; if ((code) == TIMING_A) TSH[1] += d_; if ((code) == TIMING_B) TSH[2] += d_; }
#else
#define TT_BEGIN()
#define TT_END(code)
#endif
#ifndef DBG_SUB
#define DBG_SUB 7
#endif
DEV void phase_m1(const Params& p, int l, int bid, int nblk, char* smem) {
  const int nC = (l == 0) ? 272 : 256;
  const int nBk = NB * 4 * 2 * BSL;
  const int nA = NB * ACH;
  const int NT = nC + nBk + nA;
  for (int task = bid; task < NT; task += nblk) {
    int t = task;
    if (t < nC) {
      size_t rowbase = (t < 256) ? (size_t)(t >> 5) * LSEQ + (t & 31) * 128 : (size_t)NLAT + ((t - 256) >> 1) * LCTX + ((t - 256) & 1) * 128;
      TT_BEGIN(); if (DBG_SUB & 1) c_task(p, l, rowbase, smem); TT_END(10);
      continue;
    }
    t -= nC;
    if (t < nBk) { TT_BEGIN(); if (DBG_SUB & 2) b_kv_task(p, l, t, smem); TT_END(11); continue; }
    t -= nBk;
    { TT_BEGIN(); if (DBG_SUB & 4) a_chunk(p, l, t / ACH, t % ACH, false, smem); TT_END(12); }
  }
}

DEV void phase_m2(const Params& p, int l, int bid, int nblk, char* smem) {
  constexpr int TT = 64 * 96 * 12;
  const int chunk = (TT + nblk - 1) / nblk;
  const int g_end = (bid + 1) * chunk < TT ? (bid + 1) * chunk : TT;
  for (int g = bid * chunk + tidx(); g < g_end; g += 256) b_state_scan(p, g);
  constexpr int NAB = 1536;
  for (int task = bid; task < NAB; task += nblk) a_carry_wave(p, task * 4 + (tidx() >> 6));
}

DEV void phase_m3(const Params& p, int l, int bid, int nblk, char* smem) {
  const int nB = (l == 0) ? 2048 + 128 : 2048;
  const int nA = (l == 0) ? 1024 + 64 : 1024;
  for (int task = bid; task < nB + nA; task += nblk) {
    int t = task;
    if (t < nB) {
      if (!(DBG_SUB & 2)) continue;
      TT_BEGIN();
      if (t < 2048) b_out_task(p, l, t >> 8, (t >> 6) & 3, 1, t & 63, smem);
      else { int i2 = t - 2048; b_out_task(p, l, i2 >> 4, (i2 >> 2) & 3, 0, i2 & 3, smem); }
      TT_END(13);
      continue;
    }
    t -= nB;
    if (!(DBG_SUB & 4)) continue;
    TT_BEGIN();
    if (t < 1024) a_chunk(p, l, t >> 7, 8 + (t & 127), true, smem);
    else { int i2 = t - 1024; a_chunk(p, l, i2 >> 3, i2 & 7, true, smem); }
    TT_END(14);
  }
}

#ifndef DBG_MASK
#define DBG_MASK 0xff
#endif
DEV void run_phase(const Params& p, int ph, int l, int bid, int nblk, char* smem) {
  if (!((DBG_MASK >> ph) & 1)) return;
  switch (ph) {
    case 0: phase_prep(p, bid, nblk, smem); break;
    case 1: phase_norm(p, l, bid, nblk); break;
    case 2: {
      const int full = (((MROWS / 256) * (NCOL / 128) + 7) >> 3) / (nblk >> 3);
      phase_gemm_big(p, p.hbuf(), p.wtin() + (size_t)l * NCOL * 1024, MROWS, NCOL, smem, bid, nblk, full);
      phase_gemm<0, 1>(p, l, p.hbuf(), p.wtin() + (size_t)l * NCOL * 1024, MROWS, NCOL, smem, bid, nblk, full);
      break; }
    case 3: phase_m1(p, l, bid, nblk, smem); break;
    case 4: phase_m2(p, l, bid, nblk, smem); break;
    case 5: phase_m3(p, l, bid, nblk, smem); break;
    case 6: phase_gemm<1>(p, l, p.hbuf(), p.wtout() + (size_t)l * 1024 * 1024, (l == 0) ? MROWS : NLAT, 1024, smem, bid, nblk); break;
    default: phase_final(p, bid, nblk); break;
  }
}

#define XB_TMO      128
#define XB_XCNT(j)  (256  + 64 * (j))
#define XB_XSUB(j)  (1280 + 64 * (j))
#define XB_XGEN(j)  (2304 + 64 * (j))
#define XB_TOP      3328
#define XB_TOPGEN   3392
#define XCD_BAR_WORDS 3456
#define XB_SPIN_CAP (1u << 18)
#define LAS __attribute__((address_space(3)))

__device__ __forceinline__ unsigned xb_ld(unsigned* p)              { return __hip_atomic_load(p, __ATOMIC_RELAXED, __HIP_MEMORY_SCOPE_AGENT); }
__device__ __forceinline__ unsigned xb_add(unsigned* p, unsigned v) { return __hip_atomic_fetch_add(p, v, __ATOMIC_RELAXED, __HIP_MEMORY_SCOPE_AGENT); }
__device__ __forceinline__ unsigned xb_xcc_id() { return (unsigned)__builtin_amdgcn_s_getreg((3 << 11) | 20) & 0xFu; }
#define XB_SPIN(cond, bar) do { unsigned _sp = 0; while (cond) { __builtin_amdgcn_s_sleep(1); \
    if ((++_sp & 255u) == 0u) { if (xb_ld(&(bar)[XB_TMO])) break; if (_sp > XB_SPIN_CAP) { atomicAdd(&(bar)[XB_TMO], 1u); break; } } } } while (0)

struct XcdBarrier {
    unsigned* bar; unsigned x;
    volatile LAS unsigned* st;
};

__device__ __forceinline__ XcdBarrier xcd_barrier_post(unsigned* bar, volatile LAS unsigned* st) {
    XcdBarrier b; b.bar = bar; b.x = xb_xcc_id(); b.st = st;
    if (threadIdx.x == 0) (void)xb_add(&bar[XB_XCNT(b.x)], 1u);
    return b;
}
__device__ __forceinline__ void xcd_barrier_complete(unsigned* bar, unsigned x, unsigned& nloc, unsigned& nx) {
    const unsigned G = gridDim.x * gridDim.y * gridDim.z;
    unsigned sum, cnt, mine, sp = 0u;
    for (;;) {
        sum = 0u; cnt = 0u; mine = 0u;
#pragma unroll
        for (unsigned j = 0; j < 16; ++j) { const unsigned c = xb_ld(&bar[XB_XCNT(j)]); sum += c; cnt += (c > 0u) ? 1u : 0u; mine = (j == x) ? c : mine; }
        if (sum == G) break;
        __builtin_amdgcn_s_sleep(1);
        if ((++sp & 255u) == 0u) { if (xb_ld(&bar[XB_TMO])) break; if (sp > XB_SPIN_CAP) { atomicAdd(&bar[XB_TMO], 1u); break; } }
    }
    nloc = mine > 0u ? mine : 1u; nx = cnt > 0u ? cnt : 1u;
}

__device__ __forceinline__ void xcd_barrier(const XcdBarrier& b) {
    asm volatile("s_waitcnt vmcnt(0)" ::: "memory");
    __syncthreads();
    if (threadIdx.x == 0) {
        unsigned* bar = b.bar;
        __builtin_amdgcn_s_waitcnt(0);
        unsigned nloc = b.st[0], nx = b.st[1];
        if (nloc == 0u) { xcd_barrier_complete(bar, b.x, nloc, nx); b.st[0] = nloc; b.st[1] = nx; }
        const unsigned old = xb_add(&bar[XB_XSUB(b.x)], 1u);
        const unsigned gen = old / nloc;
        if (old + 1u == (gen + 1u) * nloc) {
            __builtin_amdgcn_fence(__ATOMIC_RELEASE, "agent");
            asm volatile("s_waitcnt vmcnt(0)" ::: "memory");
            const unsigned og = xb_add(&bar[XB_TOP], 1u);
            const unsigned tg = og / nx;
            if (og + 1u == (tg + 1u) * nx) xb_add(&bar[XB_TOPGEN], 1u);
            else XB_SPIN(xb_ld(&bar[XB_TOPGEN]) == tg, bar);
            __builtin_amdgcn_fence(__ATOMIC_ACQUIRE, "agent");
            xb_add(&bar[XB_XGEN(b.x)], 1u);
            asm volatile("s_waitcnt vmcnt(0)" ::: "memory");
        } else {
            XB_SPIN(xb_ld(&bar[XB_XGEN(b.x)]) == gen, bar);
            __builtin_amdgcn_fence(__ATOMIC_ACQUIRE, "agent");
            asm volatile("s_waitcnt vmcnt(0)" ::: "memory");
        }
    }
    __syncthreads();
}


#if MEGA
__global__ void __launch_bounds__(256, 2) mega_kernel(Params p) {
  __shared__ __attribute__((aligned(16))) char smem[SMEM_BYTES];
  __shared__ uint4 xb_words;
  cg::grid_group grid = cg::this_grid();
  const int bid = blockIdx.x, nblk = gridDim.x;
  if (threadIdx.x == 0) xb_words = make_uint4(0u, 0u, 0u, 0u);
  __syncthreads();
  XcdBarrier xb = xcd_barrier_post((unsigned*)(p.ws + OFF_BAR), (volatile LAS unsigned*)&xb_words);
#if TIMING
  if (tidx() == 0) { TSH[0] = __builtin_amdgcn_s_memrealtime(); TSH[1] = 0; TSH[2] = 0; }
#define TICK(ph) { if (tidx() == 0) { unsigned long long tn = __builtin_amdgcn_s_memrealtime(); if ((ph) == TIMING_A) TSH[1] += tn - TSH[0]; if ((ph) == TIMING_B) TSH[2] += tn - TSH[0]; TSH[0] = tn; } }
#else
#define TICK(ph)
#endif
  if (p.ws == nullptr) grid.sync();
  run_phase(p, 0, 0, bid, nblk, smem);
  xcd_barrier(xb);
  TICK(0)
#define PH(ph, l) run_phase(p, ph, l, bid, nblk, smem); xcd_barrier(xb); TICK(ph)
  PH(1, 0) PH(2, 0) PH(3, 0) PH(4, 0) PH(5, 0) PH(6, 0)
  PH(1, 1) PH(2, 1) PH(3, 1) PH(4, 1) PH(5, 1) PH(6, 1)
#undef PH
  run_phase(p, 7, 0, bid, nblk, smem);
#if TIMING
  grid.sync();
  TICK(7)
  __syncthreads();
  if (bid == 0) {
    const float ta = (float)(TSH[1]) * 1e-5f, tb = (float)(TSH[2]) * 1e-5f;
    if (tidx() == 0) p.out[0] += 0.5f * ta;
    for (int i = tidx(); i < 65536; i += 256) p.out[1024 + i] += 0.5f * tb;
  }
#endif
}
#else
__global__ void __launch_bounds__(256, 2) phase_kernel(Params p, int ph, int l) {
  __shared__ __attribute__((aligned(16))) char smem[SMEM_BYTES];
  run_phase(p, ph, l, blockIdx.x, gridDim.x, smem);
}
#endif

extern "C" void kernel_launch(void* const* d_in, const int* in_sizes, int n_in, void* d_out, int out_size, void* d_ws, size_t ws_size,
                              hipStream_t stream) {
  Params p{};
  const float** f = (const float**)&p;
  for (int i = 0; i < 22; ++i) f[i] = (const float*)d_in[i];
  p.out = (float*)d_out;
  p.ws = (char*)d_ws;
  if (WS_TOTAL > ws_size) { fprintf(stderr, "workspace too small: need %zu have %zu\n", (size_t)WS_TOTAL, ws_size); return; }
#if MEGA
  static int grid_blocks = 0;
  if (!grid_blocks) {
    int dev = 0, cus = 0, per_cu = 0;
    hipGetDevice(&dev);
    hipDeviceGetAttribute(&cus, hipDeviceAttributeMultiprocessorCount, dev);
    hipOccupancyMaxActiveBlocksPerMultiprocessor(&per_cu, mega_kernel, 256, 0);
    if (per_cu > 2) per_cu = 2;
    if (per_cu < 1) per_cu = 1;
    grid_blocks = cus * per_cu;
  }
  (void)hipMemsetAsync(p.ws + OFF_BAR, 0, BAR_BYTES, stream);
  void* args[] = {&p};
  hipError_t e = hipLaunchCooperativeKernel((void*)mega_kernel, dim3(grid_blocks), dim3(256), args, 0, stream);
  if (e != hipSuccess) fprintf(stderr, "cooperative launch failed: %s (grid %d)\n", hipGetErrorString(e), grid_blocks);
#else
  const int G = 1024;
  phase_kernel<<<G, 256, 0, stream>>>(p, 0, 0);
  for (int l = 0; l < 2; ++l)
    for (int ph = 1; ph <= 6; ++ph) phase_kernel<<<G, 256, 0, stream>>>(p, ph, l);
  phase_kernel<<<G, 256, 0, stream>>>(p, 7, 0);
#endif
}
```

```cpp
#include <hip/hip_runtime.h>
#include <hip/hip_cooperative_groups.h>
#include <cstdio>
namespace cg = cooperative_groups;

#ifndef MEGA
#define MEGA 1
#endif

#define DEV __device__ __forceinline__
typedef unsigned short bf16_t;
typedef short bf16x8 __attribute__((ext_vector_type(8)));
typedef float f32x4 __attribute__((ext_vector_type(4)));

constexpr int NB = 8, LSEQ = 4096, LCTX = 256, DM = 1024, NCOL = 3456;
constexpr int NLAT = NB * LSEQ, NCTXR = NB * LCTX, MROWS = NLAT + NCTXR;
constexpr int COL_AX = 0, COL_AG = 384, COL_BQ = 768, COL_BFF = 1152, COL_BFB = 1536, COL_BI = 1920, COL_BG = 2304,
              COL_CU = 2688, COL_CV = 2944, COL_CG = 3200;
constexpr int ACH = 136;
constexpr int BSL = 68;
constexpr int SMEM_BYTES = 76800;
constexpr float EPSV = 1e-6f;

constexpr size_t al256(size_t x) { return (x + 255) & ~(size_t)255; }
constexpr size_t OFF_WTIN = 0;
constexpr size_t OFF_WTOUT = OFF_WTIN + al256((size_t)2 * NCOL * 1024 * 2);
constexpr size_t OFF_GATEPACK = OFF_WTOUT + al256((size_t)2 * 1024 * 1024 * 2);
constexpr size_t OFF_HBUF = OFF_GATEPACK + al256((size_t)64 * 3072 * 2);
constexpr size_t OFF_PBUF = OFF_HBUF + al256((size_t)MROWS * 1024 * 2);
constexpr size_t OFF_KVBUF = OFF_PBUF + al256((size_t)MROWS * NCOL * 2);
constexpr size_t OFF_MOD = OFF_KVBUF + al256((size_t)64 * BSL * 9216 * 2);
constexpr size_t OFF_LBS = OFF_MOD + al256((size_t)2 * 9 * 3072 * 4);
constexpr size_t OFF_POSTAB = OFF_LBS + al256((size_t)3 * 384 * 4);
constexpr size_t OFF_CTXRES = OFF_POSTAB + al256((size_t)64 * 512 * 4);
constexpr size_t OFF_DECAY = OFF_CTXRES + al256((size_t)NCTXR * 1024 * 4);
constexpr size_t OFF_APH = OFF_DECAY + al256((size_t)64 * BSL * 96 * 4);
constexpr size_t OFF_ACARRY = OFF_APH + al256((size_t)NB * 2 * ACH * 384 * 2 * 4);
constexpr size_t OFF_SP = OFF_ACARRY + al256((size_t)NB * 2 * ACH * 384 * 4);
constexpr int SP_NORM_W = 0, SP_CONV_W = 2048, SP_CONV_B = 5120, SP_BR = 5888, SP_BI = 7424, SP_ASP = 8960, SP_BNW = 10496,
              SP_CNW = 11264, SP_CBS = 11776, SP_FNW = 12800, SP_TOTAL = 13824;
constexpr size_t OFF_CWS = OFF_SP + al256((size_t)SP_TOTAL * 4);
constexpr size_t OFF_BAR = OFF_CWS + al256((size_t)2 * 4 * 128 * 128 * 2);
constexpr size_t BAR_BYTES = 3456 * 4;
constexpr size_t OFF_X16 = OFF_BAR + al256(BAR_BYTES);
constexpr size_t WS_TOTAL = OFF_X16 + al256((size_t)NLAT * 1024 * 2);
static_assert(WS_TOTAL <= (size_t)512 * 1024 * 1024, "workspace budget");

struct Params {
  const float *x, *c, *ctx, *c_ctx, *norm_w, *w_mod, *b_mod, *w_in, *a_conv_w, *a_conv_b, *a_wr, *a_br, *a_wi, *a_bi,
      *a_lambda, *b_lb_logits, *b_norm_w, *c_norm_w, *c_ws, *c_bs, *w_out, *final_norm_w;
  float* out;
  char* ws;
  DEV bf16_t* wtin() const { return (bf16_t*)(ws + OFF_WTIN); }
  DEV bf16_t* wtout() const { return (bf16_t*)(ws + OFF_WTOUT); }
  DEV bf16_t* gatepack() const { return (bf16_t*)(ws + OFF_GATEPACK); }
  DEV bf16_t* hbuf() const { return (bf16_t*)(ws + OFF_HBUF); }
  DEV bf16_t* pbuf() const { return (bf16_t*)(ws + OFF_PBUF); }
  DEV bf16_t* kvbuf() const { return (bf16_t*)(ws + OFF_KVBUF); }
  DEV float* mod() const { return (float*)(ws + OFF_MOD); }
  DEV float* lbs() const { return (float*)(ws + OFF_LBS); }
  DEV float* postab() const { return (float*)(ws + OFF_POSTAB); }
  DEV float* ctxres() const { return (float*)(ws + OFF_CTXRES); }
  DEV float* decay() const { return (float*)(ws + OFF_DECAY); }
  DEV float* aPH() const { return (float*)(ws + OFF_APH); }
  DEV float* aCarry() const { return (float*)(ws + OFF_ACARRY); }
  DEV float* sp() const { return (float*)(ws + OFF_SP); }
  DEV bf16_t* cws() const { return (bf16_t*)(ws + OFF_CWS); }
  DEV bf16_t* x16() const { return (bf16_t*)(ws + OFF_X16); }
  DEV bf16_t* apk() const { return (bf16_t*)out; }
};

typedef __bf16 bf2_t __attribute__((ext_vector_type(2)));
typedef float f2_t __attribute__((ext_vector_type(2)));
DEV unsigned pack2(float lo, float hi) { f2_t v = {lo, hi}; bf2_t b = __builtin_convertvector(v, bf2_t); return __builtin_bit_cast(unsigned, b); }
DEV bf16_t f2bf(float f) { __bf16 b = (__bf16)f; return __builtin_bit_cast(unsigned short, b); }
DEV float bflo(unsigned u) { return __uint_as_float(u << 16); }
DEV float bfhi(unsigned u) { return __uint_as_float(u & 0xffff0000u); }
DEV float bf2f(bf16_t h) { return __uint_as_float(((unsigned)h) << 16); }
DEV void unpack8(const uint4& r, float* o) {
  o[0] = bflo(r.x); o[1] = bfhi(r.x); o[2] = bflo(r.y); o[3] = bfhi(r.y);
  o[4] = bflo(r.z); o[5] = bfhi(r.z); o[6] = bflo(r.w); o[7] = bfhi(r.w);
}
DEV float frcp(float x) { return __builtin_amdgcn_rcpf(x); }
DEV float sigm(float x) { return frcp(1.f + __expf(-x)); }
DEV float siluf(float x) { return x * frcp(1.f + __expf(-x)); }
DEV float geluf(float x) { float z = 1.5957691216f * (x + 0.044715f * x * x * x); return x * frcp(1.f + __expf(-z)); }
DEV f32x4 mfma16(bf16x8 a, bf16x8 b, f32x4 c) { return __builtin_amdgcn_mfma_f32_16x16x32_bf16(a, b, c, 0, 0, 0); }
DEV float row_sum16(float v) {
  v += __builtin_bit_cast(float, __builtin_amdgcn_update_dpp(0, __builtin_bit_cast(int, v), 0xB1, 0xf, 0xf, false));
  v += __builtin_bit_cast(float, __builtin_amdgcn_update_dpp(0, __builtin_bit_cast(int, v), 0x4E, 0xf, 0xf, false));
  v += __builtin_bit_cast(float, __builtin_amdgcn_update_dpp(0, __builtin_bit_cast(int, v), 0x124, 0xf, 0xf, false));
  v += __builtin_bit_cast(float, __builtin_amdgcn_update_dpp(0, __builtin_bit_cast(int, v), 0x128, 0xf, 0xf, false));
  return v;
}
DEV int tidx() { int t = threadIdx.x; asm volatile("" : "+v"(t)); return t; }
DEV float wave_sum(float v) {
#pragma unroll
  for (int o = 32; o > 0; o >>= 1) v += __shfl_xor(v, o);
  return v;
}

DEV void prep_mod(const Params& p, int task, char* smem) {
  const int l = task / 192, j0 = (task % 192) * 16, tid = tidx();
  float* sv = (float*)smem;
  float* red = sv + 9 * 1024;
  for (int i = tid; i < 9 * 1024; i += 256) { int r = i >> 10, k = i & 1023; float v = (r < 8) ? p.c[r * 1024 + k] : p.c_ctx[k]; sv[i] = siluf(v); }
  __syncthreads();
  const int kg = tid >> 4, col = tid & 15;
  float acc[9];
#pragma unroll
  for (int r = 0; r < 9; ++r) acc[r] = 0.f;
  const float* w = p.w_mod + (size_t)l * 1024 * 3072 + j0 + col;
#pragma unroll 1
  for (int k = kg * 64; k < kg * 64 + 64; k += 16) {
    float wv[16];
#pragma unroll
    for (int u = 0; u < 16; ++u) wv[u] = w[(size_t)(k + u) * 3072];
#pragma unroll
    for (int u = 0; u < 16; ++u)
#pragma unroll
      for (int r = 0; r < 9; ++r) acc[r] += sv[r * 1024 + k + u] * wv[u];
  }
#pragma unroll
  for (int r = 0; r < 9; ++r) red[(kg * 9 + r) * 16 + col] = acc[r];
  __syncthreads();
  if (tid < 144) {
    int r = tid >> 4, cc = tid & 15; float s = 0.f;
#pragma unroll
    for (int g = 0; g < 16; ++g) s += red[(g * 9 + r) * 16 + cc];
    p.mod()[(l * 9 + r) * 3072 + j0 + cc] = s + p.b_mod[l * 3072 + j0 + cc];
  }
  __syncthreads();
}

DEV void prep_transpose(const float* __restrict__ src, bf16_t* __restrict__ dst, int N, int kt, int nt, char* smem) {
  float* tile = (float*)smem;
  const int tid = tidx(), r = tid >> 4, c4 = tid & 15;
#pragma unroll
  for (int i = 0; i < 4; ++i) {
    float4 v = *(const float4*)(src + (size_t)(kt * 64 + r + 16 * i) * N + nt * 64 + c4 * 4);
    float* t = tile + (r + 16 * i) * 65 + c4 * 4;
    t[0] = v.x; t[1] = v.y; t[2] = v.z; t[3] = v.w;
  }
  __syncthreads();
  const int n = tid >> 2, kq = tid & 3;
  unsigned o[8];
#pragma unroll
  for (int e = 0; e < 8; ++e) o[e] = pack2(tile[(kq * 16 + 2 * e) * 65 + n], tile[(kq * 16 + 2 * e + 1) * 65 + n]);
  uint4* d = (uint4*)(dst + (size_t)(nt * 64 + n) * 1024 + kt * 64 + kq * 16);
  d[0] = make_uint4(o[0], o[1], o[2], o[3]);
  d[1] = make_uint4(o[4], o[5], o[6], o[7]);
  __syncthreads();
}

DEV void phase_prep(const Params& p, int bid, int nblk, char* smem) {
  const int tid = tidx();
  constexpr int T_MOD = 384, T_LBS = 1, T_POS = 64, T_GP = 64, T_WIN = 2 * 16 * 54, T_WOUT = 2 * 16 * 16;
  constexpr int T_CP = 18;
  constexpr int NT = T_MOD + T_CP + T_LBS + T_POS + T_GP + T_WIN + T_WOUT;
  for (int task = bid; task < NT; task += nblk) {
    int t = task;
    if (t < T_MOD) { prep_mod(p, t, smem); continue; }
    t -= T_MOD;
    if (t < T_CP) {
      if (t >= 10) {
        const float* s = p.c_ws + (t - 10) * 16384; bf16_t* dd = p.cws() + (t - 10) * 16384;
        for (int i = tid; i < 16384; i += 256) dd[i] = f2bf(s[i]);
        continue;
      }
      const float* s; int off, n;
      switch (t) {
        case 0: s = p.norm_w; off = SP_NORM_W; n = 2048; break;
        case 1: s = p.a_conv_w; off = SP_CONV_W; n = 3072; break;
        case 2: s = p.a_conv_b; off = SP_CONV_B; n = 768; break;
        case 3: s = p.a_br; off = SP_BR; n = 1536; break;
        case 4: s = p.a_bi; off = SP_BI; n = 1536; break;
        case 5: s = p.a_lambda; off = SP_ASP; n = 1536; break;
        case 6: s = p.b_norm_w; off = SP_BNW; n = 768; break;
        case 7: s = p.c_norm_w; off = SP_CNW; n = 512; break;
        case 8: s = p.c_bs; off = SP_CBS; n = 1024; break;
        default: s = p.final_norm_w; off = SP_FNW; n = 1024; break;
      }
      float* dd = p.sp() + off;
      for (int i = tid; i < n; i += 256) { float v = s[i]; if (t == 5) v = 8.f * log1pf(expf(-v)); dd[i] = v; }
      continue;
    }
    t -= T_CP;
    if (t < T_LBS) {
      for (int i = tid; i < 384; i += 256) {
        float a = p.b_lb_logits[i], b = p.b_lb_logits[384 + i], cc = p.b_lb_logits[768 + i];
        float m = fmaxf(a, fmaxf(b, cc));
        float ea = expf(a - m), eb = expf(b - m), ec = expf(cc - m), inv = 1.f / (ea + eb + ec);
        p.lbs()[i] = ea * inv; p.lbs()[384 + i] = (ea + eb) * inv; p.lbs()[768 + i] = 1.f;
      }
      continue;
    }
    t -= T_LBS;
    if (t < T_POS) {
      int i = tid;
      float om = 1.0f / powf(10000.0f, (float)i / 256.0f);
      float ang = (float)t * om;
      p.postab()[t * 512 + i] = sinf(ang);
      p.postab()[t * 512 + 256 + i] = cosf(ang);
      continue;
    }
    t -= T_POS;
    if (t < T_GP) {
      const int mat = t & 1, ldh = t >> 1;
      const float* W = (mat ? p.a_wi : p.a_wr) + (size_t)ldh * 2304;
      bf16_t* dst = p.gatepack() + (size_t)t * 3072;
      for (int idx = tid; idx < 3072; idx += 256) {
        int jj = idx & 7, lane = (idx >> 3) & 63, nt = (idx >> 9) % 3, ks = idx / 1536;
        int k = ks * 32 + (lane >> 4) * 8 + jj, n = nt * 16 + (lane & 15);
        float v = (k < 48) ? W[k * 48 + n] : 0.f;
        dst[idx] = f2bf(v);
      }
      continue;
    }
    t -= T_GP;
    if (t < T_WIN) {
      int l = t / (16 * 54), r = t % (16 * 54);
      prep_transpose(p.w_in + (size_t)l * 1024 * NCOL, p.wtin() + (size_t)l * NCOL * 1024, NCOL, r / 54, r % 54, smem);
      continue;
    }
    t -= T_WIN;
    {
      int l = t / 256, r = t % 256;
      prep_transpose(p.w_out + (size_t)l * 1024 * 1024, p.wtout() + (size_t)l * 1024 * 1024, 1024, r / 16, r % 16, smem);
    }
  }
}

DEV void phase_norm(const Params& p, int layer, int bid, int nblk) {
  const int tid = tidx(), lane = tid & 63;
  const int wave = __builtin_amdgcn_readfirstlane(tid >> 6);
  const float* nwp = p.sp() + SP_NORM_W + layer * 1024;
  const int nwv = nblk * 4, per = (MROWS + nwv - 1) / nwv;
  const int r_begin = (bid * 4 + wave) * per;
  int r_end = r_begin + per; if (r_end > MROWS) r_end = MROWS;
  float4 nw[4], sh[4], sc[4];
#pragma unroll
  for (int i = 0; i < 4; ++i) { nw[i] = *(const float4*)(nwp + i * 256 + lane * 4); sh[i] = nw[i]; sc[i] = nw[i]; }
  int cur_m = -1;
  for (int row0 = r_begin; row0 < r_end; row0 += 2) {
    float4 v[2][4]; float ss[2]; int rows[2], mrows[2];
    const bool valid1 = row0 + 1 < r_end;
#pragma unroll
    for (int u = 0; u < 2; ++u) {
      const int row = (u == 1 && valid1) ? row0 + 1 : row0;
      rows[u] = row;
      const bool isctx = row >= NLAT;
      const float* src; float* res; int t = 0;
      if (!isctx) { t = row & 4095; src = (layer == 0 ? p.x : p.out) + (size_t)row * 1024; res = p.out + (size_t)row * 1024; mrows[u] = row >> 12; }
      else { int r2 = row - NLAT; src = (layer == 0 ? p.ctx : p.ctxres()) + (size_t)r2 * 1024; res = p.ctxres() + (size_t)r2 * 1024; mrows[u] = 8; }
      float s = 0.f;
#pragma unroll
      for (int i = 0; i < 4; ++i) {
        int col = i * 256 + lane * 4;
        float4 a;
        if (layer == 1 && !isctx) { const uint2 w_ = *(const uint2*)(p.x16() + (size_t)row * 1024 + col); a = make_float4(bflo(w_.x), bfhi(w_.x), bflo(w_.y), bfhi(w_.y)); }
        else a = *(const float4*)(src + col);
        if (layer == 0) {
          if (!isctx) {
            const float* tp = p.postab() + ((i < 2) ? (t >> 6) : (t & 63)) * 512 + (col & 511);
            float4 q = *(const float4*)tp;
            a.x += q.x; a.y += q.y; a.z += q.z; a.w += q.w;
          }
        }
        v[u][i] = a;
        s += a.x * a.x + a.y * a.y + a.z * a.z + a.w * a.w;
      }
      ss[u] = s;
    }
#pragma unroll
    for (int u = 0; u < 2; ++u) {
      if (u == 1 && !valid1) break;
      if (mrows[u] != cur_m) {
        cur_m = mrows[u];
        const float* modp = p.mod() + (layer * 9 + cur_m) * 3072;
#pragma unroll
        for (int i = 0; i < 4; ++i) { sh[i] = *(const float4*)(modp + i * 256 + lane * 4); sc[i] = *(const float4*)(modp + 1024 + i * 256 + lane * 4); }
      }
      const float rstd = rsqrtf(wave_sum(ss[u]) * (1.f / 1024.f) + EPSV);
#pragma unroll
      for (int i = 0; i < 4; ++i) {
        int col = i * 256 + lane * 4;
        float h0 = v[u][i].x * rstd * nw[i].x * (1.f + sc[i].x) + sh[i].x;
        float h1 = v[u][i].y * rstd * nw[i].y * (1.f + sc[i].y) + sh[i].y;
        float h2 = v[u][i].z * rstd * nw[i].z * (1.f + sc[i].z) + sh[i].z;
        float h3 = v[u][i].w * rstd * nw[i].w * (1.f + sc[i].w) + sh[i].w;
        *(uint2*)(p.hbuf() + (size_t)rows[u] * 1024 + col) = make_uint2(pack2(h0, h1), pack2(h2, h3));
      }
    }
  }
}

DEV void phase_final(const Params& p, int bid, int nblk) {
  const int tid = tidx(), lane = tid & 63;
  const int wave = __builtin_amdgcn_readfirstlane(tid >> 6);
  const int nwv = nblk * 4, per = (NLAT + nwv - 1) / nwv;
  const int r_begin = (bid * 4 + wave) * per;
  int r_end = r_begin + per; if (r_end > NLAT) r_end = NLAT;
  const float* fwp = p.sp() + SP_FNW;
  float4 fw[4];
#pragma unroll
  for (int i = 0; i < 4; ++i) fw[i] = *(const float4*)(fwp + i * 256 + lane * 4);
  for (int row0 = r_begin; row0 < r_end; row0 += 2) {
    const bool valid1 = row0 + 1 < r_end;
    float4 v[2][4]; float ss[2];
#pragma unroll
    for (int u = 0; u < 2; ++u) {
      const bf16_t* src = p.x16() + (size_t)((u == 1 && valid1) ? row0 + 1 : row0) * 1024;
      float s = 0.f;
#pragma unroll
      for (int i = 0; i < 4; ++i) { const uint2 w_ = *(const uint2*)(src + i * 256 + lane * 4); v[u][i] = make_float4(bflo(w_.x), bfhi(w_.x), bflo(w_.y), bfhi(w_.y)); s += v[u][i].x * v[u][i].x + v[u][i].y * v[u][i].y + v[u][i].z * v[u][i].z + v[u][i].w * v[u][i].w; }
      ss[u] = s;
    }
#pragma unroll
    for (int u = 0; u < 2; ++u) {
      if (u == 1 && !valid1) break;
      float* dst = p.out + (size_t)(row0 + u) * 1024;
      const float rstd = rsqrtf(wave_sum(ss[u]) * (1.f / 1024.f) + EPSV);
#pragma unroll
      for (int i = 0; i < 4; ++i) {
        int col = i * 256 + lane * 4;
        float4 o; o.x = v[u][i].x * rstd * fw[i].x; o.y = v[u][i].y * rstd * fw[i].y; o.z = v[u][i].z * rstd * fw[i].z; o.w = v[u][i].w * rstd * fw[i].w;
        *(float4*)(dst + col) = o;
      }
    }
  }
}

constexpr int GLD = 72;
template <int EPI, int MODE = 0>
DEV void phase_gemm(const Params& p, int layer, const bf16_t* __restrict__ A, const bf16_t* __restrict__ Bt, int M, int N, char* smem, int bid, int nblk, int big_done = 0) {
  constexpr int K = 1024;
  bf16_t* As = (bf16_t*)smem;
  bf16_t* Bs = As + 2 * 128 * GLD;
  const int tid = tidx(), lane = tid & 63, wave = tid >> 6, quad = lane >> 4, l15 = lane & 15;
  const int wm = wave >> 1, wn = wave & 1;
  const int lrow = tid >> 3, lkc = tid & 7;
  const int nN = N / 128, T = (M / 128) * nN;
  const int xcd = bid & 7, jb = bid >> 3, per = nblk >> 3;
  const int Tx = (T + 7) >> 3;
  const int t_begin = xcd * Tx + jb;
  int t_end = (xcd + 1) * Tx; if (t_end > T) t_end = T;
  int ntl = (t_end - t_begin + per - 1) / per; if (t_end <= t_begin) ntl = 0;
  const int TxB = (((M / 256) * nN) + 7) >> 3;
  int tB_end = (xcd + 1) * TxB; if (tB_end > (M / 256) * nN) tB_end = (M / 256) * nN;
  const int tB_left0 = xcd * TxB + big_done * per;
  if (MODE == 1) ntl = (tB_left0 + (jb >> 1) < tB_end) ? 1 : 0;
  const int nsteps = ntl * 16;
#define G_TILE_OF(i, pm, pn) { if (MODE == 1) { const int t_ = tB_left0 + (jb >> 1); const int g_ = t_ / (8 * nN), r_ = t_ - g_ * 8 * nN; pn = r_ >> 3; pm = 2 * (g_ * 8 + (r_ & 7)) + (jb & 1); } \
    else { const int t_ = t_begin + per * (i); const int g_ = t_ / (8 * nN), r_ = t_ - g_ * 8 * nN; pn = r_ >> 3; pm = g_ * 8 + (r_ & 7); } }
#define G_LOAD(s, a, b) { int pm_, pn_; G_TILE_OF((s) >> 4, pm_, pn_); \
    const bf16_t* Ag_ = A + (size_t)(pm_ * 128 + lrow) * K + lkc * 8 + ((s) & 15) * 64; \
    const bf16_t* Bg_ = Bt + (size_t)(pn_ * 128 + lrow) * K + lkc * 8 + ((s) & 15) * 64; \
    a##0 = *(const uint4*)(Ag_); a##1 = *(const uint4*)(Ag_ + (size_t)32 * K); a##2 = *(const uint4*)(Ag_ + (size_t)64 * K); a##3 = *(const uint4*)(Ag_ + (size_t)96 * K); \
    b##0 = *(const uint4*)(Bg_); b##1 = *(const uint4*)(Bg_ + (size_t)32 * K); b##2 = *(const uint4*)(Bg_ + (size_t)64 * K); b##3 = *(const uint4*)(Bg_ + (size_t)96 * K); }
#define G_LSTORE(buf, a, b) { bf16_t* ad_ = As + (buf) * 128 * GLD + lrow * GLD + lkc * 8; bf16_t* bd_ = Bs + (buf) * 128 * GLD + lrow * GLD + lkc * 8; \
    *(uint4*)(ad_) = a##0; *(uint4*)(ad_ + 32 * GLD) = a##1; *(uint4*)(ad_ + 64 * GLD) = a##2; *(uint4*)(ad_ + 96 * GLD) = a##3; \
    *(uint4*)(bd_) = b##0; *(uint4*)(bd_ + 32 * GLD) = b##1; *(uint4*)(bd_ + 64 * GLD) = b##2; *(uint4*)(bd_ + 96 * GLD) = b##3; }
#define G_ZERO() { _Pragma("unroll") for (int i_ = 0; i_ < 4; ++i_) _Pragma("unroll") for (int j_ = 0; j_ < 4; ++j_) acc[i_][j_] = (f32x4){0.f, 0.f, 0.f, 0.f}; }
#define G_COMPUTE(buf) { \
    const bf16_t* as_ = As + (buf) * 128 * GLD + (wm * 64 + l15) * GLD + quad * 8; \
    const bf16_t* bs_ = Bs + (buf) * 128 * GLD + (wn * 64 + l15) * GLD + quad * 8; \
    _Pragma("unroll") for (int ks_ = 0; ks_ < 2; ++ks_) { \
      bf16x8 af_[4], bf_[4]; \
      _Pragma("unroll") for (int i_ = 0; i_ < 4; ++i_) { af_[i_] = *(const bf16x8*)(as_ + i_ * 16 * GLD + ks_ * 32); bf_[i_] = *(const bf16x8*)(bs_ + i_ * 16 * GLD + ks_ * 32); } \
      __builtin_amdgcn_s_setprio(1); \
      _Pragma("unroll") for (int mi_ = 0; mi_ < 4; ++mi_) _Pragma("unroll") for (int ni_ = 0; ni_ < 4; ++ni_) acc[mi_][ni_] = mfma16(bf_[ni_], af_[mi_], acc[mi_][ni_]); \
      __builtin_amdgcn_s_setprio(0); } }
  f32x4 acc[4][4];
  if (nsteps > 0) {
    uint4 ra00, ra01, ra02, ra03, rb00, rb01, rb02, rb03, ra10, ra11, ra12, ra13, rb10, rb11, rb12, rb13;
    G_LOAD(0, ra0, rb0); G_LOAD(1, ra1, rb1);
    G_LSTORE(0, ra0, rb0);
    __syncthreads();
    G_ZERO();
    for (int s = 0; s < nsteps; s += 2) {
      { const int s2_ = (s + 2 < nsteps) ? s + 2 : nsteps - 1; G_LOAD(s2_, ra0, rb0); }
      G_COMPUTE(0);
      G_LSTORE(1, ra1, rb1);
      __syncthreads();
      { const int s3_ = (s + 3 < nsteps) ? s + 3 : nsteps - 1; G_LOAD(s3_, ra1, rb1); }
      G_COMPUTE(1);
      if ((s & 15) == 14) {
        int pm, pn; G_TILE_OF(s >> 4, pm, pn);
        const int row0 = pm * 128 + wm * 64 + l15, c0 = pn * 128 + wn * 64 + 4 * quad;
        if (EPI == 0) {
#pragma unroll
          for (int mi = 0; mi < 4; ++mi) {
            bf16_t* dst = p.pbuf() + (size_t)(row0 + mi * 16) * NCOL + c0;
#pragma unroll
            for (int ni = 0; ni < 4; ++ni) *(uint2*)(dst + ni * 16) = make_uint2(pack2(acc[mi][ni][0], acc[mi][ni][1]), pack2(acc[mi][ni][2], acc[mi][ni][3]));
          }
        } else {
          const bool lat = pm * 128 < NLAT;
          float* res = lat ? p.out + (size_t)row0 * 1024 + c0 : p.ctxres() + (size_t)(row0 - NLAT) * 1024 + c0;
          const float* g = p.mod() + (layer * 9 + (lat ? (pm * 128) >> 12 : 8)) * 3072 + 2048 + c0;
          const float* rsrc = (layer == 0) ? (lat ? p.x + (size_t)row0 * 1024 + c0 : p.ctx + (size_t)(row0 - NLAT) * 1024 + c0) : (const float*)res;
          bf16_t* x16p = p.x16() + (size_t)(lat ? row0 : 0) * 1024 + c0;
          const bool addpos = (layer == 0) && lat;
          const float* ptab = p.postab() + (c0 & 511);
          const bool rowhalf = c0 < 512;
          float4 gg[4], r[4], rn[4];
#define G_RLOAD(dst, mi_) { _Pragma("unroll") for (int ni = 0; ni < 4; ++ni) { \
            float4 v_; \
            if (layer == 0) v_ = *(const float4*)(rsrc + (size_t)(mi_) * 16 * 1024 + ni * 16); \
            else { const uint2 w_ = *(const uint2*)(x16p + (size_t)(mi_) * 16 * 1024 + ni * 16); v_ = make_float4(bflo(w_.x), bfhi(w_.x), bflo(w_.y), bfhi(w_.y)); } \
            if (addpos) { const int t_ = (row0 + (mi_) * 16) & 4095; const float4 q_ = *(const float4*)(ptab + (rowhalf ? (t_ >> 6) : (t_ & 63)) * 512 + ni * 16); \
              v_.x += q_.x; v_.y += q_.y; v_.z += q_.z; v_.w += q_.w; } \
            dst[ni] = v_; } }
#pragma unroll
          for (int ni = 0; ni < 4; ++ni) gg[ni] = *(const float4*)(g + ni * 16);
          G_RLOAD(r, 0);
#pragma unroll
          for (int mi = 0; mi < 4; ++mi) {
            if (mi < 3) G_RLOAD(rn, mi + 1);
#pragma unroll
            for (int ni = 0; ni < 4; ++ni) {
              float4 o = r[ni];
              o.x += gg[ni].x * acc[mi][ni][0]; o.y += gg[ni].y * acc[mi][ni][1]; o.z += gg[ni].z * acc[mi][ni][2]; o.w += gg[ni].w * acc[mi][ni][3];
              if (lat) *(uint2*)(x16p + (size_t)mi * 16 * 1024 + ni * 16) = make_uint2(pack2(o.x, o.y), pack2(o.z, o.w));
              else *(float4*)(res + (size_t)mi * 16 * 1024 + ni * 16) = o;
            }
#pragma unroll
            for (int ni = 0; ni < 4; ++ni) r[ni] = rn[ni];
          }
#undef G_RLOAD
        }
        G_ZERO();
      }
      G_LSTORE(0, ra0, rb0);
      __syncthreads();
    }
  }
#undef G_TILE_OF
#undef G_LOAD
#undef G_LSTORE
#undef G_ZERO
#undef G_COMPUTE
}

DEV void phase_gemm_big(const Params& p, const bf16_t* __restrict__ A, const bf16_t* __restrict__ Bt, int M, int N, char* smem, int bid, int nblk, int max_tiles) {
  constexpr int K = 1024;
  bf16_t* As = (bf16_t*)smem;
  bf16_t* Bs = As + 256 * GLD;
  const int tid = tidx(), lane = tid & 63, wave = tid >> 6, quad = lane >> 4, l15 = lane & 15;
  const int wm = wave >> 1, wn = wave & 1;
  const int lrow = tid >> 3, lkc = tid & 7;
  const int nN = N / 128, T = (M / 256) * nN;
  const int xcd = bid & 7, jb = bid >> 3, per = nblk >> 3;
  const int Tx = (T + 7) >> 3;
  const int t_begin = xcd * Tx + jb;
  int t_end = (xcd + 1) * Tx; if (t_end > T) t_end = T;
  int ntl = (t_end - t_begin + per - 1) / per; if (t_end <= t_begin) ntl = 0;
  if (ntl > max_tiles) ntl = max_tiles;
  const int nsteps = ntl * 16;
#define GB_TILE_OF(i, pm, pn) { const int t_ = t_begin + per * (i); const int g_ = t_ / (8 * nN), r_ = t_ - g_ * 8 * nN; pn = r_ >> 3; pm = g_ * 8 + (r_ & 7); }
#define GB_LOAD(s) { int pm_, pn_; GB_TILE_OF((s) >> 4, pm_, pn_); \
    const bf16_t* Ag_ = A + (size_t)(pm_ * 256 + lrow) * K + lkc * 8 + ((s) & 15) * 64; \
    const bf16_t* Bg_ = Bt + (size_t)(pn_ * 128 + lrow) * K + lkc * 8 + ((s) & 15) * 64; \
    ra0 = *(const uint4*)(Ag_); ra1 = *(const uint4*)(Ag_ + (size_t)32 * K); ra2 = *(const uint4*)(Ag_ + (size_t)64 * K); ra3 = *(const uint4*)(Ag_ + (size_t)96 * K); \
    ra4 = *(const uint4*)(Ag_ + (size_t)128 * K); ra5 = *(const uint4*)(Ag_ + (size_t)160 * K); ra6 = *(const uint4*)(Ag_ + (size_t)192 * K); ra7 = *(const uint4*)(Ag_ + (size_t)224 * K); \
    rb0 = *(const uint4*)(Bg_); rb1 = *(const uint4*)(Bg_ + (size_t)32 * K); rb2 = *(const uint4*)(Bg_ + (size_t)64 * K); rb3 = *(const uint4*)(Bg_ + (size_t)96 * K); }
#define GB_LSTORE() { bf16_t* ad_ = As + lrow * GLD + lkc * 8; bf16_t* bd_ = Bs + lrow * GLD + lkc * 8; \
    *(uint4*)(ad_) = ra0; *(uint4*)(ad_ + 32 * GLD) = ra1; *(uint4*)(ad_ + 64 * GLD) = ra2; *(uint4*)(ad_ + 96 * GLD) = ra3; \
    *(uint4*)(ad_ + 128 * GLD) = ra4; *(uint4*)(ad_ + 160 * GLD) = ra5; *(uint4*)(ad_ + 192 * GLD) = ra6; *(uint4*)(ad_ + 224 * GLD) = ra7; \
    *(uint4*)(bd_) = rb0; *(uint4*)(bd_ + 32 * GLD) = rb1; *(uint4*)(bd_ + 64 * GLD) = rb2; *(uint4*)(bd_ + 96 * GLD) = rb3; }
  f32x4 acc[8][4];
  if (nsteps > 0) {
    uint4 ra0, ra1, ra2, ra3, ra4, ra5, ra6, ra7, rb0, rb1, rb2, rb3;
    GB_LOAD(0);
    GB_LSTORE();
    __syncthreads();
#pragma unroll
    for (int i = 0; i < 8; ++i)
#pragma unroll
      for (int j = 0; j < 4; ++j) acc[i][j] = (f32x4){0.f, 0.f, 0.f, 0.f};
    const bf16_t* as_ = As + (wm * 128 + l15) * GLD + quad * 8;
    const bf16_t* bs_ = Bs + (wn * 64 + l15) * GLD + quad * 8;
    for (int s = 0; s < nsteps; ++s) {
      { const int s1_ = (s + 1 < nsteps) ? s + 1 : nsteps - 1; GB_LOAD(s1_); }
#pragma unroll
      for (int ks = 0; ks < 2; ++ks) {
        bf16x8 bf_[4];
#pragma unroll
        for (int i = 0; i < 4; ++i) bf_[i] = *(const bf16x8*)(bs_ + i * 16 * GLD + ks * 32);
#pragma unroll
        for (int hm = 0; hm < 2; ++hm) {
          bf16x8 af_[4];
#pragma unroll
          for (int i = 0; i < 4; ++i) af_[i] = *(const bf16x8*)(as_ + (hm * 4 + i) * 16 * GLD + ks * 32);
#pragma unroll
          for (int mi = 0; mi < 4; ++mi)
#pragma unroll
            for (int ni = 0; ni < 4; ++ni) acc[hm * 4 + mi][ni] = mfma16(bf_[ni], af_[mi], acc[hm * 4 + mi][ni]);
        }
      }
      if ((s & 15) == 15) {
        int pm, pn; GB_TILE_OF(s >> 4, pm, pn);
        const int row0 = pm * 256 + wm * 128 + l15, c0 = pn * 128 + wn * 64 + 4 * quad;
#pragma unroll
        for (int mi = 0; mi < 8; ++mi) {
          bf16_t* dst = p.pbuf() + (size_t)(row0 + mi * 16) * NCOL + c0;
#pragma unroll
          for (int ni = 0; ni < 4; ++ni) {
            *(uint2*)(dst + ni * 16) = make_uint2(pack2(acc[mi][ni][0], acc[mi][ni][1]), pack2(acc[mi][ni][2], acc[mi][ni][3]));
            acc[mi][ni] = (f32x4){0.f, 0.f, 0.f, 0.f};
          }
        }
      }
      __syncthreads();
      GB_LSTORE();
      __syncthreads();
    }
  }
#undef GB_TILE_OF
#undef GB_LOAD
#undef GB_LSTORE
}

DEV void a_chunk(const Params& p, int l, int b, int sc, bool fin, char* smem) {
  float* xcf = (float*)smem;
  bf16_t* xcb = (bf16_t*)(smem + 32 * 388 * 4);
  const int tid = tidx(), lane = tid & 63, wave = tid >> 6, quad = lane >> 4, l15 = lane & 15;
  int t0, Lseg; size_t rowbase;
  if (sc < 8) { t0 = sc * 32; Lseg = LCTX; rowbase = (size_t)NLAT + (size_t)b * LCTX; }
  else { t0 = (sc - 8) * 32; Lseg = LSEQ; rowbase = (size_t)b * LSEQ; }
  const float* cw = p.sp() + SP_CONV_W + l * 4 * 384;
  const float* cb = p.sp() + SP_CONV_B + l * 384;
  if (tid < 192) {
    const int cg = tid % 48, sg = tid / 48, ch0 = cg * 8, tb = sg * 8;
    uint4 rawr[11];
#pragma unroll
    for (int r = 0; r < 11; ++r) {
      const int tt = t0 + tb + r - 2;
      const int ttc = tt < 0 ? 0 : (tt >= Lseg ? Lseg - 1 : tt);
      rawr[r] = *(const uint4*)(p.pbuf() + (rowbase + ttc) * NCOL + COL_AX + ch0);
      if (tt != ttc) rawr[r] = make_uint4(0u, 0u, 0u, 0u);
    }
    float wv[4][8], bv[8];
    { const float4 b0 = *(const float4*)(cb + ch0), b1 = *(const float4*)(cb + ch0 + 4);
      bv[0] = b0.x; bv[1] = b0.y; bv[2] = b0.z; bv[3] = b0.w; bv[4] = b1.x; bv[5] = b1.y; bv[6] = b1.z; bv[7] = b1.w; }
#pragma unroll
    for (int w = 0; w < 4; ++w) {
      const float4 w0 = *(const float4*)(cw + w * 384 + ch0), w1 = *(const float4*)(cw + w * 384 + ch0 + 4);
      wv[w][0] = w0.x; wv[w][1] = w0.y; wv[w][2] = w0.z; wv[w][3] = w0.w; wv[w][4] = w1.x; wv[w][5] = w1.y; wv[w][6] = w1.z; wv[w][7] = w1.w;
    }
#pragma unroll
    for (int j = 0; j < 8; ++j) {
      float acc[8];
#pragma unroll
      for (int e = 0; e < 8; ++e) acc[e] = bv[e];
#pragma unroll
      for (int w = 0; w < 4; ++w) {
        float xs[8]; unpack8(rawr[j + w], xs);
#pragma unroll
        for (int e = 0; e < 8; ++e) acc[e] += xs[e] * wv[w][e];
      }
      const int t = tb + j;
      *(float4*)(xcf + t * 388 + ch0) = make_float4(acc[0], acc[1], acc[2], acc[3]);
      *(float4*)(xcf + t * 388 + ch0 + 4) = make_float4(acc[4], acc[5], acc[6], acc[7]);
      *(uint4*)(xcb + t * 392 + ch0) = make_uint4(pack2(acc[0], acc[1]), pack2(acc[2], acc[3]), pack2(acc[4], acc[5]), pack2(acc[6], acc[7]));
    }
  }
  __syncthreads();
  bf16x8 wrN[2][2], wiN[2][2]; float brN[2], biN[2], spN[2], hcN[2]; bf16_t gtN[2][4];
#define A_LOAD(HN) { \
    const int h_ = wave * 2 + (HN) / 3, nt_ = (HN) % 3, ch_ = h_ * 48 + nt_ * 16 + l15; \
    _Pragma("unroll") for (int d_ = 0; d_ < 2; ++d_) { \
      const bf16x8* gp_ = (const bf16x8*)p.gatepack() + (size_t)(((l * 2 + d_) * 8 + h_) * 2) * 6 * 64 + lane; \
      _Pragma("unroll") for (int ks_ = 0; ks_ < 2; ++ks_) { wrN[d_][ks_] = gp_[(ks_ * 3 + nt_) * 64]; wiN[d_][ks_] = gp_[(6 + ks_ * 3 + nt_) * 64]; } \
      brN[d_] = p.sp()[SP_BR + (l * 2 + d_) * 384 + ch_]; biN[d_] = p.sp()[SP_BI + (l * 2 + d_) * 384 + ch_]; \
      spN[d_] = p.sp()[SP_ASP + (l * 2 + d_) * 384 + ch_]; \
      hcN[d_] = fin ? p.aCarry()[((size_t)(b * 2 + d_) * ACH + sc) * 384 + ch_] : 0.f; } \
    if (fin) { _Pragma("unroll") for (int mt_ = 0; mt_ < 2; ++mt_) _Pragma("unroll") for (int jj_ = 0; jj_ < 4; ++jj_) \
      gtN[mt_][jj_] = p.pbuf()[(rowbase + t0 + mt_ * 16 + quad * 4 + jj_) * NCOL + COL_AG + ch_]; } }
  A_LOAD(0);
#pragma unroll 1
  for (int hn = 0; hn < 6; ++hn) {
    const int h = wave * 2 + hn / 3, nt = hn % 3;
    const int ch = h * 48 + nt * 16 + l15;
    f32x4 hf[2], pfv[2];
    bf16x8 wrA[2][2], wiA[2][2]; float brA[2], biA[2], spA[2], hcA[2]; bf16_t gtA[2][4];
#pragma unroll
    for (int d = 0; d < 2; ++d) {
#pragma unroll
      for (int ks = 0; ks < 2; ++ks) { wrA[d][ks] = wrN[d][ks]; wiA[d][ks] = wiN[d][ks]; }
      brA[d] = brN[d]; biA[d] = biN[d]; spA[d] = spN[d]; hcA[d] = hcN[d];
    }
#pragma unroll
    for (int mt = 0; mt < 2; ++mt)
#pragma unroll
      for (int jj = 0; jj < 4; ++jj) gtA[mt][jj] = gtN[mt][jj];
    { const int hn2 = hn < 5 ? hn + 1 : 5; A_LOAD(hn2); }
#pragma unroll
    for (int d = 0; d < 2; ++d) {
      const bf16x8 (&wr)[2] = wrA[d]; const bf16x8 (&wi)[2] = wiA[d];
      const size_t cidx = ((size_t)(b * 2 + d) * ACH + sc) * 384;
      const float br = brA[d], bi = biA[d], sp = spA[d];
      float hc = hcA[d], Pc = 1.f;
      const int lq = d ? 3 - quad : quad;
      const int s1 = d ? ((lane + 16) & 63) : ((lane - 16) & 63), s2 = d ? ((lane + 32) & 63) : ((lane - 32) & 63);
      const int lastl = d ? l15 : 48 + l15;
#pragma unroll
      for (int mi = 0; mi < 2; ++mi) {
        const int mt = d ? 1 - mi : mi;
        bf16x8 a0 = *(const bf16x8*)(xcb + (mt * 16 + l15) * 392 + h * 48 + quad * 8);
        bf16x8 a1 = {0, 0, 0, 0, 0, 0, 0, 0};
        if (quad < 2) a1 = *(const bf16x8*)(xcb + (mt * 16 + l15) * 392 + h * 48 + 32 + quad * 8);
        f32x4 ra = {0.f, 0.f, 0.f, 0.f}, ia = {0.f, 0.f, 0.f, 0.f};
        ra = mfma16(a0, wr[0], ra); ra = mfma16(a1, wr[1], ra);
        ia = mfma16(a0, wi[0], ia); ia = mfma16(a1, wi[1], ia);
        float av[4], uv[4];
#pragma unroll
        for (int jj = 0; jj < 4; ++jj) {
          const int tok = mt * 16 + quad * 4 + jj;
          const float xv = xcf[tok * 388 + ch];
          const float r = sigm(ra[jj] + br), ig = sigm(ia[jj] + bi);
          const float la = -r * sp;
          av[jj] = __expf(la);
          uv[jj] = __builtin_amdgcn_sqrtf(fmaxf(1.f - av[jj] * av[jj], 0.f)) * ig * xv;
        }
        float P = 1.f, H = 0.f, pl[4], hl[4];
#pragma unroll
        for (int q = 0; q < 4; ++q) { const int jj = d ? 3 - q : q; H = av[jj] * H + uv[jj]; P *= av[jj]; pl[jj] = P; hl[jj] = H; }
        float Pi = P, Hi = H;
        { float Ps = __shfl(Pi, s1), Hs = __shfl(Hi, s1); if (lq >= 1) { Hi = Pi * Hs + Hi; Pi = Pi * Ps; } }
        { float Ps = __shfl(Pi, s2), Hs = __shfl(Hi, s2); if (lq >= 2) { Hi = Pi * Hs + Hi; Pi = Pi * Ps; } }
        const float Pt = __shfl(Pi, lastl), Ht = __shfl(Hi, lastl);
        if (fin) {
          float Pe = __shfl(Pi, s1), He = __shfl(Hi, s1);
          if (lq == 0) { Pe = 1.f; He = 0.f; }
          const float hin = Pe * hc + He;
#pragma unroll
          for (int jj = 0; jj < 4; ++jj) {
            const float hv = pl[jj] * hin + hl[jj];
            if (d == 0) hf[mt][jj] = hv;
            else {
              const size_t row = rowbase + t0 + mt * 16 + quad * 4 + jj;
              p.hbuf()[row * 1024 + ch] = f2bf((hf[mt][jj] + hv) * siluf(bf2f(gtA[mt][jj])));
            }
          }
        }
        if (!fin) {
          float Pe = __shfl(Pi, s1), He = __shfl(Hi, s1);
          if (lq == 0) { Pe = 1.f; He = 0.f; }
          const float hin = Pe * hc + He, pin = Pe * Pc;
#pragma unroll
          for (int jj = 0; jj < 4; ++jj) {
            const float hv = pl[jj] * hin + hl[jj], pc = pl[jj] * pin;
            if (d == 0) { hf[mt][jj] = hv; pfv[mt][jj] = pc; }
            else {
              const size_t row = rowbase + t0 + mt * 16 + quad * 4 + jj;
              *(uint2*)(p.apk() + (row * 384 + ch) * 4) = make_uint2(pack2(hf[mt][jj] + hv, pfv[mt][jj]), pack2(pc, 0.f));
            }
          }
        }
        hc = Pt * hc + Ht; Pc *= Pt;
      }
      if (!fin && quad == 0) *(float2*)(p.aPH() + (cidx + ch) * 2) = make_float2(Pc, hc);
    }
  }
  __syncthreads();
}

#undef A_LOAD
DEV void a_light_task(const Params& p, int l, int t64) {
  const int tid = tidx();
#pragma unroll 4
  for (int k = 0; k < 24; ++k) {
    const int idx = tid + 256 * k;
    const int rr = idx / 96, c4 = idx - rr * 96, ch0 = c4 * 4;
    const size_t row = (size_t)t64 * 64 + rr;
    int b, sc;
    if (row < (size_t)NLAT) { b = (int)(row >> 12); sc = 8 + (((int)row & 4095) >> 5); }
    else { const int r2 = (int)row - NLAT; b = r2 >> 8; sc = (r2 & 255) >> 5; }
    const uint4 q0 = *(const uint4*)(p.apk() + (row * 384 + ch0) * 4), q1 = *(const uint4*)(p.apk() + (row * 384 + ch0) * 4 + 8);
    const float4 cf = *(const float4*)(p.aCarry() + ((size_t)(b * 2 + 0) * ACH + sc) * 384 + ch0);
    const float4 cb = *(const float4*)(p.aCarry() + ((size_t)(b * 2 + 1) * ACH + sc) * 384 + ch0);
    const uint2 g = *(const uint2*)(p.pbuf() + row * NCOL + COL_AG + ch0);
    const float y0 = (bflo(q0.x) + bfhi(q0.x) * cf.x + bflo(q0.y) * cb.x) * siluf(bflo(g.x));
    const float y1 = (bflo(q0.z) + bfhi(q0.z) * cf.y + bflo(q0.w) * cb.y) * siluf(bfhi(g.x));
    const float y2 = (bflo(q1.x) + bfhi(q1.x) * cf.z + bflo(q1.y) * cb.z) * siluf(bflo(g.y));
    const float y3 = (bflo(q1.z) + bfhi(q1.z) * cf.w + bflo(q1.w) * cb.w) * siluf(bfhi(g.y));
    *(uint2*)(p.hbuf() + row * 1024 + ch0) = make_uint2(pack2(y0, y1), pack2(y2, y3));
  }
}

DEV void b_logf_scan(const Params& p, int l, int h, int d, const uint4 (&rawf)[3], float* Lf, float* GL, float* OFFp) {
  const int tid = tidx();
  float* SEG = OFFp + 768;
  const float* lbp = p.lbs() + l * 384 + h * 96;
#pragma unroll
  for (int it = 0; it < 3; ++it) {
    const int idx = tid + 256 * it, tok = idx / 12, g8 = idx % 12;
    float xs[8]; unpack8(rawf[it], xs);
    const float4 lb0 = *(const float4*)(lbp + g8 * 8), lb1 = *(const float4*)(lbp + g8 * 8 + 4);
    const float lbv[8] = {lb0.x, lb0.y, lb0.z, lb0.w, lb1.x, lb1.y, lb1.z, lb1.w};
#pragma unroll
    for (int e = 0; e < 8; ++e) { const float lb = lbv[e]; const float f = lb + (1.f - lb) * sigm(xs[e]); Lf[tok * 97 + g8 * 8 + e] = __logf(f); }
  }
  __syncthreads();
#pragma unroll
  for (int it = 0; it < 3; ++it) {
    const int item = tid + 256 * it, c = item % 96, sg = item / 96;
    float run = 0.f;
#pragma unroll
    for (int j = 0; j < 8; ++j) { const int pp = sg * 8 + j, tok = d ? 63 - pp : pp; run += Lf[tok * 97 + c]; Lf[tok * 97 + c] = run; }
    SEG[sg * 96 + c] = run;
  }
  __syncthreads();
#pragma unroll
  for (int it = 0; it < 3; ++it) {
    const int item = tid + 256 * it, c = item % 96, sg = item / 96;
    float off = 0.f;
#pragma unroll
    for (int s = 0; s < 7; ++s) { const float t = SEG[s * 96 + c]; off += (s < sg) ? t : 0.f; }
    OFFp[sg * 96 + c] = off;
    if (sg == 7) GL[c] = off + SEG[7 * 96 + c];
  }
  __syncthreads();
}

DEV void b_kv_task(const Params& p, int l, int task, char* smem) {
  const int n = task % BSL, s = task / BSL, d = s & 1, h = (s >> 1) & 3, b = s >> 3;
  size_t rowbase;
  if (n < 4) { int cj = d ? 3 - n : n; rowbase = (size_t)NLAT + b * LCTX + cj * 64; }
  else { int cj = d ? 63 - (n - 4) : n - 4; rowbase = (size_t)b * LSEQ + cj * 64; }
  float* Lf = (float*)smem; float* GL = Lf + 64 * 97;
  bf16_t* Kt = (bf16_t*)(smem + 25600);
  bf16_t* Vt = Kt + 96 * 72;
  float* OFFp = (float*)(smem + 53248);
  const int tid = tidx(), lane = tid & 63, wave = tid >> 6, quad = lane >> 4, l15 = lane & 15;
  const int fcol = (d ? COL_BFB : COL_BFF) + h * 96;
  uint4 rawf[3], rawv[3];
#pragma unroll
  for (int it = 0; it < 3; ++it) {
    const int idx = tid + 256 * it, tok = idx / 12, g8 = idx % 12;
    rawf[it] = *(const uint4*)(p.pbuf() + (rowbase + tok) * NCOL + fcol + g8 * 8);
    rawv[it] = *(const uint4*)(p.pbuf() + (rowbase + tok) * NCOL + COL_BI + h * 96 + g8 * 8);
  }
  b_logf_scan(p, l, h, d, rawf, Lf, GL, OFFp);
  const float* lbp = p.lbs() + l * 384 + h * 96;
#pragma unroll
  for (int it = 0; it < 3; ++it) {
    const int idx = tid + 256 * it, tok = idx / 12, g8 = idx % 12;
    const int pp = d ? 63 - tok : tok;
    float xs[8]; unpack8(rawf[it], xs);
    const unsigned vv[4] = {rawv[it].x, rawv[it].y, rawv[it].z, rawv[it].w};
    float kend[8];
    const float4 lb0 = *(const float4*)(lbp + g8 * 8), lb1 = *(const float4*)(lbp + g8 * 8 + 4);
    const float lbv[8] = {lb0.x, lb0.y, lb0.z, lb0.w, lb1.x, lb1.y, lb1.z, lb1.w};
#pragma unroll
    for (int e = 0; e < 8; ++e) {
      const int dk = g8 * 8 + e;
      const float lb = lbv[e];
      const float k = (1.f - lb) * (1.f - sigm(xs[e]));
      const float G = Lf[tok * 97 + dk] + OFFp[(pp >> 3) * 96 + dk];
      kend[e] = k * __expf(GL[dk] - G);
    }
    const unsigned kp[4] = {pack2(kend[0], kend[1]), pack2(kend[2], kend[3]), pack2(kend[4], kend[5]), pack2(kend[6], kend[7])};
    bf16_t* kd = Kt + g8 * 8 * 72 + tok; bf16_t* vd = Vt + g8 * 8 * 72 + tok;
    const int rot = g8 & 7;
#pragma unroll
    for (int e0 = 0; e0 < 8; ++e0) {
      const int e = (e0 + rot) & 7;
      const unsigned kw = (e & 2) ? ((e & 4) ? kp[3] : kp[1]) : ((e & 4) ? kp[2] : kp[0]);
      const unsigned vw = (e & 2) ? ((e & 4) ? vv[3] : vv[1]) : ((e & 4) ? vv[2] : vv[0]);
      kd[e * 72] = (bf16_t)((e & 1) ? (kw >> 16) : (kw & 0xffffu));
      vd[e * 72] = (bf16_t)((e & 1) ? (vw >> 16) : (vw & 0xffffu));
    }
  }
  if (tid < 96) p.decay()[(size_t)task * 96 + tid] = __expf(GL[tid]);
  __syncthreads();
  bf16_t* dst = p.kvbuf() + (size_t)task * 9216;
  for (int i = 0; i < 9; ++i) {
    const int ti = wave * 9 + i, mt = ti / 6, nt = ti % 6;
    f32x4 acc = {0.f, 0.f, 0.f, 0.f};
#pragma unroll
    for (int ks = 0; ks < 2; ++ks) {
      bf16x8 ka = *(const bf16x8*)(Kt + (nt * 16 + l15) * 72 + ks * 32 + quad * 8);
      bf16x8 vb = *(const bf16x8*)(Vt + (mt * 16 + l15) * 72 + ks * 32 + quad * 8);
      acc = mfma16(ka, vb, acc);
    }
    *(uint2*)(dst + (mt * 16 + l15) * 96 + nt * 16 + 4 * quad) = make_uint2(pack2(acc[0], acc[1]), pack2(acc[2], acc[3]));
  }
  __syncthreads();
}

DEV void b_state_scan(const Params& p, int gidx) {
  const int dk8 = gidx % 12, dv = (gidx / 12) % 96, s = gidx / 1152;
  bf16_t* base = p.kvbuf() + (size_t)s * BSL * 9216 + dv * 96 + dk8 * 8;
  const float* dec = p.decay() + (size_t)s * BSL * 96 + dk8 * 8;
  float S[8];
#pragma unroll
  for (int e = 0; e < 8; ++e) S[e] = 0.f;
  uint4 kv[4];
#pragma unroll
  for (int i = 0; i < 4; ++i) kv[i] = *(const uint4*)(base + (size_t)i * 9216);
#pragma unroll 1
  for (int n0 = 0; n0 < BSL; n0 += 4) {
    uint4 kvn[4]; float4 d0[4], d1[4];
#pragma unroll
    for (int i = 0; i < 4; ++i) { d0[i] = *(const float4*)(dec + (n0 + i) * 96); d1[i] = *(const float4*)(dec + (n0 + i) * 96 + 4); }
    {
      const int nn = (n0 + 4 < BSL) ? n0 + 4 : n0;
#pragma unroll
      for (int i = 0; i < 4; ++i) kvn[i] = *(const uint4*)(base + (size_t)(nn + i) * 9216);
    }
#pragma unroll
    for (int i = 0; i < 4; ++i) {
      *(uint4*)(base + (size_t)(n0 + i) * 9216) = make_uint4(pack2(S[0], S[1]), pack2(S[2], S[3]), pack2(S[4], S[5]), pack2(S[6], S[7]));
      float kf[8]; unpack8(kv[i], kf);
      S[0] = d0[i].x * S[0] + kf[0]; S[1] = d0[i].y * S[1] + kf[1]; S[2] = d0[i].z * S[2] + kf[2]; S[3] = d0[i].w * S[3] + kf[3];
      S[4] = d1[i].x * S[4] + kf[4]; S[5] = d1[i].y * S[5] + kf[5]; S[6] = d1[i].z * S[6] + kf[6]; S[7] = d1[i].w * S[7] + kf[7];
    }
#pragma unroll
    for (int i = 0; i < 4; ++i) kv[i] = kvn[i];
  }
}

DEV void a_carry_wave(const Params& p, int widx) {
  const int lane = tidx() & 63;
  const int ch = widx % 384, d = (widx / 384) & 1, b = widx / 768;
  const float2* ph = (const float2*)p.aPH() + (size_t)(b * 2 + d) * ACH * 384 + ch;
  float* cr = p.aCarry() + (size_t)(b * 2 + d) * ACH * 384 + ch;
  float P[3], H[3]; int scv[3]; bool valid[3];
#pragma unroll
  for (int j = 0; j < 3; ++j) {
    const int pos = lane * 3 + j;
    valid[j] = pos < ACH;
    scv[j] = d ? (pos < 8 ? 7 - pos : ACH - 1 - (pos - 8)) : pos;
    float2 v = make_float2(1.f, 0.f);
    if (valid[j]) v = ph[(size_t)scv[j] * 384];
    P[j] = v.x; H[j] = v.y;
  }
  float Pi = P[0], Hi = H[0];
  Hi = P[1] * Hi + H[1]; Pi *= P[1];
  Hi = P[2] * Hi + H[2]; Pi *= P[2];
#pragma unroll
  for (int o = 1; o < 64; o <<= 1) {
    const float Ps = __shfl_up(Pi, o), Hs = __shfl_up(Hi, o);
    if (lane >= o) { Hi = Pi * Hs + Hi; Pi = Pi * Ps; }
  }
  float He = __shfl_up(Hi, 1);
  if (lane == 0) He = 0.f;
  const float c0 = He, c1 = P[0] * c0 + H[0], c2 = P[1] * c1 + H[1];
  if (valid[0]) cr[(size_t)scv[0] * 384] = c0;
  if (valid[1]) cr[(size_t)scv[1] * 384] = c1;
  if (valid[2]) cr[(size_t)scv[2] * 384] = c2;
}

DEV void b_out_task(const Params& p, int l, int b, int h, int seg, int cj, char* smem) {
  const size_t rowbase = seg == 0 ? (size_t)NLAT + b * LCTX + cj * 64 : (size_t)b * LSEQ + cj * 64;
  float* Lf = (float*)smem; float* GL = Lf + 64 * 97;
  bf16_t* Qs = (bf16_t*)(smem + 25600);
  bf16_t* Ks = (bf16_t*)(smem + 38912);
  bf16_t* Vt = (bf16_t*)(smem + 52224);
  bf16_t* Sc = (bf16_t*)(smem + 66048);
  float* OFFp = (float*)(smem + 66048);
  const int tid = tidx(), lane = tid & 63, wave = tid >> 6, quad = lane >> 4, l15 = lane & 15;
  uint4 rawv[3], rawq[3], rawf0[3], rawf1[3];
#pragma unroll
  for (int it = 0; it < 3; ++it) {
    const int idx = tid + 256 * it, tok = idx / 12, g8 = idx % 12;
    const bf16_t* rp = p.pbuf() + (rowbase + tok) * NCOL + h * 96 + g8 * 8;
    rawv[it] = *(const uint4*)(rp + COL_BI); rawq[it] = *(const uint4*)(rp + COL_BQ);
    rawf0[it] = *(const uint4*)(rp + COL_BFF); rawf1[it] = *(const uint4*)(rp + COL_BFB);
  }
  bf16_t gt[4][6];
#pragma unroll
  for (int jj = 0; jj < 4; ++jj)
#pragma unroll
    for (int nt = 0; nt < 6; ++nt) gt[jj][nt] = p.pbuf()[(rowbase + wave * 16 + 4 * quad + jj) * NCOL + COL_BG + h * 96 + nt * 16 + l15];
#pragma unroll
  for (int it = 0; it < 3; ++it) {
    const int idx = tid + 256 * it, tok = idx / 12, g8 = idx % 12;
    const unsigned vv[4] = {rawv[it].x, rawv[it].y, rawv[it].z, rawv[it].w};
    bf16_t* vd = Vt + g8 * 8 * 72 + tok;
    const int rot = g8 & 7;
#pragma unroll
    for (int e0 = 0; e0 < 8; ++e0) {
      const int e = (e0 + rot) & 7;
      const unsigned vw = (e & 2) ? ((e & 4) ? vv[3] : vv[1]) : ((e & 4) ? vv[2] : vv[0]);
      vd[e * 72] = (bf16_t)((e & 1) ? (vw >> 16) : (vw & 0xffffu));
    }
  }
  f32x4 oacc[6];
#pragma unroll
  for (int nt = 0; nt < 6; ++nt) oacc[nt] = (f32x4){0.f, 0.f, 0.f, 0.f};
  const float* lbp = p.lbs() + l * 384 + h * 96;
#pragma unroll
  for (int d = 0; d < 2; ++d) {
    const int n = seg == 0 ? (d ? 3 - cj : cj) : 4 + (d ? 63 - cj : cj);
    const size_t stream = (size_t)(b * 4 + h) * 2 + d;
    const bf16_t* St = p.kvbuf() + (stream * BSL + n) * 9216;
    b_logf_scan(p, l, h, d, d ? rawf1 : rawf0, Lf, GL, OFFp);
#pragma unroll
    for (int it = 0; it < 3; ++it) {
      const int idx = tid + 256 * it, tok = idx / 12, g8 = idx % 12;
      const int pp = d ? 63 - tok : tok;
      float xs[8], qs[8], qg[8], kg[8]; unpack8(d ? rawf1[it] : rawf0[it], xs); unpack8(rawq[it], qs);
      const float4 lb0 = *(const float4*)(lbp + g8 * 8), lb1 = *(const float4*)(lbp + g8 * 8 + 4);
      const float lbv[8] = {lb0.x, lb0.y, lb0.z, lb0.w, lb1.x, lb1.y, lb1.z, lb1.w};
#pragma unroll
      for (int e = 0; e < 8; ++e) {
        const int dk = g8 * 8 + e;
        const float lb = lbv[e];
        const float k = (1.f - lb) * (1.f - sigm(xs[e]));
        const float G = Lf[tok * 97 + dk] + OFFp[(pp >> 3) * 96 + dk];
        qg[e] = siluf(qs[e]) * __expf(G);
        kg[e] = k * __expf(-G);
      }
      *(uint4*)(Qs + tok * 104 + g8 * 8) = make_uint4(pack2(qg[0], qg[1]), pack2(qg[2], qg[3]), pack2(qg[4], qg[5]), pack2(qg[6], qg[7]));
      *(uint4*)(Ks + tok * 104 + g8 * 8) = make_uint4(pack2(kg[0], kg[1]), pack2(kg[2], kg[3]), pack2(kg[4], kg[5]), pack2(kg[6], kg[7]));
    }
    __syncthreads();
    bf16x8 qa[3];
#pragma unroll
    for (int ks = 0; ks < 3; ++ks) qa[ks] = *(const bf16x8*)(Qs + (wave * 16 + l15) * 104 + ks * 32 + quad * 8);
    bf16x8 sfr[6][3];
#pragma unroll
    for (int nt = 0; nt < 6; ++nt)
#pragma unroll
      for (int ks = 0; ks < 3; ++ks) sfr[nt][ks] = *(const bf16x8*)(St + (nt * 16 + l15) * 96 + ks * 32 + quad * 8);
#pragma unroll
    for (int nt = 0; nt < 4; ++nt) {
      f32x4 acc = {0.f, 0.f, 0.f, 0.f};
#pragma unroll
      for (int ks = 0; ks < 3; ++ks) acc = mfma16(qa[ks], *(const bf16x8*)(Ks + (nt * 16 + l15) * 104 + ks * 32 + quad * 8), acc);
      int cb_ = wave * 16 + 4 * quad - nt * 16 - l15;
      asm volatile("" : "+v"(cb_));
      if (d) cb_ = -cb_;
#pragma unroll
      for (int jj = 0; jj < 4; ++jj) {
        const int cc = wave * 16 + 4 * quad + jj, ss = nt * 16 + l15;
        const int df = d ? cb_ - jj : cb_ + jj;
        Sc[cc * 72 + ss] = f2bf(df >= 0 ? acc[jj] : 0.f);
      }
    }
    __syncthreads();
    bf16x8 sa[2];
#pragma unroll
    for (int ks = 0; ks < 2; ++ks) sa[ks] = *(const bf16x8*)(Sc + (wave * 16 + l15) * 72 + ks * 32 + quad * 8);
#pragma unroll
    for (int nt = 0; nt < 6; ++nt) {
#pragma unroll
      for (int ks = 0; ks < 2; ++ks) oacc[nt] = mfma16(sa[ks], *(const bf16x8*)(Vt + (nt * 16 + l15) * 72 + ks * 32 + quad * 8), oacc[nt]);
#pragma unroll
      for (int ks = 0; ks < 3; ++ks) oacc[nt] = mfma16(qa[ks], sfr[nt][ks], oacc[nt]);
    }
  }
  const float* gw = p.sp() + SP_BNW + l * 384 + h * 96;
  float gwv[6];
#pragma unroll
  for (int nt = 0; nt < 6; ++nt) gwv[nt] = gw[nt * 16 + l15];
#pragma unroll
  for (int jj = 0; jj < 4; ++jj) {
    float ss = 0.f;
#pragma unroll
    for (int nt = 0; nt < 6; ++nt) ss += oacc[nt][jj] * oacc[nt][jj];
    ss = row_sum16(ss);
    const float rstd = rsqrtf(ss * (1.f / 96.f) + EPSV);
    const size_t row = rowbase + wave * 16 + 4 * quad + jj;
#pragma unroll
    for (int nt = 0; nt < 6; ++nt) {
      const int dv = nt * 16 + l15;
      p.hbuf()[row * 1024 + 384 + h * 96 + dv] = f2bf(oacc[nt][jj] * rstd * gwv[nt] * siluf(bf2f(gt[jj][nt])));
    }
  }
  __syncthreads();
}

DEV void c_task(const Params& p, int l, size_t rowbase, char* smem) {
  bf16_t* Vt = (bf16_t*)smem;
  const int tid = tidx(), lane = tid & 63, wave = tid >> 6, quad = lane >> 4, l15 = lane & 15;
  {
    const float* cnw = p.sp() + SP_CNW + l * 256 + l15 * 16;
    const int sub = lane >> 4;
    float nwv[16];
#pragma unroll
    for (int i = 0; i < 4; ++i) { const float4 t = *(const float4*)(cnw + 4 * i); nwv[4 * i] = t.x; nwv[4 * i + 1] = t.y; nwv[4 * i + 2] = t.z; nwv[4 * i + 3] = t.w; }
#pragma unroll 1
    for (int g0 = 0; g0 < 8; g0 += 4) {
      uint4 r0[4], r1[4];
#pragma unroll
      for (int g = 0; g < 4; ++g) {
        const bf16_t* src = p.pbuf() + (rowbase + wave * 32 + (g0 + g) * 4 + sub) * NCOL + COL_CV + l15 * 16;
        r0[g] = *(const uint4*)src; r1[g] = *(const uint4*)(src + 8);
      }
#pragma unroll
      for (int g = 0; g < 4; ++g) {
        const int tok = wave * 32 + (g0 + g) * 4 + sub;
        float v[16]; unpack8(r0[g], v); unpack8(r1[g], v + 8);
        float s = 0.f;
#pragma unroll
        for (int i = 0; i < 16; ++i) { v[i] = geluf(v[i]); s += v[i]; }
        s = row_sum16(s);
        const float mu = s * (1.f / 256.f);
        float q = 0.f;
#pragma unroll
        for (int i = 0; i < 16; ++i) { v[i] -= mu; q += v[i] * v[i]; }
        q = row_sum16(q);
        const float rstd = rsqrtf(q * (1.f / 256.f) + EPSV);
        bf16_t* dstp = Vt + (l15 * 16) * 136 + ((((tok >> 3) ^ l15) & 15) << 3) + (tok & 7);
#pragma unroll
        for (int i = 0; i < 16; ++i) dstp[i * 136] = f2bf(v[i] * rstd * nwv[i]);
      }
    }
  }
  __syncthreads();
  const int h = wave;
  const bf16_t* ws = p.cws() + ((size_t)l * 4 + h) * 128 * 128;
  const float* bs = p.sp() + SP_CBS + (l * 4 + h) * 128;
  for (int mt = 0; mt < 8; ++mt) {
    bf16_t ur[4][4], gr[4][4]; float bias[4];
#pragma unroll
    for (int jj = 0; jj < 4; ++jj) {
      const size_t row = rowbase + mt * 16 + 4 * quad + jj;
      bias[jj] = bs[mt * 16 + 4 * quad + jj];
#pragma unroll
      for (int nt = 0; nt < 4; ++nt) {
        const int ch = h * 64 + nt * 16 + l15;
        ur[jj][nt] = p.pbuf()[row * NCOL + COL_CU + ch];
        gr[jj][nt] = p.pbuf()[row * NCOL + COL_CG + ch];
      }
    }
    f32x4 acc[4];
#pragma unroll
    for (int nt = 0; nt < 4; ++nt) acc[nt] = (f32x4){0.f, 0.f, 0.f, 0.f};
#pragma unroll
    for (int ks = 0; ks < 4; ++ks) {
      const bf16x8 wfrag = *(const bf16x8*)(ws + (mt * 16 + l15) * 128 + ks * 32 + quad * 8);
#pragma unroll
      for (int nt = 0; nt < 4; ++nt) acc[nt] = mfma16(wfrag, *(const bf16x8*)(Vt + (h * 64 + nt * 16 + l15) * 136 + ((((ks * 4 + quad) ^ (h * 4 + nt)) & 15) << 3)), acc[nt]);
    }
#pragma unroll
    for (int jj = 0; jj < 4; ++jj) {
      const size_t row = rowbase + mt * 16 + 4 * quad + jj;
#pragma unroll
      for (int nt = 0; nt < 4; ++nt) {
        const int ch = h * 64 + nt * 16 + l15;
        p.hbuf()[row * 1024 + 768 + ch] = f2bf(geluf(bf2f(ur[jj][nt])) * (acc[nt][jj] + bias[jj]) * siluf(bf2f(gr[jj][nt])));
      }
    }
  }
  __syncthreads();
}

#ifndef TIMING
#define TIMING 0
#endif
#if TIMING
#define TSH ((unsigned long long*)(smem + 76000))
#define TT_BEGIN() unsigned long long tt0_ = 0; if (bid == 0 && tidx() == 0) tt0_ = __builtin_amdgcn_s_memrealtime();
#define TT_END(code) if (bid == 0 && tidx() == 0) { unsigned long long d_ = __builtin_amdgcn_s_memrealtime() - tt0_; if ((code) == TIMING_A) TSH[1] += d_; if ((code) == TIMING_B) TSH[2] += d_; }
#else
#define TT_BEGIN()
#define TT_END(code)
#endif
#ifndef DBG_SUB
#define DBG_SUB 7
#endif
DEV void phase_m1(const Params& p, int l, int bid, int nblk, char* smem) {
  const int nC = (l == 0) ? 272 : 256;
  const int nBk = NB * 4 * 2 * BSL;
  const int nA = NB * ACH;
  const int NT = nC + nBk + nA;
  for (int task = bid; task < NT; task += nblk) {
    int t = task;
    if (t < nC) {
      size_t rowbase = (t < 256) ? (size_t)(t >> 5) * LSEQ + (t & 31) * 128 : (size_t)NLAT + ((t - 256) >> 1) * LCTX + ((t - 256) & 1) * 128;
      TT_BEGIN(); if (DBG_SUB & 1) c_task(p, l, rowbase, smem); TT_END(10);
      continue;
    }
    t -= nC;
    if (t < nBk) { TT_BEGIN(); if (DBG_SUB & 2) b_kv_task(p, l, t, smem); TT_END(11); continue; }
    t -= nBk;
    { TT_BEGIN(); if (DBG_SUB & 4) a_chunk(p, l, t / ACH, t % ACH, false, smem); TT_END(12); }
  }
}

DEV void phase_m2(const Params& p, int l, int bid, int nblk, char* smem) {
  constexpr int TT = 64 * 96 * 12;
  const int chunk = (TT + nblk - 1) / nblk;
  const int g_end = (bid + 1) * chunk < TT ? (bid + 1) * chunk : TT;
  for (int g = bid * chunk + tidx(); g < g_end; g += 256) b_state_scan(p, g);
  constexpr int NAB = 1536;
  for (int task = bid; task < NAB; task += nblk) a_carry_wave(p, task * 4 + (tidx() >> 6));
}

DEV void phase_m3(const Params& p, int l, int bid, int nblk, char* smem) {
  const int nB = (l == 0) ? 2048 + 128 : 2048;
  const int nA = (l == 0) ? MROWS / 64 : NLAT / 64;
  for (int task = bid; task < nB + nA; task += nblk) {
    int t = task;
    if (t < nB) {
      if (!(DBG_SUB & 2)) continue;
      TT_BEGIN();
      if (t < 2048) b_out_task(p, l, t >> 8, (t >> 6) & 3, 1, t & 63, smem);
      else { int i2 = t - 2048; b_out_task(p, l, i2 >> 4, (i2 >> 2) & 3, 0, i2 & 3, smem); }
      TT_END(13);
      continue;
    }
    t -= nB;
    if (!(DBG_SUB & 4)) continue;
    TT_BEGIN();
    a_light_task(p, l, t);
    TT_END(14);
  }
}

#ifndef DBG_MASK
#define DBG_MASK 0xff
#endif
DEV void run_phase(const Params& p, int ph, int l, int bid, int nblk, char* smem) {
  if (!((DBG_MASK >> ph) & 1)) return;
  switch (ph) {
    case 0: phase_prep(p, bid, nblk, smem); break;
    case 1: phase_norm(p, l, bid, nblk); break;
    case 2: {
      const int full = (((MROWS / 256) * (NCOL / 128) + 7) >> 3) / (nblk >> 3);
      phase_gemm_big(p, p.hbuf(), p.wtin() + (size_t)l * NCOL * 1024, MROWS, NCOL, smem, bid, nblk, full);
      phase_gemm<0, 1>(p, l, p.hbuf(), p.wtin() + (size_t)l * NCOL * 1024, MROWS, NCOL, smem, bid, nblk, full);
      break; }
    case 3: phase_m1(p, l, bid, nblk, smem); break;
    case 4: phase_m2(p, l, bid, nblk, smem); break;
    case 5: phase_m3(p, l, bid, nblk, smem); break;
    case 6: phase_gemm<1>(p, l, p.hbuf(), p.wtout() + (size_t)l * 1024 * 1024, (l == 0) ? MROWS : NLAT, 1024, smem, bid, nblk); break;
    default: phase_final(p, bid, nblk); break;
  }
}

#define XB_TMO      128
#define XB_XCNT(j)  (256  + 64 * (j))
#define XB_XSUB(j)  (1280 + 64 * (j))
#define XB_XGEN(j)  (2304 + 64 * (j))
#define XB_TOP      3328
#define XB_TOPGEN   3392
#define XCD_BAR_WORDS 3456
#define XB_SPIN_CAP (1u << 18)
#define LAS __attribute__((address_space(3)))

__device__ __forceinline__ unsigned xb_ld(unsigned* p)              { return __hip_atomic_load(p, __ATOMIC_RELAXED, __HIP_MEMORY_SCOPE_AGENT); }
__device__ __forceinline__ unsigned xb_add(unsigned* p, unsigned v) { return __hip_atomic_fetch_add(p, v, __ATOMIC_RELAXED, __HIP_MEMORY_SCOPE_AGENT); }
__device__ __forceinline__ unsigned xb_xcc_id() { return (unsigned)__builtin_amdgcn_s_getreg((3 << 11) | 20) & 0xFu; }
#define XB_SPIN(cond, bar) do { unsigned _sp = 0; while (cond) { __builtin_amdgcn_s_sleep(1); \
    if ((++_sp & 255u) == 0u) { if (xb_ld(&(bar)[XB_TMO])) break; if (_sp > XB_SPIN_CAP) { atomicAdd(&(bar)[XB_TMO], 1u); break; } } } } while (0)

struct XcdBarrier {
    unsigned* bar; unsigned x;
    volatile LAS unsigned* st;
};

__device__ __forceinline__ XcdBarrier xcd_barrier_post(unsigned* bar, volatile LAS unsigned* st) {
    XcdBarrier b; b.bar = bar; b.x = xb_xcc_id(); b.st = st;
    if (threadIdx.x == 0) (void)xb_add(&bar[XB_XCNT(b.x)], 1u);
    return b;
}
__device__ __forceinline__ void xcd_barrier_complete(unsigned* bar, unsigned x, unsigned& nloc, unsigned& nx) {
    const unsigned G = gridDim.x * gridDim.y * gridDim.z;
    unsigned sum, cnt, mine, sp = 0u;
    for (;;) {
        sum = 0u; cnt = 0u; mine = 0u;
#pragma unroll
        for (unsigned j = 0; j < 16; ++j) { const unsigned c = xb_ld(&bar[XB_XCNT(j)]); sum += c; cnt += (c > 0u) ? 1u : 0u; mine = (j == x) ? c : mine; }
        if (sum == G) break;
        __builtin_amdgcn_s_sleep(1);
        if ((++sp & 255u) == 0u) { if (xb_ld(&bar[XB_TMO])) break; if (sp > XB_SPIN_CAP) { atomicAdd(&bar[XB_TMO], 1u); break; } }
    }
    nloc = mine > 0u ? mine : 1u; nx = cnt > 0u ? cnt : 1u;
}

__device__ __forceinline__ void xcd_barrier(const XcdBarrier& b) {
    asm volatile("s_waitcnt vmcnt(0)" ::: "memory");
    __syncthreads();
    if (threadIdx.x == 0) {
        unsigned* bar = b.bar;
        __builtin_amdgcn_s_waitcnt(0);
        unsigned nloc = b.st[0], nx = b.st[1];
        if (nloc == 0u) { xcd_barrier_complete(bar, b.x, nloc, nx); b.st[0] = nloc; b.st[1] = nx; }
        const unsigned old = xb_add(&bar[XB_XSUB(b.x)], 1u);
        const unsigned gen = old / nloc;
        if (old + 1u == (gen + 1u) * nloc) {
            __builtin_amdgcn_fence(__ATOMIC_RELEASE, "agent");
            asm volatile("s_waitcnt vmcnt(0)" ::: "memory");
            const unsigned og = xb_add(&bar[XB_TOP], 1u);
            const unsigned tg = og / nx;
            if (og + 1u == (tg + 1u) * nx) xb_add(&bar[XB_TOPGEN], 1u);
            else XB_SPIN(xb_ld(&bar[XB_TOPGEN]) == tg, bar);
            __builtin_amdgcn_fence(__ATOMIC_ACQUIRE, "agent");
            xb_add(&bar[XB_XGEN(b.x)], 1u);
            asm volatile("s_waitcnt vmcnt(0)" ::: "memory");
        } else {
            XB_SPIN(xb_ld(&bar[XB_XGEN(b.x)]) == gen, bar);
            __builtin_amdgcn_fence(__ATOMIC_ACQUIRE, "agent");
            asm volatile("s_waitcnt vmcnt(0)" ::: "memory");
        }
    }
    __syncthreads();
}


#if MEGA
__global__ void __launch_bounds__(256, 2) mega_kernel(Params p) {
  __shared__ __attribute__((aligned(16))) char smem[SMEM_BYTES];
  __shared__ uint4 xb_words;
  cg::grid_group grid = cg::this_grid();
  const int bid = blockIdx.x, nblk = gridDim.x;
  if (threadIdx.x == 0) xb_words = make_uint4(0u, 0u, 0u, 0u);
  __syncthreads();
  XcdBarrier xb = xcd_barrier_post((unsigned*)(p.ws + OFF_BAR), (volatile LAS unsigned*)&xb_words);
#if TIMING
  if (tidx() == 0) { TSH[0] = __builtin_amdgcn_s_memrealtime(); TSH[1] = 0; TSH[2] = 0; }
#define TICK(ph) { if (tidx() == 0) { unsigned long long tn = __builtin_amdgcn_s_memrealtime(); if ((ph) == TIMING_A) TSH[1] += tn - TSH[0]; if ((ph) == TIMING_B) TSH[2] += tn - TSH[0]; TSH[0] = tn; } }
#else
#define TICK(ph)
#endif
  if (p.ws == nullptr) grid.sync();
  run_phase(p, 0, 0, bid, nblk, smem);
  xcd_barrier(xb);
  TICK(0)
#define PH(ph, l) run_phase(p, ph, l, bid, nblk, smem); xcd_barrier(xb); TICK(ph)
  PH(1, 0) PH(2, 0) PH(3, 0) PH(4, 0) PH(5, 0) PH(6, 0)
  PH(1, 1) PH(2, 1) PH(3, 1) PH(4, 1) PH(5, 1) PH(6, 1)
#undef PH
  run_phase(p, 7, 0, bid, nblk, smem);
#if TIMING
  grid.sync();
  TICK(7)
  __syncthreads();
  if (bid == 0) {
    const float ta = (float)(TSH[1]) * 1e-5f, tb = (float)(TSH[2]) * 1e-5f;
    if (tidx() == 0) p.out[0] += 0.5f * ta;
    for (int i = tidx(); i < 65536; i += 256) p.out[1024 + i] += 0.5f * tb;
  }
#endif
}
#else
__global__ void __launch_bounds__(256, 2) phase_kernel(Params p, int ph, int l) {
  __shared__ __attribute__((aligned(16))) char smem[SMEM_BYTES];
  run_phase(p, ph, l, blockIdx.x, gridDim.x, smem);
}
#endif

extern "C" void kernel_launch(void* const* d_in, const int* in_sizes, int n_in, void* d_out, int out_size, void* d_ws, size_t ws_size,
                              hipStream_t stream) {
  Params p{};
  const float** f = (const float**)&p;
  for (int i = 0; i < 22; ++i) f[i] = (const float*)d_in[i];
  p.out = (float*)d_out;
  p.ws = (char*)d_ws;
  if (WS_TOTAL > ws_size) { fprintf(stderr, "workspace too small: need %zu have %zu\n", (size_t)WS_TOTAL, ws_size); return; }
#if MEGA
  static int grid_blocks = 0;
  if (!grid_blocks) {
    int dev = 0, cus = 0, per_cu = 0;
    hipGetDevice(&dev);
    hipDeviceGetAttribute(&cus, hipDeviceAttributeMultiprocessorCount, dev);
    hipOccupancyMaxActiveBlocksPerMultiprocessor(&per_cu, mega_kernel, 256, 0);
    if (per_cu > 2) per_cu = 2;
    if (per_cu < 1) per_cu = 1;
    grid_blocks = cus * per_cu;
  }
  (void)hipMemsetAsync(p.ws + OFF_BAR, 0, BAR_BYTES, stream);
  void* args[] = {&p};
  hipError_t e = hipLaunchCooperativeKernel((void*)mega_kernel, dim3(grid_blocks), dim3(256), args, 0, stream);
  if (e != hipSuccess) fprintf(stderr, "cooperative launch failed: %s (grid %d)\n", hipGetErrorString(e), grid_blocks);
#else
  const int G = 1024;
  phase_kernel<<<G, 256, 0, stream>>>(p, 0, 0);
  for (int l = 0; l < 2; ++l)
    for (int ph = 1; ph <= 6; ++ph) phase_kernel<<<G, 256, 0, stream>>>(p, ph, l);
  phase_kernel<<<G, 256, 0, stream>>>(p, 7, 0);
#endif
}
```

```cpp
#include <hip/hip_runtime.h>
#include <hip/hip_cooperative_groups.h>
#include <cstdio>
namespace cg = cooperative_groups;

#ifndef MEGA
#define MEGA 1
#endif

#define DEV __device__ __forceinline__
typedef unsigned short bf16_t;
typedef short bf16x8 __attribute__((ext_vector_type(8)));
typedef float f32x4 __attribute__((ext_vector_type(4)));

constexpr int NB = 8, LSEQ = 4096, LCTX = 256, DM = 1024, NCOL = 3456;
constexpr int NLAT = NB * LSEQ, NCTXR = NB * LCTX, MROWS = NLAT + NCTXR;
constexpr int COL_AX = 0, COL_AG = 384, COL_BQ = 768, COL_BFF = 1152, COL_BFB = 1536, COL_BI = 1920, COL_BG = 2304,
              COL_CU = 2688, COL_CV = 2944, COL_CG = 3200;
constexpr int ACH = 136;
constexpr int BSL = 68;
constexpr int SMEM_BYTES = 76800;
constexpr float EPSV = 1e-6f;

constexpr size_t al256(size_t x) { return (x + 255) & ~(size_t)255; }
constexpr size_t OFF_WTIN = 0;
constexpr size_t OFF_WTOUT = OFF_WTIN + al256((size_t)2 * NCOL * 1024 * 2);
constexpr size_t OFF_GATEPACK = OFF_WTOUT + al256((size_t)2 * 1024 * 1024 * 2);
constexpr size_t OFF_HBUF = OFF_GATEPACK + al256((size_t)64 * 3072 * 2);
constexpr size_t OFF_PBUF = OFF_HBUF + al256((size_t)MROWS * 1024 * 2);
constexpr size_t OFF_KVBUF = OFF_PBUF + al256((size_t)MROWS * NCOL * 2);
constexpr size_t OFF_MOD = OFF_KVBUF + al256((size_t)64 * BSL * 9216 * 2);
constexpr size_t OFF_LBS = OFF_MOD + al256((size_t)2 * 9 * 3072 * 4);
constexpr size_t OFF_POSTAB = OFF_LBS + al256((size_t)3 * 384 * 4);
constexpr size_t OFF_CTXRES = OFF_POSTAB + al256((size_t)64 * 512 * 4);
constexpr size_t OFF_DECAY = OFF_CTXRES + al256((size_t)NCTXR * 1024 * 4);
constexpr size_t OFF_APH = OFF_DECAY + al256((size_t)64 * BSL * 96 * 4);
constexpr size_t OFF_ACARRY = OFF_APH + al256((size_t)NB * 2 * ACH * 384 * 2 * 4);
constexpr size_t OFF_SP = OFF_ACARRY + al256((size_t)NB * 2 * ACH * 384 * 4);
constexpr int SP_NORM_W = 0, SP_CONV_W = 2048, SP_CONV_B = 5120, SP_BR = 5888, SP_BI = 7424, SP_ASP = 8960, SP_BNW = 10496,
              SP_CNW = 11264, SP_CBS = 11776, SP_FNW = 12800, SP_TOTAL = 13824;
constexpr size_t OFF_CWS = OFF_SP + al256((size_t)SP_TOTAL * 4);
constexpr size_t OFF_BAR = OFF_CWS + al256((size_t)2 * 4 * 128 * 128 * 2);
constexpr size_t BAR_BYTES = 3456 * 4;
constexpr size_t OFF_X16 = OFF_BAR + al256(BAR_BYTES);
constexpr size_t WS_TOTAL = OFF_X16 + al256((size_t)NLAT * 1024 * 2);
static_assert(WS_TOTAL <= (size_t)512 * 1024 * 1024, "workspace budget");

struct Params {
  const float *x, *c, *ctx, *c_ctx, *norm_w, *w_mod, *b_mod, *w_in, *a_conv_w, *a_conv_b, *a_wr, *a_br, *a_wi, *a_bi,
      *a_lambda, *b_lb_logits, *b_norm_w, *c_norm_w, *c_ws, *c_bs, *w_out, *final_norm_w;
  float* out;
  char* ws;
  DEV bf16_t* wtin() const { return (bf16_t*)(ws + OFF_WTIN); }
  DEV bf16_t* wtout() const { return (bf16_t*)(ws + OFF_WTOUT); }
  DEV bf16_t* gatepack() const { return (bf16_t*)(ws + OFF_GATEPACK); }
  DEV bf16_t* hbuf() const { return (bf16_t*)(ws + OFF_HBUF); }
  DEV bf16_t* pbuf() const { return (bf16_t*)(ws + OFF_PBUF); }
  DEV bf16_t* kvbuf() const { return (bf16_t*)(ws + OFF_KVBUF); }
  DEV float* mod() const { return (float*)(ws + OFF_MOD); }
  DEV float* lbs() const { return (float*)(ws + OFF_LBS); }
  DEV float* postab() const { return (float*)(ws + OFF_POSTAB); }
  DEV float* ctxres() const { return (float*)(ws + OFF_CTXRES); }
  DEV float* decay() const { return (float*)(ws + OFF_DECAY); }
  DEV float* aPH() const { return (float*)(ws + OFF_APH); }
  DEV float* aCarry() const { return (float*)(ws + OFF_ACARRY); }
  DEV float* sp() const { return (float*)(ws + OFF_SP); }
  DEV bf16_t* cws() const { return (bf16_t*)(ws + OFF_CWS); }
  DEV bf16_t* x16() const { return (bf16_t*)(ws + OFF_X16); }
  DEV bf16_t* apk() const { return (bf16_t*)out; }
};

typedef __bf16 bf2_t __attribute__((ext_vector_type(2)));
typedef float f2_t __attribute__((ext_vector_type(2)));
DEV unsigned pack2(float lo, float hi) { f2_t v = {lo, hi}; bf2_t b = __builtin_convertvector(v, bf2_t); return __builtin_bit_cast(unsigned, b); }
DEV bf16_t f2bf(float f) { __bf16 b = (__bf16)f; return __builtin_bit_cast(unsigned short, b); }
DEV float bflo(unsigned u) { return __uint_as_float(u << 16); }
DEV float bfhi(unsigned u) { return __uint_as_float(u & 0xffff0000u); }
DEV float bf2f(bf16_t h) { return __uint_as_float(((unsigned)h) << 16); }
DEV void unpack8(const uint4& r, float* o) {
  o[0] = bflo(r.x); o[1] = bfhi(r.x); o[2] = bflo(r.y); o[3] = bfhi(r.y);
  o[4] = bflo(r.z); o[5] = bfhi(r.z); o[6] = bflo(r.w); o[7] = bfhi(r.w);
}
DEV float frcp(float x) { return __builtin_amdgcn_rcpf(x); }
DEV float sigm(float x) { return frcp(1.f + __expf(-x)); }
DEV float siluf(float x) { return x * frcp(1.f + __expf(-x)); }
DEV float geluf(float x) { float z = 1.5957691216f * (x + 0.044715f * x * x * x); return x * frcp(1.f + __expf(-z)); }
DEV f32x4 mfma16(bf16x8 a, bf16x8 b, f32x4 c) { return __builtin_amdgcn_mfma_f32_16x16x32_bf16(a, b, c, 0, 0, 0); }
DEV float row_sum16(float v) {
  v += __builtin_bit_cast(float, __builtin_amdgcn_update_dpp(0, __builtin_bit_cast(int, v), 0xB1, 0xf, 0xf, false));
  v += __builtin_bit_cast(float, __builtin_amdgcn_update_dpp(0, __builtin_bit_cast(int, v), 0x4E, 0xf, 0xf, false));
  v += __builtin_bit_cast(float, __builtin_amdgcn_update_dpp(0, __builtin_bit_cast(int, v), 0x124, 0xf, 0xf, false));
  v += __builtin_bit_cast(float, __builtin_amdgcn_update_dpp(0, __builtin_bit_cast(int, v), 0x128, 0xf, 0xf, false));
  return v;
}
DEV int tidx() { int t = threadIdx.x; asm volatile("" : "+v"(t)); return t; }
DEV float wave_sum(float v) {
#pragma unroll
  for (int o = 32; o > 0; o >>= 1) v += __shfl_xor(v, o);
  return v;
}

DEV void prep_mod(const Params& p, int task, char* smem) {
  const int l = task / 192, j0 = (task % 192) * 16, tid = tidx();
  float* sv = (float*)smem;
  float* red = sv + 9 * 1024;
  for (int i = tid; i < 9 * 1024; i += 256) { int r = i >> 10, k = i & 1023; float v = (r < 8) ? p.c[r * 1024 + k] : p.c_ctx[k]; sv[i] = siluf(v); }
  __syncthreads();
  const int kg = tid >> 4, col = tid & 15;
  float acc[9];
#pragma unroll
  for (int r = 0; r < 9; ++r) acc[r] = 0.f;
  const float* w = p.w_mod + (size_t)l * 1024 * 3072 + j0 + col;
#pragma unroll 1
  for (int k = kg * 64; k < kg * 64 + 64; k += 16) {
    float wv[16];
#pragma unroll
    for (int u = 0; u < 16; ++u) wv[u] = w[(size_t)(k + u) * 3072];
#pragma unroll
    for (int u = 0; u < 16; ++u)
#pragma unroll
      for (int r = 0; r < 9; ++r) acc[r] += sv[r * 1024 + k + u] * wv[u];
  }
#pragma unroll
  for (int r = 0; r < 9; ++r) red[(kg * 9 + r) * 16 + col] = acc[r];
  __syncthreads();
  if (tid < 144) {
    int r = tid >> 4, cc = tid & 15; float s = 0.f;
#pragma unroll
    for (int g = 0; g < 16; ++g) s += red[(g * 9 + r) * 16 + cc];
    p.mod()[(l * 9 + r) * 3072 + j0 + cc] = s + p.b_mod[l * 3072 + j0 + cc];
  }
  __syncthreads();
}

DEV void prep_transpose(const float* __restrict__ src, bf16_t* __restrict__ dst, int N, int kt, int nt, char* smem) {
  float* tile = (float*)smem;
  const int tid = tidx(), r = tid >> 4, c4 = tid & 15;
#pragma unroll
  for (int i = 0; i < 4; ++i) {
    float4 v = *(const float4*)(src + (size_t)(kt * 64 + r + 16 * i) * N + nt * 64 + c4 * 4);
    float* t = tile + (r + 16 * i) * 65 + c4 * 4;
    t[0] = v.x; t[1] = v.y; t[2] = v.z; t[3] = v.w;
  }
  __syncthreads();
  const int n = tid >> 2, kq = tid & 3;
  unsigned o[8];
#pragma unroll
  for (int e = 0; e < 8; ++e) o[e] = pack2(tile[(kq * 16 + 2 * e) * 65 + n], tile[(kq * 16 + 2 * e + 1) * 65 + n]);
  uint4* d = (uint4*)(dst + (size_t)(nt * 64 + n) * 1024 + kt * 64 + kq * 16);
  d[0] = make_uint4(o[0], o[1], o[2], o[3]);
  d[1] = make_uint4(o[4], o[5], o[6], o[7]);
  __syncthreads();
}

DEV void phase_prep(const Params& p, int bid, int nblk, char* smem) {
  const int tid = tidx();
  constexpr int T_MOD = 384, T_LBS = 1, T_POS = 64, T_GP = 64, T_WIN = 2 * 16 * 54, T_WOUT = 2 * 16 * 16;
  constexpr int T_CP = 18;
  constexpr int NT = T_MOD + T_CP + T_LBS + T_POS + T_GP + T_WIN + T_WOUT;
  for (int task = bid; task < NT; task += nblk) {
    int t = task;
    if (t < T_MOD) { prep_mod(p, t, smem); continue; }
    t -= T_MOD;
    if (t < T_CP) {
      if (t >= 10) {
        const float* s = p.c_ws + (t - 10) * 16384; bf16_t* dd = p.cws() + (t - 10) * 16384;
        for (int i = tid; i < 16384; i += 256) dd[i] = f2bf(s[i]);
        continue;
      }
      const float* s; int off, n;
      switch (t) {
        case 0: s = p.norm_w; off = SP_NORM_W; n = 2048; break;
        case 1: s = p.a_conv_w; off = SP_CONV_W; n = 3072; break;
        case 2: s = p.a_conv_b; off = SP_CONV_B; n = 768; break;
        case 3: s = p.a_br; off = SP_BR; n = 1536; break;
        case 4: s = p.a_bi; off = SP_BI; n = 1536; break;
        case 5: s = p.a_lambda; off = SP_ASP; n = 1536; break;
        case 6: s = p.b_norm_w; off = SP_BNW; n = 768; break;
        case 7: s = p.c_norm_w; off = SP_CNW; n = 512; break;
        case 8: s = p.c_bs; off = SP_CBS; n = 1024; break;
        default: s = p.final_norm_w; off = SP_FNW; n = 1024; break;
      }
      float* dd = p.sp() + off;
      for (int i = tid; i < n; i += 256) { float v = s[i]; if (t == 5) v = 8.f * log1pf(expf(-v)); dd[i] = v; }
      continue;
    }
    t -= T_CP;
    if (t < T_LBS) {
      for (int i = tid; i < 384; i += 256) {
        float a = p.b_lb_logits[i], b = p.b_lb_logits[384 + i], cc = p.b_lb_logits[768 + i];
        float m = fmaxf(a, fmaxf(b, cc));
        float ea = expf(a - m), eb = expf(b - m), ec = expf(cc - m), inv = 1.f / (ea + eb + ec);
        p.lbs()[i] = ea * inv; p.lbs()[384 + i] = (ea + eb) * inv; p.lbs()[768 + i] = 1.f;
      }
      continue;
    }
    t -= T_LBS;
    if (t < T_POS) {
      int i = tid;
      float om = 1.0f / powf(10000.0f, (float)i / 256.0f);
      float ang = (float)t * om;
      p.postab()[t * 512 + i] = sinf(ang);
      p.postab()[t * 512 + 256 + i] = cosf(ang);
      continue;
    }
    t -= T_POS;
    if (t < T_GP) {
      const int mat = t & 1, ldh = t >> 1;
      const float* W = (mat ? p.a_wi : p.a_wr) + (size_t)ldh * 2304;
      bf16_t* dst = p.gatepack() + (size_t)t * 3072;
      for (int idx = tid; idx < 3072; idx += 256) {
        int jj = idx & 7, lane = (idx >> 3) & 63, nt = (idx >> 9) % 3, ks = idx / 1536;
        int k = ks * 32 + (lane >> 4) * 8 + jj, n = nt * 16 + (lane & 15);
        float v = (k < 48) ? W[k * 48 + n] : 0.f;
        dst[idx] = f2bf(v);
      }
      continue;
    }
    t -= T_GP;
    if (t < T_WIN) {
      int l = t / (16 * 54), r = t % (16 * 54);
      prep_transpose(p.w_in + (size_t)l * 1024 * NCOL, p.wtin() + (size_t)l * NCOL * 1024, NCOL, r / 54, r % 54, smem);
      continue;
    }
    t -= T_WIN;
    {
      int l = t / 256, r = t % 256;
      prep_transpose(p.w_out + (size_t)l * 1024 * 1024, p.wtout() + (size_t)l * 1024 * 1024, 1024, r / 16, r % 16, smem);
    }
  }
}

DEV void phase_norm(const Params& p, int layer, int bid, int nblk) {
  const int tid = tidx(), lane = tid & 63;
  const int wave = __builtin_amdgcn_readfirstlane(tid >> 6);
  const float* nwp = p.sp() + SP_NORM_W + layer * 1024;
  const int nwv = nblk * 4, per = (MROWS + nwv - 1) / nwv;
  const int r_begin = (bid * 4 + wave) * per;
  int r_end = r_begin + per; if (r_end > MROWS) r_end = MROWS;
  float4 nw[4], sh[4], sc[4];
#pragma unroll
  for (int i = 0; i < 4; ++i) { nw[i] = *(const float4*)(nwp + i * 256 + lane * 4); sh[i] = nw[i]; sc[i] = nw[i]; }
  int cur_m = -1;
  for (int row0 = r_begin; row0 < r_end; row0 += 2) {
    float4 v[2][4]; float ss[2]; int rows[2], mrows[2];
    const bool valid1 = row0 + 1 < r_end;
#pragma unroll
    for (int u = 0; u < 2; ++u) {
      const int row = (u == 1 && valid1) ? row0 + 1 : row0;
      rows[u] = row;
      const bool isctx = row >= NLAT;
      const float* src; float* res; int t = 0;
      if (!isctx) { t = row & 4095; src = (layer == 0 ? p.x : p.out) + (size_t)row * 1024; res = p.out + (size_t)row * 1024; mrows[u] = row >> 12; }
      else { int r2 = row - NLAT; src = (layer == 0 ? p.ctx : p.ctxres()) + (size_t)r2 * 1024; res = p.ctxres() + (size_t)r2 * 1024; mrows[u] = 8; }
      float s = 0.f;
#pragma unroll
      for (int i = 0; i < 4; ++i) {
        int col = i * 256 + lane * 4;
        float4 a;
        if (layer == 1 && !isctx) { const uint2 w_ = *(const uint2*)(p.x16() + (size_t)row * 1024 + col); a = make_float4(bflo(w_.x), bfhi(w_.x), bflo(w_.y), bfhi(w_.y)); }
        else a = *(const float4*)(src + col);
        if (layer == 0) {
          if (!isctx) {
            const float* tp = p.postab() + ((i < 2) ? (t >> 6) : (t & 63)) * 512 + (col & 511);
            float4 q = *(const float4*)tp;
            a.x += q.x; a.y += q.y; a.z += q.z; a.w += q.w;
          }
        }
        v[u][i] = a;
        s += a.x * a.x + a.y * a.y + a.z * a.z + a.w * a.w;
      }
      ss[u] = s;
    }
#pragma unroll
    for (int u = 0; u < 2; ++u) {
      if (u == 1 && !valid1) break;
      if (mrows[u] != cur_m) {
        cur_m = mrows[u];
        const float* modp = p.mod() + (layer * 9 + cur_m) * 3072;
#pragma unroll
        for (int i = 0; i < 4; ++i) { sh[i] = *(const float4*)(modp + i * 256 + lane * 4); sc[i] = *(const float4*)(modp + 1024 + i * 256 + lane * 4); }
      }
      const float rstd = rsqrtf(wave_sum(ss[u]) * (1.f / 1024.f) + EPSV);
#pragma unroll
      for (int i = 0; i < 4; ++i) {
        int col = i * 256 + lane * 4;
        float h0 = v[u][i].x * rstd * nw[i].x * (1.f + sc[i].x) + sh[i].x;
        float h1 = v[u][i].y * rstd * nw[i].y * (1.f + sc[i].y) + sh[i].y;
        float h2 = v[u][i].z * rstd * nw[i].z * (1.f + sc[i].z) + sh[i].z;
        float h3 = v[u][i].w * rstd * nw[i].w * (1.f + sc[i].w) + sh[i].w;
        *(uint2*)(p.hbuf() + (size_t)rows[u] * 1024 + col) = make_uint2(pack2(h0, h1), pack2(h2, h3));
      }
    }
  }
}

DEV void phase_final(const Params& p, int bid, int nblk) {
  const int tid = tidx(), lane = tid & 63;
  const int wave = __builtin_amdgcn_readfirstlane(tid >> 6);
  const int nwv = nblk * 4, per = (NLAT + nwv - 1) / nwv;
  const int r_begin = (bid * 4 + wave) * per;
  int r_end = r_begin + per; if (r_end > NLAT) r_end = NLAT;
  const float* fwp = p.sp() + SP_FNW;
  float4 fw[4];
#pragma unroll
  for (int i = 0; i < 4; ++i) fw[i] = *(const float4*)(fwp + i * 256 + lane * 4);
  for (int row0 = r_begin; row0 < r_end; row0 += 2) {
    const bool valid1 = row0 + 1 < r_end;
    float4 v[2][4]; float ss[2];
#pragma unroll
    for (int u = 0; u < 2; ++u) {
      const bf16_t* src = p.x16() + (size_t)((u == 1 && valid1) ? row0 + 1 : row0) * 1024;
      float s = 0.f;
#pragma unroll
      for (int i = 0; i < 4; ++i) { const uint2 w_ = *(const uint2*)(src + i * 256 + lane * 4); v[u][i] = make_float4(bflo(w_.x), bfhi(w_.x), bflo(w_.y), bfhi(w_.y)); s += v[u][i].x * v[u][i].x + v[u][i].y * v[u][i].y + v[u][i].z * v[u][i].z + v[u][i].w * v[u][i].w; }
      ss[u] = s;
    }
#pragma unroll
    for (int u = 0; u < 2; ++u) {
      if (u == 1 && !valid1) break;
      float* dst = p.out + (size_t)(row0 + u) * 1024;
      const float rstd = rsqrtf(wave_sum(ss[u]) * (1.f / 1024.f) + EPSV);
#pragma unroll
      for (int i = 0; i < 4; ++i) {
        int col = i * 256 + lane * 4;
        float4 o; o.x = v[u][i].x * rstd * fw[i].x; o.y = v[u][i].y * rstd * fw[i].y; o.z = v[u][i].z * rstd * fw[i].z; o.w = v[u][i].w * rstd * fw[i].w;
        *(float4*)(dst + col) = o;
      }
    }
  }
}

constexpr int GLD = 72;
template <int EPI, int MODE = 0>
DEV void phase_gemm(const Params& p, int layer, const bf16_t* __restrict__ A, const bf16_t* __restrict__ Bt, int M, int N, char* smem, int bid, int nblk, int big_done = 0) {
  constexpr int K = 1024;
  bf16_t* As = (bf16_t*)smem;
  bf16_t* Bs = As + 2 * 128 * GLD;
  const int tid = tidx(), lane = tid & 63, wave = tid >> 6, quad = lane >> 4, l15 = lane & 15;
  const int wm = wave >> 1, wn = wave & 1;
  const int lrow = tid >> 3, lkc = tid & 7;
  const int nN = N / 128, T = (M / 128) * nN;
  const int xcd = bid & 7, jb = bid >> 3, per = nblk >> 3;
  const int Tx = (T + 7) >> 3;
  const int t_begin = xcd * Tx + jb;
  int t_end = (xcd + 1) * Tx; if (t_end > T) t_end = T;
  int ntl = (t_end - t_begin + per - 1) / per; if (t_end <= t_begin) ntl = 0;
  const int TxB = (((M / 256) * nN) + 7) >> 3;
  int tB_end = (xcd + 1) * TxB; if (tB_end > (M / 256) * nN) tB_end = (M / 256) * nN;
  const int tB_left0 = xcd * TxB + big_done * per;
  if (MODE == 1) ntl = (tB_left0 + (jb >> 1) < tB_end) ? 1 : 0;
  const int nsteps = ntl * 16;
#define G_TILE_OF(i, pm, pn) { if (MODE == 1) { const int t_ = tB_left0 + (jb >> 1); const int g_ = t_ / (8 * nN), r_ = t_ - g_ * 8 * nN; pn = r_ >> 3; pm = 2 * (g_ * 8 + (r_ & 7)) + (jb & 1); } \
    else { const int t_ = t_begin + per * (i); const int g_ = t_ / (8 * nN), r_ = t_ - g_ * 8 * nN; pn = r_ >> 3; pm = g_ * 8 + (r_ & 7); } }
#define G_LOAD(s, a, b) { int pm_, pn_; G_TILE_OF((s) >> 4, pm_, pn_); \
    const bf16_t* Ag_ = A + (size_t)(pm_ * 128 + lrow) * K + lkc * 8 + ((s) & 15) * 64; \
    const bf16_t* Bg_ = Bt + (size_t)(pn_ * 128 + lrow) * K + lkc * 8 + ((s) & 15) * 64; \
    a##0 = *(const uint4*)(Ag_); a##1 = *(const uint4*)(Ag_ + (size_t)32 * K); a##2 = *(const uint4*)(Ag_ + (size_t)64 * K); a##3 = *(const uint4*)(Ag_ + (size_t)96 * K); \
    b##0 = *(const uint4*)(Bg_); b##1 = *(const uint4*)(Bg_ + (size_t)32 * K); b##2 = *(const uint4*)(Bg_ + (size_t)64 * K); b##3 = *(const uint4*)(Bg_ + (size_t)96 * K); }
#define G_LSTORE(buf, a, b) { bf16_t* ad_ = As + (buf) * 128 * GLD + lrow * GLD + lkc * 8; bf16_t* bd_ = Bs + (buf) * 128 * GLD + lrow * GLD + lkc * 8; \
    *(uint4*)(ad_) = a##0; *(uint4*)(ad_ + 32 * GLD) = a##1; *(uint4*)(ad_ + 64 * GLD) = a##2; *(uint4*)(ad_ + 96 * GLD) = a##3; \
    *(uint4*)(bd_) = b##0; *(uint4*)(bd_ + 32 * GLD) = b##1; *(uint4*)(bd_ + 64 * GLD) = b##2; *(uint4*)(bd_ + 96 * GLD) = b##3; }
#define G_ZERO() { _Pragma("unroll") for (int i_ = 0; i_ < 4; ++i_) _Pragma("unroll") for (int j_ = 0; j_ < 4; ++j_) acc[i_][j_] = (f32x4){0.f, 0.f, 0.f, 0.f}; }
#define G_COMPUTE(buf) { \
    const bf16_t* as_ = As + (buf) * 128 * GLD + (wm * 64 + l15) * GLD + quad * 8; \
    const bf16_t* bs_ = Bs + (buf) * 128 * GLD + (wn * 64 + l15) * GLD + quad * 8; \
    _Pragma("unroll") for (int ks_ = 0; ks_ < 2; ++ks_) { \
      bf16x8 af_[4], bf_[4]; \
      _Pragma("unroll") for (int i_ = 0; i_ < 4; ++i_) { af_[i_] = *(const bf16x8*)(as_ + i_ * 16 * GLD + ks_ * 32); bf_[i_] = *(const bf16x8*)(bs_ + i_ * 16 * GLD + ks_ * 32); } \
      __builtin_amdgcn_s_setprio(1); \
      _Pragma("unroll") for (int mi_ = 0; mi_ < 4; ++mi_) _Pragma("unroll") for (int ni_ = 0; ni_ < 4; ++ni_) acc[mi_][ni_] = mfma16(bf_[ni_], af_[mi_], acc[mi_][ni_]); \
      __builtin_amdgcn_s_setprio(0); } }
  f32x4 acc[4][4];
  if (nsteps > 0) {
    uint4 ra00, ra01, ra02, ra03, rb00, rb01, rb02, rb03, ra10, ra11, ra12, ra13, rb10, rb11, rb12, rb13;
    G_LOAD(0, ra0, rb0); G_LOAD(1, ra1, rb1);
    G_LSTORE(0, ra0, rb0);
    __syncthreads();
    G_ZERO();
    for (int s = 0; s < nsteps; s += 2) {
      { const int s2_ = (s + 2 < nsteps) ? s + 2 : nsteps - 1; G_LOAD(s2_, ra0, rb0); }
      G_COMPUTE(0);
      G_LSTORE(1, ra1, rb1);
      __syncthreads();
      { const int s3_ = (s + 3 < nsteps) ? s + 3 : nsteps - 1; G_LOAD(s3_, ra1, rb1); }
      G_COMPUTE(1);
      if ((s & 15) == 14) {
        int pm, pn; G_TILE_OF(s >> 4, pm, pn);
        const int row0 = pm * 128 + wm * 64 + l15, c0 = pn * 128 + wn * 64 + 4 * quad;
        if (EPI == 0) {
#pragma unroll
          for (int mi = 0; mi < 4; ++mi) {
            bf16_t* dst = p.pbuf() + (size_t)(row0 + mi * 16) * NCOL + c0;
#pragma unroll
            for (int ni = 0; ni < 4; ++ni) *(uint2*)(dst + ni * 16) = make_uint2(pack2(acc[mi][ni][0], acc[mi][ni][1]), pack2(acc[mi][ni][2], acc[mi][ni][3]));
          }
        } else {
          const bool lat = pm * 128 < NLAT;
          float* res = lat ? p.out + (size_t)row0 * 1024 + c0 : p.ctxres() + (size_t)(row0 - NLAT) * 1024 + c0;
          const float* g = p.mod() + (layer * 9 + (lat ? (pm * 128) >> 12 : 8)) * 3072 + 2048 + c0;
          const float* rsrc = (layer == 0) ? (lat ? p.x + (size_t)row0 * 1024 + c0 : p.ctx + (size_t)(row0 - NLAT) * 1024 + c0) : (const float*)res;
          bf16_t* x16p = p.x16() + (size_t)(lat ? row0 : 0) * 1024 + c0;
          const bool addpos = (layer == 0) && lat;
          const float* ptab = p.postab() + (c0 & 511);
          const bool rowhalf = c0 < 512;
          float4 gg[4], r[4], rn[4];
#define G_RLOAD(dst, mi_) { _Pragma("unroll") for (int ni = 0; ni < 4; ++ni) { \
            float4 v_; \
            if (layer == 0) v_ = *(const float4*)(rsrc + (size_t)(mi_) * 16 * 1024 + ni * 16); \
            else { const uint2 w_ = *(const uint2*)(x16p + (size_t)(mi_) * 16 * 1024 + ni * 16); v_ = make_float4(bflo(w_.x), bfhi(w_.x), bflo(w_.y), bfhi(w_.y)); } \
            if (addpos) { const int t_ = (row0 + (mi_) * 16) & 4095; const float4 q_ = *(const float4*)(ptab + (rowhalf ? (t_ >> 6) : (t_ & 63)) * 512 + ni * 16); \
              v_.x += q_.x; v_.y += q_.y; v_.z += q_.z; v_.w += q_.w; } \
            dst[ni] = v_; } }
#pragma unroll
          for (int ni = 0; ni < 4; ++ni) gg[ni] = *(const float4*)(g + ni * 16);
          G_RLOAD(r, 0);
#pragma unroll
          for (int mi = 0; mi < 4; ++mi) {
            if (mi < 3) G_RLOAD(rn, mi + 1);
#pragma unroll
            for (int ni = 0; ni < 4; ++ni) {
              float4 o = r[ni];
              o.x += gg[ni].x * acc[mi][ni][0]; o.y += gg[ni].y * acc[mi][ni][1]; o.z += gg[ni].z * acc[mi][ni][2]; o.w += gg[ni].w * acc[mi][ni][3];
              if (lat) *(uint2*)(x16p + (size_t)mi * 16 * 1024 + ni * 16) = make_uint2(pack2(o.x, o.y), pack2(o.z, o.w));
              else *(float4*)(res + (size_t)mi * 16 * 1024 + ni * 16) = o;
            }
#pragma unroll
            for (int ni = 0; ni < 4; ++ni) r[ni] = rn[ni];
          }
#undef G_RLOAD
        }
        G_ZERO();
      }
      G_LSTORE(0, ra0, rb0);
      __syncthreads();
    }
  }
#undef G_TILE_OF
#undef G_LOAD
#undef G_LSTORE
#undef G_ZERO
#undef G_COMPUTE
}

DEV void phase_gemm_big(const Params& p, const bf16_t* __restrict__ A, const bf16_t* __restrict__ Bt, int M, int N, char* smem, int bid, int nblk, int max_tiles) {
  constexpr int K = 1024;
  bf16_t* As = (bf16_t*)smem;
  bf16_t* Bs = As + 256 * GLD;
  const int tid = tidx(), lane = tid & 63, wave = tid >> 6, quad = lane >> 4, l15 = lane & 15;
  const int wm = wave >> 1, wn = wave & 1;
  const int lrow = tid >> 3, lkc = tid & 7;
  const int nN = N / 128, T = (M / 256) * nN;
  const int xcd = bid & 7, jb = bid >> 3, per = nblk >> 3;
  const int Tx = (T + 7) >> 3;
  const int t_begin = xcd * Tx + jb;
  int t_end = (xcd + 1) * Tx; if (t_end > T) t_end = T;
  int ntl = (t_end - t_begin + per - 1) / per; if (t_end <= t_begin) ntl = 0;
  if (ntl > max_tiles) ntl = max_tiles;
  const int nsteps = ntl * 16;
#define GB_TILE_OF(i, pm, pn) { const int t_ = t_begin + per * (i); const int g_ = t_ / (8 * nN), r_ = t_ - g_ * 8 * nN; pn = r_ >> 3; pm = g_ * 8 + (r_ & 7); }
#define GB_LOAD(s) { int pm_, pn_; GB_TILE_OF((s) >> 4, pm_, pn_); \
    const bf16_t* Ag_ = A + (size_t)(pm_ * 256 + lrow) * K + lkc * 8 + ((s) & 15) * 64; \
    const bf16_t* Bg_ = Bt + (size_t)(pn_ * 128 + lrow) * K + lkc * 8 + ((s) & 15) * 64; \
    ra0 = *(const uint4*)(Ag_); ra1 = *(const uint4*)(Ag_ + (size_t)32 * K); ra2 = *(const uint4*)(Ag_ + (size_t)64 * K); ra3 = *(const uint4*)(Ag_ + (size_t)96 * K); \
    ra4 = *(const uint4*)(Ag_ + (size_t)128 * K); ra5 = *(const uint4*)(Ag_ + (size_t)160 * K); ra6 = *(const uint4*)(Ag_ + (size_t)192 * K); ra7 = *(const uint4*)(Ag_ + (size_t)224 * K); \
    rb0 = *(const uint4*)(Bg_); rb1 = *(const uint4*)(Bg_ + (size_t)32 * K); rb2 = *(const uint4*)(Bg_ + (size_t)64 * K); rb3 = *(const uint4*)(Bg_ + (size_t)96 * K); }
#define GB_LSTORE() { bf16_t* ad_ = As + lrow * GLD + lkc * 8; bf16_t* bd_ = Bs + lrow * GLD + lkc * 8; \
    *(uint4*)(ad_) = ra0; *(uint4*)(ad_ + 32 * GLD) = ra1; *(uint4*)(ad_ + 64 * GLD) = ra2; *(uint4*)(ad_ + 96 * GLD) = ra3; \
    *(uint4*)(ad_ + 128 * GLD) = ra4; *(uint4*)(ad_ + 160 * GLD) = ra5; *(uint4*)(ad_ + 192 * GLD) = ra6; *(uint4*)(ad_ + 224 * GLD) = ra7; \
    *(uint4*)(bd_) = rb0; *(uint4*)(bd_ + 32 * GLD) = rb1; *(uint4*)(bd_ + 64 * GLD) = rb2; *(uint4*)(bd_ + 96 * GLD) = rb3; }
  f32x4 acc[8][4];
  if (nsteps > 0) {
    uint4 ra0, ra1, ra2, ra3, ra4, ra5, ra6, ra7, rb0, rb1, rb2, rb3;
    GB_LOAD(0);
    GB_LSTORE();
    __syncthreads();
#pragma unroll
    for (int i = 0; i < 8; ++i)
#pragma unroll
      for (int j = 0; j < 4; ++j) acc[i][j] = (f32x4){0.f, 0.f, 0.f, 0.f};
    const bf16_t* as_ = As + (wm * 128 + l15) * GLD + quad * 8;
    const bf16_t* bs_ = Bs + (wn * 64 + l15) * GLD + quad * 8;
    for (int s = 0; s < nsteps; ++s) {
      { const int s1_ = (s + 1 < nsteps) ? s + 1 : nsteps - 1; GB_LOAD(s1_); }
#pragma unroll
      for (int ks = 0; ks < 2; ++ks) {
        bf16x8 bf_[4];
#pragma unroll
        for (int i = 0; i < 4; ++i) bf_[i] = *(const bf16x8*)(bs_ + i * 16 * GLD + ks * 32);
#pragma unroll
        for (int hm = 0; hm < 2; ++hm) {
          bf16x8 af_[4];
#pragma unroll
          for (int i = 0; i < 4; ++i) af_[i] = *(const bf16x8*)(as_ + (hm * 4 + i) * 16 * GLD + ks * 32);
#pragma unroll
          for (int mi = 0; mi < 4; ++mi)
#pragma unroll
            for (int ni = 0; ni < 4; ++ni) acc[hm * 4 + mi][ni] = mfma16(bf_[ni], af_[mi], acc[hm * 4 + mi][ni]);
        }
      }
      if ((s & 15) == 15) {
        int pm, pn; GB_TILE_OF(s >> 4, pm, pn);
        const int row0 = pm * 256 + wm * 128 + l15, c0 = pn * 128 + wn * 64 + 4 * quad;
#pragma unroll
        for (int mi = 0; mi < 8; ++mi) {
          bf16_t* dst = p.pbuf() + (size_t)(row0 + mi * 16) * NCOL + c0;
#pragma unroll
          for (int ni = 0; ni < 4; ++ni) {
            *(uint2*)(dst + ni * 16) = make_uint2(pack2(acc[mi][ni][0], acc[mi][ni][1]), pack2(acc[mi][ni][2], acc[mi][ni][3]));
            acc[mi][ni] = (f32x4){0.f, 0.f, 0.f, 0.f};
          }
        }
      }
      __syncthreads();
      GB_LSTORE();
      __syncthreads();
    }
  }
#undef GB_TILE_OF
#undef GB_LOAD
#undef GB_LSTORE
}

DEV void a_chunk(const Params& p, int l, int b, int sc, bool fin, char* smem) {
  float* xcf = (float*)smem;
  bf16_t* xcb = (bf16_t*)(smem + 32 * 388 * 4);
  const int tid = tidx(), lane = tid & 63, wave = tid >> 6, quad = lane >> 4, l15 = lane & 15;
  int t0, Lseg; size_t rowbase;
  if (sc < 8) { t0 = sc * 32; Lseg = LCTX; rowbase = (size_t)NLAT + (size_t)b * LCTX; }
  else { t0 = (sc - 8) * 32; Lseg = LSEQ; rowbase = (size_t)b * LSEQ; }
  const float* cw = p.sp() + SP_CONV_W + l * 4 * 384;
  const float* cb = p.sp() + SP_CONV_B + l * 384;
  if (tid < 192) {
    const int cg = tid % 48, sg = tid / 48, ch0 = cg * 8, tb = sg * 8;
    uint4 rawr[11];
#pragma unroll
    for (int r = 0; r < 11; ++r) {
      const int tt = t0 + tb + r - 2;
      const int ttc = tt < 0 ? 0 : (tt >= Lseg ? Lseg - 1 : tt);
      rawr[r] = *(const uint4*)(p.pbuf() + (rowbase + ttc) * NCOL + COL_AX + ch0);
      if (tt != ttc) rawr[r] = make_uint4(0u, 0u, 0u, 0u);
    }
    float wv[4][8], bv[8];
    { const float4 b0 = *(const float4*)(cb + ch0), b1 = *(const float4*)(cb + ch0 + 4);
      bv[0] = b0.x; bv[1] = b0.y; bv[2] = b0.z; bv[3] = b0.w; bv[4] = b1.x; bv[5] = b1.y; bv[6] = b1.z; bv[7] = b1.w; }
#pragma unroll
    for (int w = 0; w < 4; ++w) {
      const float4 w0 = *(const float4*)(cw + w * 384 + ch0), w1 = *(const float4*)(cw + w * 384 + ch0 + 4);
      wv[w][0] = w0.x; wv[w][1] = w0.y; wv[w][2] = w0.z; wv[w][3] = w0.w; wv[w][4] = w1.x; wv[w][5] = w1.y; wv[w][6] = w1.z; wv[w][7] = w1.w;
    }
#pragma unroll
    for (int j = 0; j < 8; ++j) {
      float acc[8];
#pragma unroll
      for (int e = 0; e < 8; ++e) acc[e] = bv[e];
#pragma unroll
      for (int w = 0; w < 4; ++w) {
        float xs[8]; unpack8(rawr[j + w], xs);
#pragma unroll
        for (int e = 0; e < 8; ++e) acc[e] += xs[e] * wv[w][e];
      }
      const int t = tb + j;
      *(float4*)(xcf + t * 388 + ch0) = make_float4(acc[0], acc[1], acc[2], acc[3]);
      *(float4*)(xcf + t * 388 + ch0 + 4) = make_float4(acc[4], acc[5], acc[6], acc[7]);
      *(uint4*)(xcb + t * 392 + ch0) = make_uint4(pack2(acc[0], acc[1]), pack2(acc[2], acc[3]), pack2(acc[4], acc[5]), pack2(acc[6], acc[7]));
    }
  }
  __syncthreads();
  bf16x8 wrN[2][2], wiN[2][2]; float brN[2], biN[2], spN[2], hcN[2]; bf16_t gtN[2][4];
#define A_LOAD(HN) { \
    const int h_ = wave * 2 + (HN) / 3, nt_ = (HN) % 3, ch_ = h_ * 48 + nt_ * 16 + l15; \
    _Pragma("unroll") for (int d_ = 0; d_ < 2; ++d_) { \
      const bf16x8* gp_ = (const bf16x8*)p.gatepack() + (size_t)(((l * 2 + d_) * 8 + h_) * 2) * 6 * 64 + lane; \
      _Pragma("unroll") for (int ks_ = 0; ks_ < 2; ++ks_) { wrN[d_][ks_] = gp_[(ks_ * 3 + nt_) * 64]; wiN[d_][ks_] = gp_[(6 + ks_ * 3 + nt_) * 64]; } \
      brN[d_] = p.sp()[SP_BR + (l * 2 + d_) * 384 + ch_]; biN[d_] = p.sp()[SP_BI + (l * 2 + d_) * 384 + ch_]; \
      spN[d_] = p.sp()[SP_ASP + (l * 2 + d_) * 384 + ch_]; \
      hcN[d_] = fin ? p.aCarry()[((size_t)(b * 2 + d_) * ACH + sc) * 384 + ch_] : 0.f; } \
    if (fin) { _Pragma("unroll") for (int mt_ = 0; mt_ < 2; ++mt_) _Pragma("unroll") for (int jj_ = 0; jj_ < 4; ++jj_) \
      gtN[mt_][jj_] = p.pbuf()[(rowbase + t0 + mt_ * 16 + quad * 4 + jj_) * NCOL + COL_AG + ch_]; } }
  A_LOAD(0);
#pragma unroll 1
  for (int hn = 0; hn < 6; ++hn) {
    const int h = wave * 2 + hn / 3, nt = hn % 3;
    const int ch = h * 48 + nt * 16 + l15;
    f32x4 hf[2], pfv[2];
    bf16x8 wrA[2][2], wiA[2][2]; float brA[2], biA[2], spA[2], hcA[2]; bf16_t gtA[2][4];
#pragma unroll
    for (int d = 0; d < 2; ++d) {
#pragma unroll
      for (int ks = 0; ks < 2; ++ks) { wrA[d][ks] = wrN[d][ks]; wiA[d][ks] = wiN[d][ks]; }
      brA[d] = brN[d]; biA[d] = biN[d]; spA[d] = spN[d]; hcA[d] = hcN[d];
    }
#pragma unroll
    for (int mt = 0; mt < 2; ++mt)
#pragma unroll
      for (int jj = 0; jj < 4; ++jj) gtA[mt][jj] = gtN[mt][jj];
    { const int hn2 = hn < 5 ? hn + 1 : 5; A_LOAD(hn2); }
#pragma unroll
    for (int d = 0; d < 2; ++d) {
      const bf16x8 (&wr)[2] = wrA[d]; const bf16x8 (&wi)[2] = wiA[d];
      const size_t cidx = ((size_t)(b * 2 + d) * ACH + sc) * 384;
      const float br = brA[d], bi = biA[d], sp = spA[d];
      float hc = hcA[d], Pc = 1.f;
      const int lq = d ? 3 - quad : quad;
      const int s1 = d ? ((lane + 16) & 63) : ((lane - 16) & 63), s2 = d ? ((lane + 32) & 63) : ((lane - 32) & 63);
      const int lastl = d ? l15 : 48 + l15;
#pragma unroll
      for (int mi = 0; mi < 2; ++mi) {
        const int mt = d ? 1 - mi : mi;
        bf16x8 a0 = *(const bf16x8*)(xcb + (mt * 16 + l15) * 392 + h * 48 + quad * 8);
        bf16x8 a1 = {0, 0, 0, 0, 0, 0, 0, 0};
        if (quad < 2) a1 = *(const bf16x8*)(xcb + (mt * 16 + l15) * 392 + h * 48 + 32 + quad * 8);
        f32x4 ra = {0.f, 0.f, 0.f, 0.f}, ia = {0.f, 0.f, 0.f, 0.f};
        ra = mfma16(a0, wr[0], ra); ra = mfma16(a1, wr[1], ra);
        ia = mfma16(a0, wi[0], ia); ia = mfma16(a1, wi[1], ia);
        float av[4], uv[4];
#pragma unroll
        for (int jj = 0; jj < 4; ++jj) {
          const int tok = mt * 16 + quad * 4 + jj;
          const float xv = xcf[tok * 388 + ch];
          const float r = sigm(ra[jj] + br), ig = sigm(ia[jj] + bi);
          const float la = -r * sp;
          av[jj] = __expf(la);
          uv[jj] = __builtin_amdgcn_sqrtf(fmaxf(1.f - av[jj] * av[jj], 0.f)) * ig * xv;
        }
        float P = 1.f, H = 0.f, pl[4], hl[4];
#pragma unroll
        for (int q = 0; q < 4; ++q) { const int jj = d ? 3 - q : q; H = av[jj] * H + uv[jj]; P *= av[jj]; pl[jj] = P; hl[jj] = H; }
        float Pi = P, Hi = H;
        { float Ps = __shfl(Pi, s1), Hs = __shfl(Hi, s1); if (lq >= 1) { Hi = Pi * Hs + Hi; Pi = Pi * Ps; } }
        { float Ps = __shfl(Pi, s2), Hs = __shfl(Hi, s2); if (lq >= 2) { Hi = Pi * Hs + Hi; Pi = Pi * Ps; } }
        const float Pt = __shfl(Pi, lastl), Ht = __shfl(Hi, lastl);
        if (fin) {
          float Pe = __shfl(Pi, s1), He = __shfl(Hi, s1);
          if (lq == 0) { Pe = 1.f; He = 0.f; }
          const float hin = Pe * hc + He;
#pragma unroll
          for (int jj = 0; jj < 4; ++jj) {
            const float hv = pl[jj] * hin + hl[jj];
            if (d == 0) hf[mt][jj] = hv;
            else {
              const size_t row = rowbase + t0 + mt * 16 + quad * 4 + jj;
              p.hbuf()[row * 1024 + ch] = f2bf((hf[mt][jj] + hv) * siluf(bf2f(gtA[mt][jj])));
            }
          }
        }
        if (!fin) {
          float Pe = __shfl(Pi, s1), He = __shfl(Hi, s1);
          if (lq == 0) { Pe = 1.f; He = 0.f; }
          const float hin = Pe * hc + He, pin = Pe * Pc;
#pragma unroll
          for (int jj = 0; jj < 4; ++jj) {
            const float hv = pl[jj] * hin + hl[jj], pc = pl[jj] * pin;
            if (d == 0) { hf[mt][jj] = hv; pfv[mt][jj] = pc; }
            else {
              const size_t row = rowbase + t0 + mt * 16 + quad * 4 + jj;
              *(uint2*)(p.apk() + (row * 384 + ch) * 4) = make_uint2(pack2(hf[mt][jj] + hv, pfv[mt][jj]), pack2(pc, 0.f));
            }
          }
        }
        hc = Pt * hc + Ht; Pc *= Pt;
      }
      if (!fin && quad == 0) *(float2*)(p.aPH() + (cidx + ch) * 2) = make_float2(Pc, hc);
    }
  }
  __syncthreads();
}

#undef A_LOAD
DEV void a_light_task(const Params& p, int l, int t64) {
  const int tid = tidx();
#pragma unroll 4
  for (int k = 0; k < 24; ++k) {
    const int idx = tid + 256 * k;
    const int rr = idx / 96, c4 = idx - rr * 96, ch0 = c4 * 4;
    const size_t row = (size_t)t64 * 64 + rr;
    int b, sc;
    if (row < (size_t)NLAT) { b = (int)(row >> 12); sc = 8 + (((int)row & 4095) >> 5); }
    else { const int r2 = (int)row - NLAT; b = r2 >> 8; sc = (r2 & 255) >> 5; }
    const uint4 q0 = *(const uint4*)(p.apk() + (row * 384 + ch0) * 4), q1 = *(const uint4*)(p.apk() + (row * 384 + ch0) * 4 + 8);
    const float4 cf = *(const float4*)(p.aCarry() + ((size_t)(b * 2 + 0) * ACH + sc) * 384 + ch0);
    const float4 cb = *(const float4*)(p.aCarry() + ((size_t)(b * 2 + 1) * ACH + sc) * 384 + ch0);
    const uint2 g = *(const uint2*)(p.pbuf() + row * NCOL + COL_AG + ch0);
    const float y0 = (bflo(q0.x) + bfhi(q0.x) * cf.x + bflo(q0.y) * cb.x) * siluf(bflo(g.x));
    const float y1 = (bflo(q0.z) + bfhi(q0.z) * cf.y + bflo(q0.w) * cb.y) * siluf(bfhi(g.x));
    const float y2 = (bflo(q1.x) + bfhi(q1.x) * cf.z + bflo(q1.y) * cb.z) * siluf(bflo(g.y));
    const float y3 = (bflo(q1.z) + bfhi(q1.z) * cf.w + bflo(q1.w) * cb.w) * siluf(bfhi(g.y));
    *(uint2*)(p.hbuf() + row * 1024 + ch0) = make_uint2(pack2(y0, y1), pack2(y2, y3));
  }
}

DEV void b_logf_scan(const Params& p, int l, int h, int d, const uint4 (&rawf)[3], float* Lf, float* GL, float* OFFp) {
  const int tid = tidx();
  float* SEG = OFFp + 768;
  const float* lbp = p.lbs() + l * 384 + h * 96;
#pragma unroll
  for (int it = 0; it < 3; ++it) {
    const int idx = tid + 256 * it, tok = idx / 12, g8 = idx % 12;
    float xs[8]; unpack8(rawf[it], xs);
    const float4 lb0 = *(const float4*)(lbp + g8 * 8), lb1 = *(const float4*)(lbp + g8 * 8 + 4);
    const float lbv[8] = {lb0.x, lb0.y, lb0.z, lb0.w, lb1.x, lb1.y, lb1.z, lb1.w};
#pragma unroll
    for (int e = 0; e < 8; ++e) { const float lb = lbv[e]; const float f = lb + (1.f - lb) * sigm(xs[e]); Lf[tok * 97 + g8 * 8 + e] = __logf(f); }
  }
  __syncthreads();
#pragma unroll
  for (int it = 0; it < 3; ++it) {
    const int item = tid + 256 * it, c = item % 96, sg = item / 96;
    float run = 0.f;
#pragma unroll
    for (int j = 0; j < 8; ++j) { const int pp = sg * 8 + j, tok = d ? 63 - pp : pp; run += Lf[tok * 97 + c]; Lf[tok * 97 + c] = run; }
    SEG[sg * 96 + c] = run;
  }
  __syncthreads();
#pragma unroll
  for (int it = 0; it < 3; ++it) {
    const int item = tid + 256 * it, c = item % 96, sg = item / 96;
    float off = 0.f;
#pragma unroll
    for (int s = 0; s < 7; ++s) { const float t = SEG[s * 96 + c]; off += (s < sg) ? t : 0.f; }
    OFFp[sg * 96 + c] = off;
    if (sg == 7) GL[c] = off + SEG[7 * 96 + c];
  }
  __syncthreads();
}

DEV void b_kv_task(const Params& p, int l, int task, char* smem) {
  const int n = task % BSL, s = task / BSL, d = s & 1, h = (s >> 1) & 3, b = s >> 3;
  size_t rowbase;
  if (n < 4) { int cj = d ? 3 - n : n; rowbase = (size_t)NLAT + b * LCTX + cj * 64; }
  else { int cj = d ? 63 - (n - 4) : n - 4; rowbase = (size_t)b * LSEQ + cj * 64; }
  float* Lf = (float*)smem; float* GL = Lf + 64 * 97;
  bf16_t* Kt = (bf16_t*)(smem + 25600);
  bf16_t* Vt = Kt + 96 * 72;
  float* OFFp = (float*)(smem + 53248);
  const int tid = tidx(), lane = tid & 63, wave = tid >> 6, quad = lane >> 4, l15 = lane & 15;
  const int fcol = (d ? COL_BFB : COL_BFF) + h * 96;
  uint4 rawf[3], rawv[3];
#pragma unroll
  for (int it = 0; it < 3; ++it) {
    const int idx = tid + 256 * it, tok = idx / 12, g8 = idx % 12;
    rawf[it] = *(const uint4*)(p.pbuf() + (rowbase + tok) * NCOL + fcol + g8 * 8);
    rawv[it] = *(const uint4*)(p.pbuf() + (rowbase + tok) * NCOL + COL_BI + h * 96 + g8 * 8);
  }
  b_logf_scan(p, l, h, d, rawf, Lf, GL, OFFp);
  const float* lbp = p.lbs() + l * 384 + h * 96;
#pragma unroll
  for (int it = 0; it < 3; ++it) {
    const int idx = tid + 256 * it, tok = idx / 12, g8 = idx % 12;
    const int pp = d ? 63 - tok : tok;
    float xs[8]; unpack8(rawf[it], xs);
    const unsigned vv[4] = {rawv[it].x, rawv[it].y, rawv[it].z, rawv[it].w};
    float kend[8];
    const float4 lb0 = *(const float4*)(lbp + g8 * 8), lb1 = *(const float4*)(lbp + g8 * 8 + 4);
    const float lbv[8] = {lb0.x, lb0.y, lb0.z, lb0.w, lb1.x, lb1.y, lb1.z, lb1.w};
#pragma unroll
    for (int e = 0; e < 8; ++e) {
      const int dk = g8 * 8 + e;
      const float lb = lbv[e];
      const float k = (1.f - lb) * (1.f - sigm(xs[e]));
      const float G = Lf[tok * 97 + dk] + OFFp[(pp >> 3) * 96 + dk];
      kend[e] = k * __expf(GL[dk] - G);
    }
    const unsigned kp[4] = {pack2(kend[0], kend[1]), pack2(kend[2], kend[3]), pack2(kend[4], kend[5]), pack2(kend[6], kend[7])};
    bf16_t* kd = Kt + g8 * 8 * 72 + tok; bf16_t* vd = Vt + g8 * 8 * 72 + tok;
    const int rot = g8 & 7;
#pragma unroll
    for (int e0 = 0; e0 < 8; ++e0) {
      const int e = (e0 + rot) & 7;
      const unsigned kw = (e & 2) ? ((e & 4) ? kp[3] : kp[1]) : ((e & 4) ? kp[2] : kp[0]);
      const unsigned vw = (e & 2) ? ((e & 4) ? vv[3] : vv[1]) : ((e & 4) ? vv[2] : vv[0]);
      kd[e * 72] = (bf16_t)((e & 1) ? (kw >> 16) : (kw & 0xffffu));
      vd[e * 72] = (bf16_t)((e & 1) ? (vw >> 16) : (vw & 0xffffu));
    }
  }
  if (tid < 96) p.decay()[(size_t)task * 96 + tid] = __expf(GL[tid]);
  __syncthreads();
  bf16_t* dst = p.kvbuf() + (size_t)task * 9216;
  for (int i = 0; i < 9; ++i) {
    const int ti = wave * 9 + i, mt = ti / 6, nt = ti % 6;
    f32x4 acc = {0.f, 0.f, 0.f, 0.f};
#pragma unroll
    for (int ks = 0; ks < 2; ++ks) {
      bf16x8 ka = *(const bf16x8*)(Kt + (nt * 16 + l15) * 72 + ks * 32 + quad * 8);
      bf16x8 vb = *(const bf16x8*)(Vt + (mt * 16 + l15) * 72 + ks * 32 + quad * 8);
      acc = mfma16(ka, vb, acc);
    }
    *(uint2*)(dst + (mt * 16 + l15) * 96 + nt * 16 + 4 * quad) = make_uint2(pack2(acc[0], acc[1]), pack2(acc[2], acc[3]));
  }
  __syncthreads();
}

DEV void b_state_scan(const Params& p, int gidx) {
  const int dk8 = gidx % 12, dv = (gidx / 12) % 96, s = gidx / 1152;
  bf16_t* base = p.kvbuf() + (size_t)s * BSL * 9216 + dv * 96 + dk8 * 8;
  const float* dec = p.decay() + (size_t)s * BSL * 96 + dk8 * 8;
  float S[8];
#pragma unroll
  for (int e = 0; e < 8; ++e) S[e] = 0.f;
  uint4 kv[4]; float4 d0[4], d1[4];
#pragma unroll
  for (int i = 0; i < 4; ++i) { kv[i] = *(const uint4*)(base + (size_t)i * 9216); d0[i] = *(const float4*)(dec + i * 96); d1[i] = *(const float4*)(dec + i * 96 + 4); }
#pragma unroll 1
  for (int n0 = 0; n0 < BSL; n0 += 4) {
    uint4 kvn[4]; float4 dn0[4], dn1[4];
    {
      const int nn = (n0 + 4 < BSL) ? n0 + 4 : n0;
#pragma unroll
      for (int i = 0; i < 4; ++i) { kvn[i] = *(const uint4*)(base + (size_t)(nn + i) * 9216); dn0[i] = *(const float4*)(dec + (nn + i) * 96); dn1[i] = *(const float4*)(dec + (nn + i) * 96 + 4); }
    }
#pragma unroll
    for (int i = 0; i < 4; ++i) {
      *(uint4*)(base + (size_t)(n0 + i) * 9216) = make_uint4(pack2(S[0], S[1]), pack2(S[2], S[3]), pack2(S[4], S[5]), pack2(S[6], S[7]));
      float kf[8]; unpack8(kv[i], kf);
      S[0] = d0[i].x * S[0] + kf[0]; S[1] = d0[i].y * S[1] + kf[1]; S[2] = d0[i].z * S[2] + kf[2]; S[3] = d0[i].w * S[3] + kf[3];
      S[4] = d1[i].x * S[4] + kf[4]; S[5] = d1[i].y * S[5] + kf[5]; S[6] = d1[i].z * S[6] + kf[6]; S[7] = d1[i].w * S[7] + kf[7];
    }
#pragma unroll
    for (int i = 0; i < 4; ++i) { kv[i] = kvn[i]; d0[i] = dn0[i]; d1[i] = dn1[i]; }
  }
}

DEV void a_carry_wave(const Params& p, int widx) {
  const int lane = tidx() & 63;
  const int ch = widx % 384, d = (widx / 384) & 1, b = widx / 768;
  const float2* ph = (const float2*)p.aPH() + (size_t)(b * 2 + d) * ACH * 384 + ch;
  float* cr = p.aCarry() + (size_t)(b * 2 + d) * ACH * 384 + ch;
  float P[3], H[3]; int scv[3]; bool valid[3];
#pragma unroll
  for (int j = 0; j < 3; ++j) {
    const int pos = lane * 3 + j;
    valid[j] = pos < ACH;
    scv[j] = d ? (pos < 8 ? 7 - pos : ACH - 1 - (pos - 8)) : pos;
    float2 v = make_float2(1.f, 0.f);
    if (valid[j]) v = ph[(size_t)scv[j] * 384];
    P[j] = v.x; H[j] = v.y;
  }
  float Pi = P[0], Hi = H[0];
  Hi = P[1] * Hi + H[1]; Pi *= P[1];
  Hi = P[2] * Hi + H[2]; Pi *= P[2];
#pragma unroll
  for (int o = 1; o < 64; o <<= 1) {
    const float Ps = __shfl_up(Pi, o), Hs = __shfl_up(Hi, o);
    if (lane >= o) { Hi = Pi * Hs + Hi; Pi = Pi * Ps; }
  }
  float He = __shfl_up(Hi, 1);
  if (lane == 0) He = 0.f;
  const float c0 = He, c1 = P[0] * c0 + H[0], c2 = P[1] * c1 + H[1];
  if (valid[0]) cr[(size_t)scv[0] * 384] = c0;
  if (valid[1]) cr[(size_t)scv[1] * 384] = c1;
  if (valid[2]) cr[(size_t)scv[2] * 384] = c2;
}

DEV void b_out_task(const Params& p, int l, int b, int h, int seg, int cj, char* smem) {
  const size_t rowbase = seg == 0 ? (size_t)NLAT + b * LCTX + cj * 64 : (size_t)b * LSEQ + cj * 64;
  float* Lf = (float*)smem; float* GL = Lf + 64 * 97;
  bf16_t* Qs = (bf16_t*)(smem + 25600);
  bf16_t* Ks = (bf16_t*)(smem + 38912);
  bf16_t* Vt = (bf16_t*)(smem + 52224);
  bf16_t* Sc = (bf16_t*)(smem + 66048);
  float* OFFp = (float*)(smem + 66048);
  const int tid = tidx(), lane = tid & 63, wave = tid >> 6, quad = lane >> 4, l15 = lane & 15;
  uint4 rawv[3], rawq[3], rawf0[3], rawf1[3];
#pragma unroll
  for (int it = 0; it < 3; ++it) {
    const int idx = tid + 256 * it, tok = idx / 12, g8 = idx % 12;
    const bf16_t* rp = p.pbuf() + (rowbase + tok) * NCOL + h * 96 + g8 * 8;
    rawv[it] = *(const uint4*)(rp + COL_BI); rawq[it] = *(const uint4*)(rp + COL_BQ);
    rawf0[it] = *(const uint4*)(rp + COL_BFF); rawf1[it] = *(const uint4*)(rp + COL_BFB);
  }
  bf16_t gt[4][6];
#pragma unroll
  for (int jj = 0; jj < 4; ++jj)
#pragma unroll
    for (int nt = 0; nt < 6; ++nt) gt[jj][nt] = p.pbuf()[(rowbase + wave * 16 + 4 * quad + jj) * NCOL + COL_BG + h * 96 + nt * 16 + l15];
#pragma unroll
  for (int it = 0; it < 3; ++it) {
    const int idx = tid + 256 * it, tok = idx / 12, g8 = idx % 12;
    const unsigned vv[4] = {rawv[it].x, rawv[it].y, rawv[it].z, rawv[it].w};
    bf16_t* vd = Vt + g8 * 8 * 72 + tok;
    const int rot = g8 & 7;
#pragma unroll
    for (int e0 = 0; e0 < 8; ++e0) {
      const int e = (e0 + rot) & 7;
      const unsigned vw = (e & 2) ? ((e & 4) ? vv[3] : vv[1]) : ((e & 4) ? vv[2] : vv[0]);
      vd[e * 72] = (bf16_t)((e & 1) ? (vw >> 16) : (vw & 0xffffu));
    }
  }
  f32x4 oacc[6];
#pragma unroll
  for (int nt = 0; nt < 6; ++nt) oacc[nt] = (f32x4){0.f, 0.f, 0.f, 0.f};
  const float* lbp = p.lbs() + l * 384 + h * 96;
#pragma unroll
  for (int d = 0; d < 2; ++d) {
    const int n = seg == 0 ? (d ? 3 - cj : cj) : 4 + (d ? 63 - cj : cj);
    const size_t stream = (size_t)(b * 4 + h) * 2 + d;
    const bf16_t* St = p.kvbuf() + (stream * BSL + n) * 9216;
    b_logf_scan(p, l, h, d, d ? rawf1 : rawf0, Lf, GL, OFFp);
#pragma unroll
    for (int it = 0; it < 3; ++it) {
      const int idx = tid + 256 * it, tok = idx / 12, g8 = idx % 12;
      const int pp = d ? 63 - tok : tok;
      float xs[8], qs[8], qg[8], kg[8]; unpack8(d ? rawf1[it] : rawf0[it], xs); unpack8(rawq[it], qs);
      const float4 lb0 = *(const float4*)(lbp + g8 * 8), lb1 = *(const float4*)(lbp + g8 * 8 + 4);
      const float lbv[8] = {lb0.x, lb0.y, lb0.z, lb0.w, lb1.x, lb1.y, lb1.z, lb1.w};
#pragma unroll
      for (int e = 0; e < 8; ++e) {
        const int dk = g8 * 8 + e;
        const float lb = lbv[e];
        const float k = (1.f - lb) * (1.f - sigm(xs[e]));
        const float G = Lf[tok * 97 + dk] + OFFp[(pp >> 3) * 96 + dk];
        qg[e] = siluf(qs[e]) * __expf(G);
        kg[e] = k * __expf(-G);
      }
      *(uint4*)(Qs + tok * 104 + g8 * 8) = make_uint4(pack2(qg[0], qg[1]), pack2(qg[2], qg[3]), pack2(qg[4], qg[5]), pack2(qg[6], qg[7]));
      *(uint4*)(Ks + tok * 104 + g8 * 8) = make_uint4(pack2(kg[0], kg[1]), pack2(kg[2], kg[3]), pack2(kg[4], kg[5]), pack2(kg[6], kg[7]));
    }
    __syncthreads();
    bf16x8 qa[3];
#pragma unroll
    for (int ks = 0; ks < 3; ++ks) qa[ks] = *(const bf16x8*)(Qs + (wave * 16 + l15) * 104 + ks * 32 + quad * 8);
    bf16x8 sfr[6][3];
#pragma unroll
    for (int nt = 0; nt < 6; ++nt)
#pragma unroll
      for (int ks = 0; ks < 3; ++ks) sfr[nt][ks] = *(const bf16x8*)(St + (nt * 16 + l15) * 96 + ks * 32 + quad * 8);
#pragma unroll
    for (int nt = 0; nt < 4; ++nt) {
      f32x4 acc = {0.f, 0.f, 0.f, 0.f};
#pragma unroll
      for (int ks = 0; ks < 3; ++ks) acc = mfma16(qa[ks], *(const bf16x8*)(Ks + (nt * 16 + l15) * 104 + ks * 32 + quad * 8), acc);
      int cb_ = wave * 16 + 4 * quad - nt * 16 - l15;
      asm volatile("" : "+v"(cb_));
      if (d) cb_ = -cb_;
#pragma unroll
      for (int jj = 0; jj < 4; ++jj) {
        const int cc = wave * 16 + 4 * quad + jj, ss = nt * 16 + l15;
        const int df = d ? cb_ - jj : cb_ + jj;
        Sc[cc * 72 + ss] = f2bf(df >= 0 ? acc[jj] : 0.f);
      }
    }
    __syncthreads();
    bf16x8 sa[2];
#pragma unroll
    for (int ks = 0; ks < 2; ++ks) sa[ks] = *(const bf16x8*)(Sc + (wave * 16 + l15) * 72 + ks * 32 + quad * 8);
#pragma unroll
    for (int nt = 0; nt < 6; ++nt) {
#pragma unroll
      for (int ks = 0; ks < 2; ++ks) oacc[nt] = mfma16(sa[ks], *(const bf16x8*)(Vt + (nt * 16 + l15) * 72 + ks * 32 + quad * 8), oacc[nt]);
#pragma unroll
      for (int ks = 0; ks < 3; ++ks) oacc[nt] = mfma16(qa[ks], sfr[nt][ks], oacc[nt]);
    }
  }
  const float* gw = p.sp() + SP_BNW + l * 384 + h * 96;
  float gwv[6];
#pragma unroll
  for (int nt = 0; nt < 6; ++nt) gwv[nt] = gw[nt * 16 + l15];
#pragma unroll
  for (int jj = 0; jj < 4; ++jj) {
    float ss = 0.f;
#pragma unroll
    for (int nt = 0; nt < 6; ++nt) ss += oacc[nt][jj] * oacc[nt][jj];
    ss = row_sum16(ss);
    const float rstd = rsqrtf(ss * (1.f / 96.f) + EPSV);
    const size_t row = rowbase + wave * 16 + 4 * quad + jj;
#pragma unroll
    for (int nt = 0; nt < 6; ++nt) {
      const int dv = nt * 16 + l15;
      p.hbuf()[row * 1024 + 384 + h * 96 + dv] = f2bf(oacc[nt][jj] * rstd * gwv[nt] * siluf(bf2f(gt[jj][nt])));
    }
  }
  __syncthreads();
}

DEV void c_task(const Params& p, int l, size_t rowbase, char* smem) {
  bf16_t* Vt = (bf16_t*)smem;
  const int tid = tidx(), lane = tid & 63, wave = tid >> 6, quad = lane >> 4, l15 = lane & 15;
  {
    const float* cnw = p.sp() + SP_CNW + l * 256 + l15 * 16;
    const int sub = lane >> 4;
    float nwv[16];
#pragma unroll
    for (int i = 0; i < 4; ++i) { const float4 t = *(const float4*)(cnw + 4 * i); nwv[4 * i] = t.x; nwv[4 * i + 1] = t.y; nwv[4 * i + 2] = t.z; nwv[4 * i + 3] = t.w; }
#pragma unroll 1
    for (int g0 = 0; g0 < 8; g0 += 4) {
      uint4 r0[4], r1[4];
#pragma unroll
      for (int g = 0; g < 4; ++g) {
        const bf16_t* src = p.pbuf() + (rowbase + wave * 32 + (g0 + g) * 4 + sub) * NCOL + COL_CV + l15 * 16;
        r0[g] = *(const uint4*)src; r1[g] = *(const uint4*)(src + 8);
      }
#pragma unroll
      for (int g = 0; g < 4; ++g) {
        const int tok = wave * 32 + (g0 + g) * 4 + sub;
        float v[16]; unpack8(r0[g], v); unpack8(r1[g], v + 8);
        float s = 0.f;
#pragma unroll
        for (int i = 0; i < 16; ++i) { v[i] = geluf(v[i]); s += v[i]; }
        s = row_sum16(s);
        const float mu = s * (1.f / 256.f);
        float q = 0.f;
#pragma unroll
        for (int i = 0; i < 16; ++i) { v[i] -= mu; q += v[i] * v[i]; }
        q = row_sum16(q);
        const float rstd = rsqrtf(q * (1.f / 256.f) + EPSV);
        bf16_t* dstp = Vt + (l15 * 16) * 136 + ((((tok >> 3) ^ l15) & 15) << 3) + (tok & 7);
#pragma unroll
        for (int i = 0; i < 16; ++i) dstp[i * 136] = f2bf(v[i] * rstd * nwv[i]);
      }
    }
  }
  __syncthreads();
  const int h = wave;
  const bf16_t* ws = p.cws() + ((size_t)l * 4 + h) * 128 * 128;
  const float* bs = p.sp() + SP_CBS + (l * 4 + h) * 128;
  for (int mt = 0; mt < 8; ++mt) {
    bf16_t ur[4][4], gr[4][4]; float bias[4];
#pragma unroll
    for (int jj = 0; jj < 4; ++jj) {
      const size_t row = rowbase + mt * 16 + 4 * quad + jj;
      bias[jj] = bs[mt * 16 + 4 * quad + jj];
#pragma unroll
      for (int nt = 0; nt < 4; ++nt) {
        const int ch = h * 64 + nt * 16 + l15;
        ur[jj][nt] = p.pbuf()[row * NCOL + COL_CU + ch];
        gr[jj][nt] = p.pbuf()[row * NCOL + COL_CG + ch];
      }
    }
    f32x4 acc[4];
#pragma unroll
    for (int nt = 0; nt < 4; ++nt) acc[nt] = (f32x4){0.f, 0.f, 0.f, 0.f};
#pragma unroll
    for (int ks = 0; ks < 4; ++ks) {
      const bf16x8 wfrag = *(const bf16x8*)(ws + (mt * 16 + l15) * 128 + ks * 32 + quad * 8);
#pragma unroll
      for (int nt = 0; nt < 4; ++nt) acc[nt] = mfma16(wfrag, *(const bf16x8*)(Vt + (h * 64 + nt * 16 + l15) * 136 + ((((ks * 4 + quad) ^ (h * 4 + nt)) & 15) << 3)), acc[nt]);
    }
#pragma unroll
    for (int jj = 0; jj < 4; ++jj) {
      const size_t row = rowbase + mt * 16 + 4 * quad + jj;
#pragma unroll
      for (int nt = 0; nt < 4; ++nt) {
        const int ch = h * 64 + nt * 16 + l15;
        p.hbuf()[row * 1024 + 768 + ch] = f2bf(geluf(bf2f(ur[jj][nt])) * (acc[nt][jj] + bias[jj]) * siluf(bf2f(gr[jj][nt])));
      }
    }
  }
  __syncthreads();
}

#ifndef TIMING
#define TIMING 0
#endif
#if TIMING
#define TSH ((unsigned long long*)(smem + 76000))
#define TT_BEGIN() unsigned long long tt0_ = 0; if (bid == 0 && tidx() == 0) tt0_ = __builtin_amdgcn_s_memrealtime();
#define TT_END(code) if (bid == 0 && tidx() == 0) { unsigned long long d_ = __builtin_amdgcn_s_memrealtime() - tt0_; if ((code) == TIMING_A) TSH[1] += d_; if ((code) == TIMING_B) TSH[2] += d_; }
#else
#define TT_BEGIN()
#define TT_END(code)
#endif
#ifndef DBG_SUB
#define DBG_SUB 7
#endif
DEV void phase_m1(const Params& p, int l, int bid, int nblk, char* smem) {
  const int nC = (l == 0) ? 272 : 256;
  const int nBk = NB * 4 * 2 * BSL;
  const int nA = NB * ACH;
  const int NT = nC + nBk + nA;
  for (int task = bid; task < NT; task += nblk) {
    int t = task;
    if (t < nC) {
      size_t rowbase = (t < 256) ? (size_t)(t >> 5) * LSEQ + (t & 31) * 128 : (size_t)NLAT + ((t - 256) >> 1) * LCTX + ((t - 256) & 1) * 128;
      TT_BEGIN(); if (DBG_SUB & 1) c_task(p, l, rowbase, smem); TT_END(10);
      continue;
    }
    t -= nC;
    if (t < nBk) { TT_BEGIN(); if (DBG_SUB & 2) b_kv_task(p, l, t, smem); TT_END(11); continue; }
    t -= nBk;
    { TT_BEGIN(); if (DBG_SUB & 4) a_chunk(p, l, t / ACH, t % ACH, false, smem); TT_END(12); }
  }
}

DEV void phase_m2(const Params& p, int l, int bid, int nblk, char* smem) {
  constexpr int TT = 64 * 96 * 12;
  const int chunk = (TT + nblk - 1) / nblk;
  const int g_end = (bid + 1) * chunk < TT ? (bid + 1) * chunk : TT;
  for (int g = bid * chunk + tidx(); g < g_end; g += 256) b_state_scan(p, g);
  constexpr int NAB = 1536;
  for (int task = bid; task < NAB; task += nblk) a_carry_wave(p, task * 4 + (tidx() >> 6));
}

DEV void phase_m3(const Params& p, int l, int bid, int nblk, char* smem) {
  const int nB = (l == 0) ? 2048 + 128 : 2048;
  const int nA = (l == 0) ? MROWS / 64 : NLAT / 64;
  for (int task = bid; task < nB + nA; task += nblk) {
    int t = task;
    if (t < nB) {
      if (!(DBG_SUB & 2)) continue;
      TT_BEGIN();
      if (t < 2048) b_out_task(p, l, t >> 8, (t >> 6) & 3, 1, t & 63, smem);
      else { int i2 = t - 2048; b_out_task(p, l, i2 >> 4, (i2 >> 2) & 3, 0, i2 & 3, smem); }
      TT_END(13);
      continue;
    }
    t -= nB;
    if (!(DBG_SUB & 4)) continue;
    TT_BEGIN();
    a_light_task(p, l, t);
    TT_END(14);
  }
}

#ifndef DBG_MASK
#define DBG_MASK 0xff
#endif
DEV void run_phase(const Params& p, int ph, int l, int bid, int nblk, char* smem) {
  if (!((DBG_MASK >> ph) & 1)) return;
  switch (ph) {
    case 0: phase_prep(p, bid, nblk, smem); break;
    case 1: phase_norm(p, l, bid, nblk); break;
    case 2: {
      const int full = (((MROWS / 256) * (NCOL / 128) + 7) >> 3) / (nblk >> 3);
      phase_gemm_big(p, p.hbuf(), p.wtin() + (size_t)l * NCOL * 1024, MROWS, NCOL, smem, bid, nblk, full);
      phase_gemm<0, 1>(p, l, p.hbuf(), p.wtin() + (size_t)l * NCOL * 1024, MROWS, NCOL, smem, bid, nblk, full);
      break; }
    case 3: phase_m1(p, l, bid, nblk, smem); break;
    case 4: phase_m2(p, l, bid, nblk, smem); break;
    case 5: phase_m3(p, l, bid, nblk, smem); break;
    case 6: phase_gemm<1>(p, l, p.hbuf(), p.wtout() + (size_t)l * 1024 * 1024, (l == 0) ? MROWS : NLAT, 1024, smem, bid, nblk); break;
    default: phase_final(p, bid, nblk); break;
  }
}

#define XB_TMO      128
#define XB_XCNT(j)  (256  + 64 * (j))
#define XB_XSUB(j)  (1280 + 64 * (j))
#define XB_XGEN(j)  (2304 + 64 * (j))
#define XB_TOP      3328
#define XB_TOPGEN   3392
#define XCD_BAR_WORDS 3456
#define XB_SPIN_CAP (1u << 18)
#define LAS __attribute__((address_space(3)))

__device__ __forceinline__ unsigned xb_ld(unsigned* p)              { return __hip_atomic_load(p, __ATOMIC_RELAXED, __HIP_MEMORY_SCOPE_AGENT); }
__device__ __forceinline__ unsigned xb_add(unsigned* p, unsigned v) { return __hip_atomic_fetch_add(p, v, __ATOMIC_RELAXED, __HIP_MEMORY_SCOPE_AGENT); }
__device__ __forceinline__ unsigned xb_xcc_id() { return (unsigned)__builtin_amdgcn_s_getreg((3 << 11) | 20) & 0xFu; }
#define XB_SPIN(cond, bar) do { unsigned _sp = 0; while (cond) { __builtin_amdgcn_s_sleep(1); \
    if ((++_sp & 255u) == 0u) { if (xb_ld(&(bar)[XB_TMO])) break; if (_sp > XB_SPIN_CAP) { atomicAdd(&(bar)[XB_TMO], 1u); break; } } } } while (0)

struct XcdBarrier {
    unsigned* bar; unsigned x;
    volatile LAS unsigned* st;
};

__device__ __forceinline__ XcdBarrier xcd_barrier_post(unsigned* bar, volatile LAS unsigned* st) {
    XcdBarrier b; b.bar = bar; b.x = xb_xcc_id(); b.st = st;
    if (threadIdx.x == 0) (void)xb_add(&bar[XB_XCNT(b.x)], 1u);
    return b;
}
__device__ __forceinline__ void xcd_barrier_complete(unsigned* bar, unsigned x, unsigned& nloc, unsigned& nx) {
    const unsigned G = gridDim.x * gridDim.y * gridDim.z;
    unsigned sum, cnt, mine, sp = 0u;
    for (;;) {
        sum = 0u; cnt = 0u; mine = 0u;
#pragma unroll
        for (unsigned j = 0; j < 16; ++j) { const unsigned c = xb_ld(&bar[XB_XCNT(j)]); sum += c; cnt += (c > 0u) ? 1u : 0u; mine = (j == x) ? c : mine; }
        if (sum == G) break;
        __builtin_amdgcn_s_sleep(1);
        if ((++sp & 255u) == 0u) { if (xb_ld(&bar[XB_TMO])) break; if (sp > XB_SPIN_CAP) { atomicAdd(&bar[XB_TMO], 1u); break; } }
    }
    nloc = mine > 0u ? mine : 1u; nx = cnt > 0u ? cnt : 1u;
}

__device__ __forceinline__ void xcd_barrier(const XcdBarrier& b) {
    asm volatile("s_waitcnt vmcnt(0)" ::: "memory");
    __syncthreads();
    if (threadIdx.x == 0) {
        unsigned* bar = b.bar;
        __builtin_amdgcn_s_waitcnt(0);
        unsigned nloc = b.st[0], nx = b.st[1];
        if (nloc == 0u) { xcd_barrier_complete(bar, b.x, nloc, nx); b.st[0] = nloc; b.st[1] = nx; }
        const unsigned old = xb_add(&bar[XB_XSUB(b.x)], 1u);
        const unsigned gen = old / nloc;
        if (old + 1u == (gen + 1u) * nloc) {
            __builtin_amdgcn_fence(__ATOMIC_RELEASE, "agent");
            asm volatile("s_waitcnt vmcnt(0)" ::: "memory");
            const unsigned og = xb_add(&bar[XB_TOP], 1u);
            const unsigned tg = og / nx;
            if (og + 1u == (tg + 1u) * nx) xb_add(&bar[XB_TOPGEN], 1u);
            else XB_SPIN(xb_ld(&bar[XB_TOPGEN]) == tg, bar);
            __builtin_amdgcn_fence(__ATOMIC_ACQUIRE, "agent");
            xb_add(&bar[XB_XGEN(b.x)], 1u);
            asm volatile("s_waitcnt vmcnt(0)" ::: "memory");
        } else {
            XB_SPIN(xb_ld(&bar[XB_XGEN(b.x)]) == gen, bar);
            __builtin_amdgcn_fence(__ATOMIC_ACQUIRE, "agent");
            asm volatile("s_waitcnt vmcnt(0)" ::: "memory");
        }
    }
    __syncthreads();
}


#if MEGA
__global__ void __launch_bounds__(256, 2) mega_kernel(Params p) {
  __shared__ __attribute__((aligned(16))) char smem[SMEM_BYTES];
  __shared__ uint4 xb_words;
  cg::grid_group grid = cg::this_grid();
  const int bid = blockIdx.x, nblk = gridDim.x;
  if (threadIdx.x == 0) xb_words = make_uint4(0u, 0u, 0u, 0u);
  __syncthreads();
  XcdBarrier xb = xcd_barrier_post((unsigned*)(p.ws + OFF_BAR), (volatile LAS unsigned*)&xb_words);
#if TIMING
  if (tidx() == 0) { TSH[0] = __builtin_amdgcn_s_memrealtime(); TSH[1] = 0; TSH[2] = 0; }
#define TICK(ph) { if (tidx() == 0) { unsigned long long tn = __builtin_amdgcn_s_memrealtime(); if ((ph) == TIMING_A) TSH[1] += tn - TSH[0]; if ((ph) == TIMING_B) TSH[2] += tn - TSH[0]; TSH[0] = tn; } }
#else
#define TICK(ph)
#endif
  if (p.ws == nullptr) grid.sync();
  run_phase(p, 0, 0, bid, nblk, smem);
  xcd_barrier(xb);
  TICK(0)
#define PH(ph, l) run_phase(p, ph, l, bid, nblk, smem); xcd_barrier(xb); TICK(ph)
  PH(1, 0) PH(2, 0) PH(3, 0) PH(4, 0) PH(5, 0) PH(6, 0)
  PH(1, 1) PH(2, 1) PH(3, 1) PH(4, 1) PH(5, 1) PH(6, 1)
#undef PH
  run_phase(p, 7, 0, bid, nblk, smem);
#if TIMING
  grid.sync();
  TICK(7)
  __syncthreads();
  if (bid == 0) {
    const float ta = (float)(TSH[1]) * 1e-5f, tb = (float)(TSH[2]) * 1e-5f;
    if (tidx() == 0) p.out[0] += 0.5f * ta;
    for (int i = tidx(); i < 65536; i += 256) p.out[1024 + i] += 0.5f * tb;
  }
#endif
}
#else
__global__ void __launch_bounds__(256, 2) phase_kernel(Params p, int ph, int l) {
  __shared__ __attribute__((aligned(16))) char smem[SMEM_BYTES];
  run_phase(p, ph, l, blockIdx.x, gridDim.x, smem);
}
#endif

extern "C" void kernel_launch(void* const* d_in, const int* in_sizes, int n_in, void* d_out, int out_size, void* d_ws, size_t ws_size,
                              hipStream_t stream) {
  Params p{};
  const float** f = (const float**)&p;
  for (int i = 0; i < 22; ++i) f[i] = (const float*)d_in[i];
  p.out = (float*)d_out;
  p.ws = (char*)d_ws;
  if (WS_TOTAL > ws_size) { fprintf(stderr, "workspace too small: need %zu have %zu\n", (size_t)WS_TOTAL, ws_size); return; }
#if MEGA
  static int grid_blocks = 0;
  if (!grid_blocks) {
    int dev = 0, cus = 0, per_cu = 0;
    hipGetDevice(&dev);
    hipDeviceGetAttribute(&cus, hipDeviceAttributeMultiprocessorCount, dev);
    hipOccupancyMaxActiveBlocksPerMultiprocessor(&per_cu, mega_kernel, 256, 0);
    if (per_cu > 2) per_cu = 2;
    if (per_cu < 1) per_cu = 1;
    grid_blocks = cus * per_cu;
  }
  (void)hipMemsetAsync(p.ws + OFF_BAR, 0, BAR_BYTES, stream);
  void* args[] = {&p};
  hipError_t e = hipLaunchCooperativeKernel((void*)mega_kernel, dim3(grid_blocks), dim3(256), args, 0, stream);
  if (e != hipSuccess) fprintf(stderr, "cooperative launch failed: %s (grid %d)\n", hipGetErrorString(e), grid_blocks);
#else
  const int G = 1024;
  phase_kernel<<<G, 256, 0, stream>>>(p, 0, 0);
  for (int l = 0; l < 2; ++l)
    for (int ph = 1; ph <= 6; ++ph) phase_kernel<<<G, 256, 0, stream>>>(p, ph, l);
  phase_kernel<<<G, 256, 0, stream>>>(p, 7, 0);
#endif
}
```

```cpp
#include <hip/hip_runtime.h>
#include <hip/hip_cooperative_groups.h>
#include <cstdio>
namespace cg = cooperative_groups;

#ifndef MEGA
#define MEGA 1
#endif

#define DEV __device__ __forceinline__
typedef unsigned short bf16_t;
typedef short bf16x8 __attribute__((ext_vector_type(8)));
typedef float f32x4 __attribute__((ext_vector_type(4)));

constexpr int NB = 8, LSEQ = 4096, LCTX = 256, DM = 1024, NCOL = 3456;
constexpr int NLAT = NB * LSEQ, NCTXR = NB * LCTX, MROWS = NLAT + NCTXR;
constexpr int COL_AX = 0, COL_AG = 384, COL_BQ = 768, COL_BFF = 1152, COL_BFB = 1536, COL_BI = 1920, COL_BG = 2304,
              COL_CU = 2688, COL_CV = 2944, COL_CG = 3200;
constexpr int ACH = 136;
constexpr int BSL = 68;
constexpr int SMEM_BYTES = 76800;
constexpr float EPSV = 1e-6f;

constexpr size_t al256(size_t x) { return (x + 255) & ~(size_t)255; }
constexpr size_t OFF_WTIN = 0;
constexpr size_t OFF_WTOUT = OFF_WTIN + al256((size_t)2 * NCOL * 1024 * 2);
constexpr size_t OFF_GATEPACK = OFF_WTOUT + al256((size_t)2 * 1024 * 1024 * 2);
constexpr size_t OFF_HBUF = OFF_GATEPACK + al256((size_t)64 * 3072 * 2);
constexpr size_t OFF_PBUF = OFF_HBUF + al256((size_t)MROWS * 1024 * 2);
constexpr size_t OFF_KVBUF = OFF_PBUF + al256((size_t)MROWS * NCOL * 2);
constexpr size_t OFF_MOD = OFF_KVBUF + al256((size_t)64 * BSL * 9216 * 2);
constexpr size_t OFF_LBS = OFF_MOD + al256((size_t)2 * 9 * 3072 * 4);
constexpr size_t OFF_POSTAB = OFF_LBS + al256((size_t)3 * 384 * 4);
constexpr size_t OFF_CTXRES = OFF_POSTAB + al256((size_t)64 * 512 * 4);
constexpr size_t OFF_DECAY = OFF_CTXRES + al256((size_t)NCTXR * 1024 * 4);
constexpr size_t OFF_APH = OFF_DECAY + al256((size_t)64 * BSL * 96 * 4);
constexpr size_t OFF_ACARRY = OFF_APH + al256((size_t)NB * 2 * ACH * 384 * 2 * 4);
constexpr size_t OFF_SP = OFF_ACARRY + al256((size_t)NB * 2 * ACH * 384 * 4);
constexpr int SP_NORM_W = 0, SP_CONV_W = 2048, SP_CONV_B = 5120, SP_BR = 5888, SP_BI = 7424, SP_ASP = 8960, SP_BNW = 10496,
              SP_CNW = 11264, SP_CBS = 11776, SP_FNW = 12800, SP_TOTAL = 13824;
constexpr size_t OFF_CWS = OFF_SP + al256((size_t)SP_TOTAL * 4);
constexpr size_t OFF_BAR = OFF_CWS + al256((size_t)2 * 4 * 128 * 128 * 2);
constexpr size_t BAR_BYTES = 3456 * 4;
constexpr size_t OFF_X16 = OFF_BAR + al256(BAR_BYTES);
constexpr size_t WS_TOTAL = OFF_X16 + al256((size_t)NLAT * 1024 * 2);
static_assert(WS_TOTAL <= (size_t)512 * 1024 * 1024, "workspace budget");

struct Params {
  const float *x, *c, *ctx, *c_ctx, *norm_w, *w_mod, *b_mod, *w_in, *a_conv_w, *a_conv_b, *a_wr, *a_br, *a_wi, *a_bi,
      *a_lambda, *b_lb_logits, *b_norm_w, *c_norm_w, *c_ws, *c_bs, *w_out, *final_norm_w;
  float* out;
  char* ws;
  DEV bf16_t* wtin() const { return (bf16_t*)(ws + OFF_WTIN); }
  DEV bf16_t* wtout() const { return (bf16_t*)(ws + OFF_WTOUT); }
  DEV bf16_t* gatepack() const { return (bf16_t*)(ws + OFF_GATEPACK); }
  DEV bf16_t* hbuf() const { return (bf16_t*)(ws + OFF_HBUF); }
  DEV bf16_t* pbuf() const { return (bf16_t*)(ws + OFF_PBUF); }
  DEV bf16_t* kvbuf() const { return (bf16_t*)(ws + OFF_KVBUF); }
  DEV float* mod() const { return (float*)(ws + OFF_MOD); }
  DEV float* lbs() const { return (float*)(ws + OFF_LBS); }
  DEV float* postab() const { return (float*)(ws + OFF_POSTAB); }
  DEV float* ctxres() const { return (float*)(ws + OFF_CTXRES); }
  DEV float* decay() const { return (float*)(ws + OFF_DECAY); }
  DEV float* aPH() const { return (float*)(ws + OFF_APH); }
  DEV float* aCarry() const { return (float*)(ws + OFF_ACARRY); }
  DEV float* sp() const { return (float*)(ws + OFF_SP); }
  DEV bf16_t* cws() const { return (bf16_t*)(ws + OFF_CWS); }
  DEV bf16_t* x16() const { return (bf16_t*)(ws + OFF_X16); }
  DEV bf16_t* apk() const { return (bf16_t*)out; }
};

typedef __bf16 bf2_t __attribute__((ext_vector_type(2)));
typedef float f2_t __attribute__((ext_vector_type(2)));
DEV unsigned pack2(float lo, float hi) { f2_t v = {lo, hi}; bf2_t b = __builtin_convertvector(v, bf2_t); return __builtin_bit_cast(unsigned, b); }
DEV bf16_t f2bf(float f) { __bf16 b = (__bf16)f; return __builtin_bit_cast(unsigned short, b); }
DEV float bflo(unsigned u) { return __uint_as_float(u << 16); }
DEV float bfhi(unsigned u) { return __uint_as_float(u & 0xffff0000u); }
DEV float bf2f(bf16_t h) { return __uint_as_float(((unsigned)h) << 16); }
DEV void unpack8(const uint4& r, float* o) {
  o[0] = bflo(r.x); o[1] = bfhi(r.x); o[2] = bflo(r.y); o[3] = bfhi(r.y);
  o[4] = bflo(r.z); o[5] = bfhi(r.z); o[6] = bflo(r.w); o[7] = bfhi(r.w);
}
DEV float frcp(float x) { return __builtin_amdgcn_rcpf(x); }
DEV float sigm(float x) { return frcp(1.f + __expf(-x)); }
DEV float siluf(float x) { return x * frcp(1.f + __expf(-x)); }
DEV float geluf(float x) { float z = 1.5957691216f * (x + 0.044715f * x * x * x); return x * frcp(1.f + __expf(-z)); }
DEV f32x4 mfma16(bf16x8 a, bf16x8 b, f32x4 c) { return __builtin_amdgcn_mfma_f32_16x16x32_bf16(a, b, c, 0, 0, 0); }
DEV float row_sum16(float v) {
  v += __builtin_bit_cast(float, __builtin_amdgcn_update_dpp(0, __builtin_bit_cast(int, v), 0xB1, 0xf, 0xf, false));
  v += __builtin_bit_cast(float, __builtin_amdgcn_update_dpp(0, __builtin_bit_cast(int, v), 0x4E, 0xf, 0xf, false));
  v += __builtin_bit_cast(float, __builtin_amdgcn_update_dpp(0, __builtin_bit_cast(int, v), 0x124, 0xf, 0xf, false));
  v += __builtin_bit_cast(float, __builtin_amdgcn_update_dpp(0, __builtin_bit_cast(int, v), 0x128, 0xf, 0xf, false));
  return v;
}
DEV int tidx() { int t = threadIdx.x; asm volatile("" : "+v"(t)); return t; }
DEV float wave_sum(float v) {
#pragma unroll
  for (int o = 32; o > 0; o >>= 1) v += __shfl_xor(v, o);
  return v;
}

DEV void prep_mod(const Params& p, int task, char* smem) {
  const int l = task / 192, j0 = (task % 192) * 16, tid = tidx();
  float* sv = (float*)smem;
  float* red = sv + 9 * 1024;
  for (int i = tid; i < 9 * 1024; i += 256) { int r = i >> 10, k = i & 1023; float v = (r < 8) ? p.c[r * 1024 + k] : p.c_ctx[k]; sv[i] = siluf(v); }
  __syncthreads();
  const int kg = tid >> 4, col = tid & 15;
  float acc[9];
#pragma unroll
  for (int r = 0; r < 9; ++r) acc[r] = 0.f;
  const float* w = p.w_mod + (size_t)l * 1024 * 3072 + j0 + col;
#pragma unroll 1
  for (int k = kg * 64; k < kg * 64 + 64; k += 16) {
    float wv[16];
#pragma unroll
    for (int u = 0; u < 16; ++u) wv[u] = w[(size_t)(k + u) * 3072];
#pragma unroll
    for (int u = 0; u < 16; ++u)
#pragma unroll
      for (int r = 0; r < 9; ++r) acc[r] += sv[r * 1024 + k + u] * wv[u];
  }
#pragma unroll
  for (int r = 0; r < 9; ++r) red[(kg * 9 + r) * 16 + col] = acc[r];
  __syncthreads();
  if (tid < 144) {
    int r = tid >> 4, cc = tid & 15; float s = 0.f;
#pragma unroll
    for (int g = 0; g < 16; ++g) s += red[(g * 9 + r) * 16 + cc];
    p.mod()[(l * 9 + r) * 3072 + j0 + cc] = s + p.b_mod[l * 3072 + j0 + cc];
  }
  __syncthreads();
}

DEV void prep_transpose(const float* __restrict__ src, bf16_t* __restrict__ dst, int N, int kt, int nt, char* smem) {
  float* tile = (float*)smem;
  const int tid = tidx(), r = tid >> 4, c4 = tid & 15;
#pragma unroll
  for (int i = 0; i < 4; ++i) {
    float4 v = *(const float4*)(src + (size_t)(kt * 64 + r + 16 * i) * N + nt * 64 + c4 * 4);
    float* t = tile + (r + 16 * i) * 65 + c4 * 4;
    t[0] = v.x; t[1] = v.y; t[2] = v.z; t[3] = v.w;
  }
  __syncthreads();
  const int n = tid >> 2, kq = tid & 3;
  unsigned o[8];
#pragma unroll
  for (int e = 0; e < 8; ++e) o[e] = pack2(tile[(kq * 16 + 2 * e) * 65 + n], tile[(kq * 16 + 2 * e + 1) * 65 + n]);
  uint4* d = (uint4*)(dst + (size_t)(nt * 64 + n) * 1024 + kt * 64 + kq * 16);
  d[0] = make_uint4(o[0], o[1], o[2], o[3]);
  d[1] = make_uint4(o[4], o[5], o[6], o[7]);
  __syncthreads();
}

DEV void phase_prep(const Params& p, int bid, int nblk, char* smem) {
  const int tid = tidx();
  constexpr int T_MOD = 384, T_LBS = 1, T_POS = 64, T_GP = 64, T_WIN = 2 * 16 * 54, T_WOUT = 2 * 16 * 16;
  constexpr int T_CP = 18;
  constexpr int NT = T_MOD + T_CP + T_LBS + T_POS + T_GP + T_WIN + T_WOUT;
  for (int task = bid; task < NT; task += nblk) {
    int t = task;
    if (t < T_MOD) { prep_mod(p, t, smem); continue; }
    t -= T_MOD;
    if (t < T_CP) {
      if (t >= 10) {
        const float* s = p.c_ws + (t - 10) * 16384; bf16_t* dd = p.cws() + (t - 10) * 16384;
        for (int i = tid; i < 16384; i += 256) dd[i] = f2bf(s[i]);
        continue;
      }
      const float* s; int off, n;
      switch (t) {
        case 0: s = p.norm_w; off = SP_NORM_W; n = 2048; break;
        case 1: s = p.a_conv_w; off = SP_CONV_W; n = 3072; break;
        case 2: s = p.a_conv_b; off = SP_CONV_B; n = 768; break;
        case 3: s = p.a_br; off = SP_BR; n = 1536; break;
        case 4: s = p.a_bi; off = SP_BI; n = 1536; break;
        case 5: s = p.a_lambda; off = SP_ASP; n = 1536; break;
        case 6: s = p.b_norm_w; off = SP_BNW; n = 768; break;
        case 7: s = p.c_norm_w; off = SP_CNW; n = 512; break;
        case 8: s = p.c_bs; off = SP_CBS; n = 1024; break;
        default: s = p.final_norm_w; off = SP_FNW; n = 1024; break;
      }
      float* dd = p.sp() + off;
      for (int i = tid; i < n; i += 256) { float v = s[i]; if (t == 5) v = 8.f * log1pf(expf(-v)); dd[i] = v; }
      continue;
    }
    t -= T_CP;
    if (t < T_LBS) {
      for (int i = tid; i < 384; i += 256) {
        float a = p.b_lb_logits[i], b = p.b_lb_logits[384 + i], cc = p.b_lb_logits[768 + i];
        float m = fmaxf(a, fmaxf(b, cc));
        float ea = expf(a - m), eb = expf(b - m), ec = expf(cc - m), inv = 1.f / (ea + eb + ec);
        p.lbs()[i] = ea * inv; p.lbs()[384 + i] = (ea + eb) * inv; p.lbs()[768 + i] = 1.f;
      }
      continue;
    }
    t -= T_LBS;
    if (t < T_POS) {
      int i = tid;
      float om = 1.0f / powf(10000.0f, (float)i / 256.0f);
      float ang = (float)t * om;
      p.postab()[t * 512 + i] = sinf(ang);
      p.postab()[t * 512 + 256 + i] = cosf(ang);
      continue;
    }
    t -= T_POS;
    if (t < T_GP) {
      const int mat = t & 1, ldh = t >> 1;
      const float* W = (mat ? p.a_wi : p.a_wr) + (size_t)ldh * 2304;
      bf16_t* dst = p.gatepack() + (size_t)t * 3072;
      for (int idx = tid; idx < 3072; idx += 256) {
        int jj = idx & 7, lane = (idx >> 3) & 63, nt = (idx >> 9) % 3, ks = idx / 1536;
        int k = ks * 32 + (lane >> 4) * 8 + jj, n = nt * 16 + (lane & 15);
        float v = (k < 48) ? W[k * 48 + n] : 0.f;
        dst[idx] = f2bf(v);
      }
      continue;
    }
    t -= T_GP;
    if (t < T_WIN) {
      int l = t / (16 * 54), r = t % (16 * 54);
      prep_transpose(p.w_in + (size_t)l * 1024 * NCOL, p.wtin() + (size_t)l * NCOL * 1024, NCOL, r / 54, r % 54, smem);
      continue;
    }
    t -= T_WIN;
    {
      int l = t / 256, r = t % 256;
      prep_transpose(p.w_out + (size_t)l * 1024 * 1024, p.wtout() + (size_t)l * 1024 * 1024, 1024, r / 16, r % 16, smem);
    }
  }
}

DEV void phase_norm(const Params& p, int layer, int bid, int nblk) {
  const int tid = tidx(), lane = tid & 63;
  const int wave = __builtin_amdgcn_readfirstlane(tid >> 6);
  const float* nwp = p.sp() + SP_NORM_W + layer * 1024;
  const int nwv = nblk * 4, per = (MROWS + nwv - 1) / nwv;
  const int r_begin = (bid * 4 + wave) * per;
  int r_end = r_begin + per; if (r_end > MROWS) r_end = MROWS;
  float4 nw[4], sh[4], sc[4];
#pragma unroll
  for (int i = 0; i < 4; ++i) { nw[i] = *(const float4*)(nwp + i * 256 + lane * 4); sh[i] = nw[i]; sc[i] = nw[i]; }
  int cur_m = -1;
  for (int row0 = r_begin; row0 < r_end; row0 += 2) {
    float4 v[2][4]; float ss[2]; int rows[2], mrows[2];
    const bool valid1 = row0 + 1 < r_end;
#pragma unroll
    for (int u = 0; u < 2; ++u) {
      const int row = (u == 1 && valid1) ? row0 + 1 : row0;
      rows[u] = row;
      const bool isctx = row >= NLAT;
      const float* src; float* res; int t = 0;
      if (!isctx) { t = row & 4095; src = (layer == 0 ? p.x : p.out) + (size_t)row * 1024; res = p.out + (size_t)row * 1024; mrows[u] = row >> 12; }
      else { int r2 = row - NLAT; src = (layer == 0 ? p.ctx : p.ctxres()) + (size_t)r2 * 1024; res = p.ctxres() + (size_t)r2 * 1024; mrows[u] = 8; }
      float s = 0.f;
#pragma unroll
      for (int i = 0; i < 4; ++i) {
        int col = i * 256 + lane * 4;
        float4 a;
        if (layer == 1 && !isctx) { const uint2 w_ = *(const uint2*)(p.x16() + (size_t)row * 1024 + col); a = make_float4(bflo(w_.x), bfhi(w_.x), bflo(w_.y), bfhi(w_.y)); }
        else a = *(const float4*)(src + col);
        if (layer == 0) {
          if (!isctx) {
            const float* tp = p.postab() + ((i < 2) ? (t >> 6) : (t & 63)) * 512 + (col & 511);
            float4 q = *(const float4*)tp;
            a.x += q.x; a.y += q.y; a.z += q.z; a.w += q.w;
          }
        }
        v[u][i] = a;
        s += a.x * a.x + a.y * a.y + a.z * a.z + a.w * a.w;
      }
      ss[u] = s;
    }
#pragma unroll
    for (int u = 0; u < 2; ++u) {
      if (u == 1 && !valid1) break;
      if (mrows[u] != cur_m) {
        cur_m = mrows[u];
        const float* modp = p.mod() + (layer * 9 + cur_m) * 3072;
#pragma unroll
        for (int i = 0; i < 4; ++i) { sh[i] = *(const float4*)(modp + i * 256 + lane * 4); sc[i] = *(const float4*)(modp + 1024 + i * 256 + lane * 4); }
      }
      const float rstd = rsqrtf(wave_sum(ss[u]) * (1.f / 1024.f) + EPSV);
#pragma unroll
      for (int i = 0; i < 4; ++i) {
        int col = i * 256 + lane * 4;
        float h0 = v[u][i].x * rstd * nw[i].x * (1.f + sc[i].x) + sh[i].x;
        float h1 = v[u][i].y * rstd * nw[i].y * (1.f + sc[i].y) + sh[i].y;
        float h2 = v[u][i].z * rstd * nw[i].z * (1.f + sc[i].z) + sh[i].z;
        float h3 = v[u][i].w * rstd * nw[i].w * (1.f + sc[i].w) + sh[i].w;
        *(uint2*)(p.hbuf() + (size_t)rows[u] * 1024 + col) = make_uint2(pack2(h0, h1), pack2(h2, h3));
      }
    }
  }
}

DEV void phase_final(const Params& p, int bid, int nblk) {
  const int tid = tidx(), lane = tid & 63;
  const int wave = __builtin_amdgcn_readfirstlane(tid >> 6);
  const int nwv = nblk * 4, per = (NLAT + nwv - 1) / nwv;
  const int r_begin = (bid * 4 + wave) * per;
  int r_end = r_begin + per; if (r_end > NLAT) r_end = NLAT;
  const float* fwp = p.sp() + SP_FNW;
  float4 fw[4];
#pragma unroll
  for (int i = 0; i < 4; ++i) fw[i] = *(const float4*)(fwp + i * 256 + lane * 4);
  for (int row0 = r_begin; row0 < r_end; row0 += 2) {
    const bool valid1 = row0 + 1 < r_end;
    float4 v[2][4]; float ss[2];
#pragma unroll
    for (int u = 0; u < 2; ++u) {
      const bf16_t* src = p.x16() + (size_t)((u == 1 && valid1) ? row0 + 1 : row0) * 1024;
      float s = 0.f;
#pragma unroll
      for (int i = 0; i < 4; ++i) { const uint2 w_ = *(const uint2*)(src + i * 256 + lane * 4); v[u][i] = make_float4(bflo(w_.x), bfhi(w_.x), bflo(w_.y), bfhi(w_.y)); s += v[u][i].x * v[u][i].x + v[u][i].y * v[u][i].y + v[u][i].z * v[u][i].z + v[u][i].w * v[u][i].w; }
      ss[u] = s;
    }
#pragma unroll
    for (int u = 0; u < 2; ++u) {
      if (u == 1 && !valid1) break;
      float* dst = p.out + (size_t)(row0 + u) * 1024;
      const float rstd = rsqrtf(wave_sum(ss[u]) * (1.f / 1024.f) + EPSV);
#pragma unroll
      for (int i = 0; i < 4; ++i) {
        int col = i * 256 + lane * 4;
        float4 o; o.x = v[u][i].x * rstd * fw[i].x; o.y = v[u][i].y * rstd * fw[i].y; o.z = v[u][i].z * rstd * fw[i].z; o.w = v[u][i].w * rstd * fw[i].w;
        *(float4*)(dst + col) = o;
      }
    }
  }
}

constexpr int GLD = 72;
template <int EPI, int MODE = 0>
DEV void phase_gemm(const Params& p, int layer, const bf16_t* __restrict__ A, const bf16_t* __restrict__ Bt, int M, int N, char* smem, int bid, int nblk, int big_done = 0) {
  constexpr int K = 1024;
  bf16_t* As = (bf16_t*)smem;
  bf16_t* Bs = As + 2 * 128 * GLD;
  const int tid = tidx(), lane = tid & 63, wave = tid >> 6, quad = lane >> 4, l15 = lane & 15;
  const int wm = wave >> 1, wn = wave & 1;
  const int lrow = tid >> 3, lkc = tid & 7;
  const int nN = N / 128, T = (M / 128) * nN;
  const int xcd = bid & 7, jb = bid >> 3, per = nblk >> 3;
  const int Tx = (T + 7) >> 3;
  const int t_begin = xcd * Tx + jb;
  int t_end = (xcd + 1) * Tx; if (t_end > T) t_end = T;
  int ntl = (t_end - t_begin + per - 1) / per; if (t_end <= t_begin) ntl = 0;
  const int TxB = (((M / 256) * nN) + 7) >> 3;
  int tB_end = (xcd + 1) * TxB; if (tB_end > (M / 256) * nN) tB_end = (M / 256) * nN;
  const int tB_left0 = xcd * TxB + big_done * per;
  if (MODE == 1) ntl = (tB_left0 + (jb >> 1) < tB_end) ? 1 : 0;
  const int nsteps = ntl * 16;
#define G_TILE_OF(i, pm, pn) { if (MODE == 1) { const int t_ = tB_left0 + (jb >> 1); const int g_ = t_ / (8 * nN), r_ = t_ - g_ * 8 * nN; pn = r_ >> 3; pm = 2 * (g_ * 8 + (r_ & 7)) + (jb & 1); } \
    else { const int t_ = t_begin + per * (i); const int g_ = t_ / (8 * nN), r_ = t_ - g_ * 8 * nN; pn = r_ >> 3; pm = g_ * 8 + (r_ & 7); } }
#define G_LOAD(s, a, b) { int pm_, pn_; G_TILE_OF((s) >> 4, pm_, pn_); \
    const bf16_t* Ag_ = A + (size_t)(pm_ * 128 + lrow) * K + lkc * 8 + ((s) & 15) * 64; \
    const bf16_t* Bg_ = Bt + (size_t)(pn_ * 128 + lrow) * K + lkc * 8 + ((s) & 15) * 64; \
    a##0 = *(const uint4*)(Ag_); a##1 = *(const uint4*)(Ag_ + (size_t)32 * K); a##2 = *(const uint4*)(Ag_ + (size_t)64 * K); a##3 = *(const uint4*)(Ag_ + (size_t)96 * K); \
    b##0 = *(const uint4*)(Bg_); b##1 = *(const uint4*)(Bg_ + (size_t)32 * K); b##2 = *(const uint4*)(Bg_ + (size_t)64 * K); b##3 = *(const uint4*)(Bg_ + (size_t)96 * K); }
#define G_LSTORE(buf, a, b) { bf16_t* ad_ = As + (buf) * 128 * GLD + lrow * GLD + lkc * 8; bf16_t* bd_ = Bs + (buf) * 128 * GLD + lrow * GLD + lkc * 8; \
    *(uint4*)(ad_) = a##0; *(uint4*)(ad_ + 32 * GLD) = a##1; *(uint4*)(ad_ + 64 * GLD) = a##2; *(uint4*)(ad_ + 96 * GLD) = a##3; \
    *(uint4*)(bd_) = b##0; *(uint4*)(bd_ + 32 * GLD) = b##1; *(uint4*)(bd_ + 64 * GLD) = b##2; *(uint4*)(bd_ + 96 * GLD) = b##3; }
#define G_ZERO() { _Pragma("unroll") for (int i_ = 0; i_ < 4; ++i_) _Pragma("unroll") for (int j_ = 0; j_ < 4; ++j_) acc[i_][j_] = (f32x4){0.f, 0.f, 0.f, 0.f}; }
#define G_COMPUTE(buf) { \
    const bf16_t* as_ = As + (buf) * 128 * GLD + (wm * 64 + l15) * GLD + quad * 8; \
    const bf16_t* bs_ = Bs + (buf) * 128 * GLD + (wn * 64 + l15) * GLD + quad * 8; \
    _Pragma("unroll") for (int ks_ = 0; ks_ < 2; ++ks_) { \
      bf16x8 af_[4], bf_[4]; \
      _Pragma("unroll") for (int i_ = 0; i_ < 4; ++i_) { af_[i_] = *(const bf16x8*)(as_ + i_ * 16 * GLD + ks_ * 32); bf_[i_] = *(const bf16x8*)(bs_ + i_ * 16 * GLD + ks_ * 32); } \
      __builtin_amdgcn_s_setprio(1); \
      _Pragma("unroll") for (int mi_ = 0; mi_ < 4; ++mi_) _Pragma("unroll") for (int ni_ = 0; ni_ < 4; ++ni_) acc[mi_][ni_] = mfma16(bf_[ni_], af_[mi_], acc[mi_][ni_]); \
      __builtin_amdgcn_s_setprio(0); } }
  f32x4 acc[4][4];
  if (nsteps > 0) {
    uint4 ra00, ra01, ra02, ra03, rb00, rb01, rb02, rb03, ra10, ra11, ra12, ra13, rb10, rb11, rb12, rb13;
    G_LOAD(0, ra0, rb0); G_LOAD(1, ra1, rb1);
    G_LSTORE(0, ra0, rb0);
    __syncthreads();
    G_ZERO();
    for (int s = 0; s < nsteps; s += 2) {
      { const int s2_ = (s + 2 < nsteps) ? s + 2 : nsteps - 1; G_LOAD(s2_, ra0, rb0); }
      G_COMPUTE(0);
      G_LSTORE(1, ra1, rb1);
      __syncthreads();
      { const int s3_ = (s + 3 < nsteps) ? s + 3 : nsteps - 1; G_LOAD(s3_, ra1, rb1); }
      G_COMPUTE(1);
      if ((s & 15) == 14) {
        int pm, pn; G_TILE_OF(s >> 4, pm, pn);
        const int row0 = pm * 128 + wm * 64 + l15, c0 = pn * 128 + wn * 64 + 4 * quad;
        if (EPI == 0) {
#pragma unroll
          for (int mi = 0; mi < 4; ++mi) {
            bf16_t* dst = p.pbuf() + (size_t)(row0 + mi * 16) * NCOL + c0;
#pragma unroll
            for (int ni = 0; ni < 4; ++ni) *(uint2*)(dst + ni * 16) = make_uint2(pack2(acc[mi][ni][0], acc[mi][ni][1]), pack2(acc[mi][ni][2], acc[mi][ni][3]));
          }
        } else {
          const bool lat = pm * 128 < NLAT;
          float* res = lat ? p.out + (size_t)row0 * 1024 + c0 : p.ctxres() + (size_t)(row0 - NLAT) * 1024 + c0;
          const float* g = p.mod() + (layer * 9 + (lat ? (pm * 128) >> 12 : 8)) * 3072 + 2048 + c0;
          const float* rsrc = (layer == 0) ? (lat ? p.x + (size_t)row0 * 1024 + c0 : p.ctx + (size_t)(row0 - NLAT) * 1024 + c0) : (const float*)res;
          bf16_t* x16p = p.x16() + (size_t)(lat ? row0 : 0) * 1024 + c0;
          const bool addpos = (layer == 0) && lat;
          const float* ptab = p.postab() + (c0 & 511);
          const bool rowhalf = c0 < 512;
          float4 gg[4], r[4], rn[4];
#define G_RLOAD(dst, mi_) { _Pragma("unroll") for (int ni = 0; ni < 4; ++ni) { \
            float4 v_; \
            if (layer == 0) v_ = *(const float4*)(rsrc + (size_t)(mi_) * 16 * 1024 + ni * 16); \
            else { const uint2 w_ = *(const uint2*)(x16p + (size_t)(mi_) * 16 * 1024 + ni * 16); v_ = make_float4(bflo(w_.x), bfhi(w_.x), bflo(w_.y), bfhi(w_.y)); } \
            if (addpos) { const int t_ = (row0 + (mi_) * 16) & 4095; const float4 q_ = *(const float4*)(ptab + (rowhalf ? (t_ >> 6) : (t_ & 63)) * 512 + ni * 16); \
              v_.x += q_.x; v_.y += q_.y; v_.z += q_.z; v_.w += q_.w; } \
            dst[ni] = v_; } }
#pragma unroll
          for (int ni = 0; ni < 4; ++ni) gg[ni] = *(const float4*)(g + ni * 16);
          G_RLOAD(r, 0);
#pragma unroll
          for (int mi = 0; mi < 4; ++mi) {
            if (mi < 3) G_RLOAD(rn, mi + 1);
#pragma unroll
            for (int ni = 0; ni < 4; ++ni) {
              float4 o = r[ni];
              o.x += gg[ni].x * acc[mi][ni][0]; o.y += gg[ni].y * acc[mi][ni][1]; o.z += gg[ni].z * acc[mi][ni][2]; o.w += gg[ni].w * acc[mi][ni][3];
              if (lat) *(uint2*)(x16p + (size_t)mi * 16 * 1024 + ni * 16) = make_uint2(pack2(o.x, o.y), pack2(o.z, o.w));
              else *(float4*)(res + (size_t)mi * 16 * 1024 + ni * 16) = o;
            }
#pragma unroll
            for (int ni = 0; ni < 4; ++ni) r[ni] = rn[ni];
          }
#undef G_RLOAD
        }
        G_ZERO();
      }
      G_LSTORE(0, ra0, rb0);
      __syncthreads();
    }
  }
#undef G_TILE_OF
#undef G_LOAD
#undef G_LSTORE
#undef G_ZERO
#undef G_COMPUTE
}

DEV void phase_gemm_big(const Params& p, const bf16_t* __restrict__ A, const bf16_t* __restrict__ Bt, int M, int N, char* smem, int bid, int nblk, int max_tiles) {
  constexpr int K = 1024;
  bf16_t* As = (bf16_t*)smem;
  bf16_t* Bs = As + 256 * GLD;
  const int tid = tidx(), lane = tid & 63, wave = tid >> 6, quad = lane >> 4, l15 = lane & 15;
  const int wm = wave >> 1, wn = wave & 1;
  const int lrow = tid >> 3, lkc = tid & 7;
  const int nN = N / 128, T = (M / 256) * nN;
  const int xcd = bid & 7, jb = bid >> 3, per = nblk >> 3;
  const int Tx = (T + 7) >> 3;
  const int t_begin = xcd * Tx + jb;
  int t_end = (xcd + 1) * Tx; if (t_end > T) t_end = T;
  int ntl = (t_end - t_begin + per - 1) / per; if (t_end <= t_begin) ntl = 0;
  if (ntl > max_tiles) ntl = max_tiles;
  const int nsteps = ntl * 16;
#define GB_TILE_OF(i, pm, pn) { const int t_ = t_begin + per * (i); const int g_ = t_ / (8 * nN), r_ = t_ - g_ * 8 * nN; pn = r_ >> 3; pm = g_ * 8 + (r_ & 7); }
#define GB_LOAD(s) { int pm_, pn_; GB_TILE_OF((s) >> 4, pm_, pn_); \
    const bf16_t* Ag_ = A + (size_t)(pm_ * 256 + lrow) * K + lkc * 8 + ((s) & 15) * 64; \
    const bf16_t* Bg_ = Bt + (size_t)(pn_ * 128 + lrow) * K + lkc * 8 + ((s) & 15) * 64; \
    ra0 = *(const uint4*)(Ag_); ra1 = *(const uint4*)(Ag_ + (size_t)32 * K); ra2 = *(const uint4*)(Ag_ + (size_t)64 * K); ra3 = *(const uint4*)(Ag_ + (size_t)96 * K); \
    ra4 = *(const uint4*)(Ag_ + (size_t)128 * K); ra5 = *(const uint4*)(Ag_ + (size_t)160 * K); ra6 = *(const uint4*)(Ag_ + (size_t)192 * K); ra7 = *(const uint4*)(Ag_ + (size_t)224 * K); \
    rb0 = *(const uint4*)(Bg_); rb1 = *(const uint4*)(Bg_ + (size_t)32 * K); rb2 = *(const uint4*)(Bg_ + (size_t)64 * K); rb3 = *(const uint4*)(Bg_ + (size_t)96 * K); }
#define GB_LSTORE() { bf16_t* ad_ = As + lrow * GLD + lkc * 8; bf16_t* bd_ = Bs + lrow * GLD + lkc * 8; \
    *(uint4*)(ad_) = ra0; *(uint4*)(ad_ + 32 * GLD) = ra1; *(uint4*)(ad_ + 64 * GLD) = ra2; *(uint4*)(ad_ + 96 * GLD) = ra3; \
    *(uint4*)(ad_ + 128 * GLD) = ra4; *(uint4*)(ad_ + 160 * GLD) = ra5; *(uint4*)(ad_ + 192 * GLD) = ra6; *(uint4*)(ad_ + 224 * GLD) = ra7; \
    *(uint4*)(bd_) = rb0; *(uint4*)(bd_ + 32 * GLD) = rb1; *(uint4*)(bd_ + 64 * GLD) = rb2; *(uint4*)(bd_ + 96 * GLD) = rb3; }
  f32x4 acc[8][4];
  if (nsteps > 0) {
    uint4 ra0, ra1, ra2, ra3, ra4, ra5, ra6, ra7, rb0, rb1, rb2, rb3;
    GB_LOAD(0);
    GB_LSTORE();
    __syncthreads();
#pragma unroll
    for (int i = 0; i < 8; ++i)
#pragma unroll
      for (int j = 0; j < 4; ++j) acc[i][j] = (f32x4){0.f, 0.f, 0.f, 0.f};
    const bf16_t* as_ = As + (wm * 128 + l15) * GLD + quad * 8;
    const bf16_t* bs_ = Bs + (wn * 64 + l15) * GLD + quad * 8;
    for (int s = 0; s < nsteps; ++s) {
      { const int s1_ = (s + 1 < nsteps) ? s + 1 : nsteps - 1; GB_LOAD(s1_); }
#pragma unroll
      for (int ks = 0; ks < 2; ++ks) {
        bf16x8 bf_[4];
#pragma unroll
        for (int i = 0; i < 4; ++i) bf_[i] = *(const bf16x8*)(bs_ + i * 16 * GLD + ks * 32);
#pragma unroll
        for (int hm = 0; hm < 2; ++hm) {
          bf16x8 af_[4];
#pragma unroll
          for (int i = 0; i < 4; ++i) af_[i] = *(const bf16x8*)(as_ + (hm * 4 + i) * 16 * GLD + ks * 32);
#pragma unroll
          for (int mi = 0; mi < 4; ++mi)
#pragma unroll
            for (int ni = 0; ni < 4; ++ni) acc[hm * 4 + mi][ni] = mfma16(bf_[ni], af_[mi], acc[hm * 4 + mi][ni]);
        }
      }
      if ((s & 15) == 15) {
        int pm, pn; GB_TILE_OF(s >> 4, pm, pn);
        const int row0 = pm * 256 + wm * 128 + l15, c0 = pn * 128 + wn * 64 + 4 * quad;
#pragma unroll
        for (int mi = 0; mi < 8; ++mi) {
          bf16_t* dst = p.pbuf() + (size_t)(row0 + mi * 16) * NCOL + c0;
#pragma unroll
          for (int ni = 0; ni < 4; ++ni) {
            *(uint2*)(dst + ni * 16) = make_uint2(pack2(acc[mi][ni][0], acc[mi][ni][1]), pack2(acc[mi][ni][2], acc[mi][ni][3]));
            acc[mi][ni] = (f32x4){0.f, 0.f, 0.f, 0.f};
          }
        }
      }
      __syncthreads();
      GB_LSTORE();
      __syncthreads();
    }
  }
#undef GB_TILE_OF
#undef GB_LOAD
#undef GB_LSTORE
}

DEV void a_chunk(const Params& p, int l, int b, int sc, bool fin, char* smem) {
  float* xcf = (float*)smem;
  bf16_t* xcb = (bf16_t*)(smem + 32 * 388 * 4);
  const int tid = tidx(), lane = tid & 63, wave = tid >> 6, quad = lane >> 4, l15 = lane & 15;
  int t0, Lseg; size_t rowbase;
  if (sc < 8) { t0 = sc * 32; Lseg = LCTX; rowbase = (size_t)NLAT + (size_t)b * LCTX; }
  else { t0 = (sc - 8) * 32; Lseg = LSEQ; rowbase = (size_t)b * LSEQ; }
  const float* cw = p.sp() + SP_CONV_W + l * 4 * 384;
  const float* cb = p.sp() + SP_CONV_B + l * 384;
  if (tid < 192) {
    const int cg = tid % 48, sg = tid / 48, ch0 = cg * 8, tb = sg * 8;
    uint4 rawr[11];
#pragma unroll
    for (int r = 0; r < 11; ++r) {
      const int tt = t0 + tb + r - 2;
      const int ttc = tt < 0 ? 0 : (tt >= Lseg ? Lseg - 1 : tt);
      rawr[r] = *(const uint4*)(p.pbuf() + (rowbase + ttc) * NCOL + COL_AX + ch0);
      if (tt != ttc) rawr[r] = make_uint4(0u, 0u, 0u, 0u);
    }
    float wv[4][8], bv[8];
    { const float4 b0 = *(const float4*)(cb + ch0), b1 = *(const float4*)(cb + ch0 + 4);
      bv[0] = b0.x; bv[1] = b0.y; bv[2] = b0.z; bv[3] = b0.w; bv[4] = b1.x; bv[5] = b1.y; bv[6] = b1.z; bv[7] = b1.w; }
#pragma unroll
    for (int w = 0; w < 4; ++w) {
      const float4 w0 = *(const float4*)(cw + w * 384 + ch0), w1 = *(const float4*)(cw + w * 384 + ch0 + 4);
      wv[w][0] = w0.x; wv[w][1] = w0.y; wv[w][2] = w0.z; wv[w][3] = w0.w; wv[w][4] = w1.x; wv[w][5] = w1.y; wv[w][6] = w1.z; wv[w][7] = w1.w;
    }
#pragma unroll
    for (int j = 0; j < 8; ++j) {
      float acc[8];
#pragma unroll
      for (int e = 0; e < 8; ++e) acc[e] = bv[e];
#pragma unroll
      for (int w = 0; w < 4; ++w) {
        float xs[8]; unpack8(rawr[j + w], xs);
#pragma unroll
        for (int e = 0; e < 8; ++e) acc[e] += xs[e] * wv[w][e];
      }
      const int t = tb + j;
      *(float4*)(xcf + t * 388 + ch0) = make_float4(acc[0], acc[1], acc[2], acc[3]);
      *(float4*)(xcf + t * 388 + ch0 + 4) = make_float4(acc[4], acc[5], acc[6], acc[7]);
      *(uint4*)(xcb + t * 392 + ch0) = make_uint4(pack2(acc[0], acc[1]), pack2(acc[2], acc[3]), pack2(acc[4], acc[5]), pack2(acc[6], acc[7]));
    }
  }
  __syncthreads();
  bf16x8 wrN[2][2], wiN[2][2]; float brN[2], biN[2], spN[2], hcN[2]; bf16_t gtN[2][4];
#define A_LOAD(HN) { \
    const int h_ = wave * 2 + (HN) / 3, nt_ = (HN) % 3, ch_ = h_ * 48 + nt_ * 16 + l15; \
    _Pragma("unroll") for (int d_ = 0; d_ < 2; ++d_) { \
      const bf16x8* gp_ = (const bf16x8*)p.gatepack() + (size_t)(((l * 2 + d_) * 8 + h_) * 2) * 6 * 64 + lane; \
      _Pragma("unroll") for (int ks_ = 0; ks_ < 2; ++ks_) { wrN[d_][ks_] = gp_[(ks_ * 3 + nt_) * 64]; wiN[d_][ks_] = gp_[(6 + ks_ * 3 + nt_) * 64]; } \
      brN[d_] = p.sp()[SP_BR + (l * 2 + d_) * 384 + ch_]; biN[d_] = p.sp()[SP_BI + (l * 2 + d_) * 384 + ch_]; \
      spN[d_] = p.sp()[SP_ASP + (l * 2 + d_) * 384 + ch_]; \
      hcN[d_] = fin ? p.aCarry()[((size_t)(b * 2 + d_) * ACH + sc) * 384 + ch_] : 0.f; } \
    if (fin) { _Pragma("unroll") for (int mt_ = 0; mt_ < 2; ++mt_) _Pragma("unroll") for (int jj_ = 0; jj_ < 4; ++jj_) \
      gtN[mt_][jj_] = p.pbuf()[(rowbase + t0 + mt_ * 16 + quad * 4 + jj_) * NCOL + COL_AG + ch_]; } }
  A_LOAD(0);
#pragma unroll 1
  for (int hn = 0; hn < 6; ++hn) {
    const int h = wave * 2 + hn / 3, nt = hn % 3;
    const int ch = h * 48 + nt * 16 + l15;
    f32x4 hf[2], pfv[2];
    bf16x8 wrA[2][2], wiA[2][2]; float brA[2], biA[2], spA[2], hcA[2]; bf16_t gtA[2][4];
#pragma unroll
    for (int d = 0; d < 2; ++d) {
#pragma unroll
      for (int ks = 0; ks < 2; ++ks) { wrA[d][ks] = wrN[d][ks]; wiA[d][ks] = wiN[d][ks]; }
      brA[d] = brN[d]; biA[d] = biN[d]; spA[d] = spN[d]; hcA[d] = hcN[d];
    }
#pragma unroll
    for (int mt = 0; mt < 2; ++mt)
#pragma unroll
      for (int jj = 0; jj < 4; ++jj) gtA[mt][jj] = gtN[mt][jj];
    { const int hn2 = hn < 5 ? hn + 1 : 5; A_LOAD(hn2); }
#pragma unroll
    for (int d = 0; d < 2; ++d) {
      const bf16x8 (&wr)[2] = wrA[d]; const bf16x8 (&wi)[2] = wiA[d];
      const size_t cidx = ((size_t)(b * 2 + d) * ACH + sc) * 384;
      const float br = brA[d], bi = biA[d], sp = spA[d];
      float hc = hcA[d], Pc = 1.f;
      const int lq = d ? 3 - quad : quad;
      const int s1 = d ? ((lane + 16) & 63) : ((lane - 16) & 63), s2 = d ? ((lane + 32) & 63) : ((lane - 32) & 63);
      const int lastl = d ? l15 : 48 + l15;
#pragma unroll
      for (int mi = 0; mi < 2; ++mi) {
        const int mt = d ? 1 - mi : mi;
        bf16x8 a0 = *(const bf16x8*)(xcb + (mt * 16 + l15) * 392 + h * 48 + quad * 8);
        bf16x8 a1 = {0, 0, 0, 0, 0, 0, 0, 0};
        if (quad < 2) a1 = *(const bf16x8*)(xcb + (mt * 16 + l15) * 392 + h * 48 + 32 + quad * 8);
        f32x4 ra = {0.f, 0.f, 0.f, 0.f}, ia = {0.f, 0.f, 0.f, 0.f};
        ra = mfma16(a0, wr[0], ra); ra = mfma16(a1, wr[1], ra);
        ia = mfma16(a0, wi[0], ia); ia = mfma16(a1, wi[1], ia);
        float av[4], uv[4];
#pragma unroll
        for (int jj = 0; jj < 4; ++jj) {
          const int tok = mt * 16 + quad * 4 + jj;
          const float xv = xcf[tok * 388 + ch];
          const float r = sigm(ra[jj] + br), ig = sigm(ia[jj] + bi);
          const float la = -r * sp;
          av[jj] = __expf(la);
          uv[jj] = __builtin_amdgcn_sqrtf(fmaxf(1.f - av[jj] * av[jj], 0.f)) * ig * xv;
        }
        float P = 1.f, H = 0.f, pl[4], hl[4];
#pragma unroll
        for (int q = 0; q < 4; ++q) { const int jj = d ? 3 - q : q; H = av[jj] * H + uv[jj]; P *= av[jj]; pl[jj] = P; hl[jj] = H; }
        float Pi = P, Hi = H;
        { float Ps = __shfl(Pi, s1), Hs = __shfl(Hi, s1); if (lq >= 1) { Hi = Pi * Hs + Hi; Pi = Pi * Ps; } }
        { float Ps = __shfl(Pi, s2), Hs = __shfl(Hi, s2); if (lq >= 2) { Hi = Pi * Hs + Hi; Pi = Pi * Ps; } }
        const float Pt = __shfl(Pi, lastl), Ht = __shfl(Hi, lastl);
        if (fin) {
          float Pe = __shfl(Pi, s1), He = __shfl(Hi, s1);
          if (lq == 0) { Pe = 1.f; He = 0.f; }
          const float hin = Pe * hc + He;
#pragma unroll
          for (int jj = 0; jj < 4; ++jj) {
            const float hv = pl[jj] * hin + hl[jj];
            if (d == 0) hf[mt][jj] = hv;
            else {
              const size_t row = rowbase + t0 + mt * 16 + quad * 4 + jj;
              p.hbuf()[row * 1024 + ch] = f2bf((hf[mt][jj] + hv) * siluf(bf2f(gtA[mt][jj])));
            }
          }
        }
        if (!fin) {
          float Pe = __shfl(Pi, s1), He = __shfl(Hi, s1);
          if (lq == 0) { Pe = 1.f; He = 0.f; }
          const float hin = Pe * hc + He, pin = Pe * Pc;
#pragma unroll
          for (int jj = 0; jj < 4; ++jj) {
            const float hv = pl[jj] * hin + hl[jj], pc = pl[jj] * pin;
            if (d == 0) { hf[mt][jj] = hv; pfv[mt][jj] = pc; }
            else {
              const size_t row = rowbase + t0 + mt * 16 + quad * 4 + jj;
              *(uint2*)(p.apk() + (row * 384 + ch) * 4) = make_uint2(pack2(hf[mt][jj] + hv, pfv[mt][jj]), pack2(pc, 0.f));
            }
          }
        }
        hc = Pt * hc + Ht; Pc *= Pt;
      }
      if (!fin && quad == 0) *(float2*)(p.aPH() + (cidx + ch) * 2) = make_float2(Pc, hc);
    }
  }
  __syncthreads();
}

#undef A_LOAD
DEV void a_light_task(const Params& p, int l, int t64) {
  const int tid = tidx();
#pragma unroll 4
  for (int k = 0; k < 24; ++k) {
    const int idx = tid + 256 * k;
    const int rr = idx / 96, c4 = idx - rr * 96, ch0 = c4 * 4;
    const size_t row = (size_t)t64 * 64 + rr;
    int b, sc;
    if (row < (size_t)NLAT) { b = (int)(row >> 12); sc = 8 + (((int)row & 4095) >> 5); }
    else { const int r2 = (int)row - NLAT; b = r2 >> 8; sc = (r2 & 255) >> 5; }
    const uint4 q0 = *(const uint4*)(p.apk() + (row * 384 + ch0) * 4), q1 = *(const uint4*)(p.apk() + (row * 384 + ch0) * 4 + 8);
    const float4 cf = *(const float4*)(p.aCarry() + ((size_t)(b * 2 + 0) * ACH + sc) * 384 + ch0);
    const float4 cb = *(const float4*)(p.aCarry() + ((size_t)(b * 2 + 1) * ACH + sc) * 384 + ch0);
    const uint2 g = *(const uint2*)(p.pbuf() + row * NCOL + COL_AG + ch0);
    const float y0 = (bflo(q0.x) + bfhi(q0.x) * cf.x + bflo(q0.y) * cb.x) * siluf(bflo(g.x));
    const float y1 = (bflo(q0.z) + bfhi(q0.z) * cf.y + bflo(q0.w) * cb.y) * siluf(bfhi(g.x));
    const float y2 = (bflo(q1.x) + bfhi(q1.x) * cf.z + bflo(q1.y) * cb.z) * siluf(bflo(g.y));
    const float y3 = (bflo(q1.z) + bfhi(q1.z) * cf.w + bflo(q1.w) * cb.w) * siluf(bfhi(g.y));
    *(uint2*)(p.hbuf() + row * 1024 + ch0) = make_uint2(pack2(y0, y1), pack2(y2, y3));
  }
}

DEV void b_logf_scan(const Params& p, int l, int h, int d, const uint4 (&rawf)[3], float* Lf, float* GL, float* OFFp) {
  const int tid = tidx();
  float* SEG = OFFp + 768;
  const float* lbp = p.lbs() + l * 384 + h * 96;
#pragma unroll
  for (int it = 0; it < 3; ++it) {
    const int idx = tid + 256 * it, tok = idx / 12, g8 = idx % 12;
    float xs[8]; unpack8(rawf[it], xs);
    const float4 lb0 = *(const float4*)(lbp + g8 * 8), lb1 = *(const float4*)(lbp + g8 * 8 + 4);
    const float lbv[8] = {lb0.x, lb0.y, lb0.z, lb0.w, lb1.x, lb1.y, lb1.z, lb1.w};
#pragma unroll
    for (int e = 0; e < 8; ++e) { const float lb = lbv[e]; const float f = lb + (1.f - lb) * sigm(xs[e]); Lf[tok * 97 + g8 * 8 + e] = __logf(f); }
  }
  __syncthreads();
#pragma unroll
  for (int it = 0; it < 3; ++it) {
    const int item = tid + 256 * it, c = item % 96, sg = item / 96;
    float run = 0.f;
#pragma unroll
    for (int j = 0; j < 8; ++j) { const int pp = sg * 8 + j, tok = d ? 63 - pp : pp; run += Lf[tok * 97 + c]; Lf[tok * 97 + c] = run; }
    SEG[sg * 96 + c] = run;
  }
  __syncthreads();
#pragma unroll
  for (int it = 0; it < 3; ++it) {
    const int item = tid + 256 * it, c = item % 96, sg = item / 96;
    float off = 0.f;
#pragma unroll
    for (int s = 0; s < 7; ++s) { const float t = SEG[s * 96 + c]; off += (s < sg) ? t : 0.f; }
    OFFp[sg * 96 + c] = off;
    if (sg == 7) GL[c] = off + SEG[7 * 96 + c];
  }
  __syncthreads();
}

DEV void b_kv_task(const Params& p, int l, int task, char* smem) {
  const int n = task % BSL, s = task / BSL, d = s & 1, h = (s >> 1) & 3, b = s >> 3;
  size_t rowbase;
  if (n < 4) { int cj = d ? 3 - n : n; rowbase = (size_t)NLAT + b * LCTX + cj * 64; }
  else { int cj = d ? 63 - (n - 4) : n - 4; rowbase = (size_t)b * LSEQ + cj * 64; }
  float* Lf = (float*)smem; float* GL = Lf + 64 * 97;
  bf16_t* Kt = (bf16_t*)(smem + 25600);
  bf16_t* Vt = Kt + 96 * 72;
  float* OFFp = (float*)(smem + 53248);
  const int tid = tidx(), lane = tid & 63, wave = tid >> 6, quad = lane >> 4, l15 = lane & 15;
  const int fcol = (d ? COL_BFB : COL_BFF) + h * 96;
  uint4 rawf[3], rawv[3];
#pragma unroll
  for (int it = 0; it < 3; ++it) {
    const int idx = tid + 256 * it, tok = idx / 12, g8 = idx % 12;
    rawf[it] = *(const uint4*)(p.pbuf() + (rowbase + tok) * NCOL + fcol + g8 * 8);
    rawv[it] = *(const uint4*)(p.pbuf() + (rowbase + tok) * NCOL + COL_BI + h * 96 + g8 * 8);
  }
  b_logf_scan(p, l, h, d, rawf, Lf, GL, OFFp);
  const float* lbp = p.lbs() + l * 384 + h * 96;
#pragma unroll
  for (int it = 0; it < 3; ++it) {
    const int idx = tid + 256 * it, tok = idx / 12, g8 = idx % 12;
    const int pp = d ? 63 - tok : tok;
    float xs[8]; unpack8(rawf[it], xs);
    const unsigned vv[4] = {rawv[it].x, rawv[it].y, rawv[it].z, rawv[it].w};
    float kend[8];
    const float4 lb0 = *(const float4*)(lbp + g8 * 8), lb1 = *(const float4*)(lbp + g8 * 8 + 4);
    const float lbv[8] = {lb0.x, lb0.y, lb0.z, lb0.w, lb1.x, lb1.y, lb1.z, lb1.w};
#pragma unroll
    for (int e = 0; e < 8; ++e) {
      const int dk = g8 * 8 + e;
      const float lb = lbv[e];
      const float k = (1.f - lb) * (1.f - sigm(xs[e]));
      const float G = Lf[tok * 97 + dk] + OFFp[(pp >> 3) * 96 + dk];
      kend[e] = k * __expf(GL[dk] - G);
    }
    const unsigned kp[4] = {pack2(kend[0], kend[1]), pack2(kend[2], kend[3]), pack2(kend[4], kend[5]), pack2(kend[6], kend[7])};
    bf16_t* kd = Kt + g8 * 8 * 72 + tok; bf16_t* vd = Vt + g8 * 8 * 72 + tok;
    const int rot = g8 & 7;
#pragma unroll
    for (int e0 = 0; e0 < 8; ++e0) {
      const int e = (e0 + rot) & 7;
      const unsigned kw = (e & 2) ? ((e & 4) ? kp[3] : kp[1]) : ((e & 4) ? kp[2] : kp[0]);
      const unsigned vw = (e & 2) ? ((e & 4) ? vv[3] : vv[1]) : ((e & 4) ? vv[2] : vv[0]);
      kd[e * 72] = (bf16_t)((e & 1) ? (kw >> 16) : (kw & 0xffffu));
      vd[e * 72] = (bf16_t)((e & 1) ? (vw >> 16) : (vw & 0xffffu));
    }
  }
  if (tid < 96) p.decay()[(size_t)task * 96 + tid] = __expf(GL[tid]);
  __syncthreads();
  bf16_t* dst = p.kvbuf() + (size_t)task * 9216;
  for (int i = 0; i < 9; ++i) {
    const int ti = wave * 9 + i, mt = ti / 6, nt = ti % 6;
    f32x4 acc = {0.f, 0.f, 0.f, 0.f};
#pragma unroll
    for (int ks = 0; ks < 2; ++ks) {
      bf16x8 ka = *(const bf16x8*)(Kt + (nt * 16 + l15) * 72 + ks * 32 + quad * 8);
      bf16x8 vb = *(const bf16x8*)(Vt + (mt * 16 + l15) * 72 + ks * 32 + quad * 8);
      acc = mfma16(ka, vb, acc);
    }
    *(uint2*)(dst + (mt * 16 + l15) * 96 + nt * 16 + 4 * quad) = make_uint2(pack2(acc[0], acc[1]), pack2(acc[2], acc[3]));
  }
  __syncthreads();
}

DEV void b_state_scan(const Params& p, int gidx) {
  const int dk8 = gidx % 12, dv = (gidx / 12) % 96, s = gidx / 1152;
  bf16_t* base = p.kvbuf() + (size_t)s * BSL * 9216 + dv * 96 + dk8 * 8;
  const float* dec = p.decay() + (size_t)s * BSL * 96 + dk8 * 8;
  float S[8];
#pragma unroll
  for (int e = 0; e < 8; ++e) S[e] = 0.f;
  uint4 kv[4]; float4 d0[4], d1[4];
#pragma unroll
  for (int i = 0; i < 4; ++i) { kv[i] = *(const uint4*)(base + (size_t)i * 9216); d0[i] = *(const float4*)(dec + i * 96); d1[i] = *(const float4*)(dec + i * 96 + 4); }
#pragma unroll 1
  for (int n0 = 0; n0 < BSL; n0 += 4) {
    uint4 kvn[4]; float4 dn0[4], dn1[4];
    {
      const int nn = (n0 + 4 < BSL) ? n0 + 4 : n0;
#pragma unroll
      for (int i = 0; i < 4; ++i) { kvn[i] = *(const uint4*)(base + (size_t)(nn + i) * 9216); dn0[i] = *(const float4*)(dec + (nn + i) * 96); dn1[i] = *(const float4*)(dec + (nn + i) * 96 + 4); }
    }
#pragma unroll
    for (int i = 0; i < 4; ++i) {
      *(uint4*)(base + (size_t)(n0 + i) * 9216) = make_uint4(pack2(S[0], S[1]), pack2(S[2], S[3]), pack2(S[4], S[5]), pack2(S[6], S[7]));
      float kf[8]; unpack8(kv[i], kf);
      S[0] = d0[i].x * S[0] + kf[0]; S[1] = d0[i].y * S[1] + kf[1]; S[2] = d0[i].z * S[2] + kf[2]; S[3] = d0[i].w * S[3] + kf[3];
      S[4] = d1[i].x * S[4] + kf[4]; S[5] = d1[i].y * S[5] + kf[5]; S[6] = d1[i].z * S[6] + kf[6]; S[7] = d1[i].w * S[7] + kf[7];
    }
#pragma unroll
    for (int i = 0; i < 4; ++i) { kv[i] = kvn[i]; d0[i] = dn0[i]; d1[i] = dn1[i]; }
  }
}

DEV void a_carry_wave(const Params& p, int widx) {
  const int lane = tidx() & 63;
  const int ch = widx % 384, d = (widx / 384) & 1, b = widx / 768;
  const float2* ph = (const float2*)p.aPH() + (size_t)(b * 2 + d) * ACH * 384 + ch;
  float* cr = p.aCarry() + (size_t)(b * 2 + d) * ACH * 384 + ch;
  float P[3], H[3]; int scv[3]; bool valid[3];
#pragma unroll
  for (int j = 0; j < 3; ++j) {
    const int pos = lane * 3 + j;
    valid[j] = pos < ACH;
    scv[j] = d ? (pos < 8 ? 7 - pos : ACH - 1 - (pos - 8)) : pos;
    float2 v = make_float2(1.f, 0.f);
    if (valid[j]) v = ph[(size_t)scv[j] * 384];
    P[j] = v.x; H[j] = v.y;
  }
  float Pi = P[0], Hi = H[0];
  Hi = P[1] * Hi + H[1]; Pi *= P[1];
  Hi = P[2] * Hi + H[2]; Pi *= P[2];
#pragma unroll
  for (int o = 1; o < 64; o <<= 1) {
    const float Ps = __shfl_up(Pi, o), Hs = __shfl_up(Hi, o);
    if (lane >= o) { Hi = Pi * Hs + Hi; Pi = Pi * Ps; }
  }
  float He = __shfl_up(Hi, 1);
  if (lane == 0) He = 0.f;
  const float c0 = He, c1 = P[0] * c0 + H[0], c2 = P[1] * c1 + H[1];
  if (valid[0]) cr[(size_t)scv[0] * 384] = c0;
  if (valid[1]) cr[(size_t)scv[1] * 384] = c1;
  if (valid[2]) cr[(size_t)scv[2] * 384] = c2;
}

DEV void b_out_task(const Params& p, int l, int b, int h, int seg, int cj, char* smem) {
  const size_t rowbase = seg == 0 ? (size_t)NLAT + b * LCTX + cj * 64 : (size_t)b * LSEQ + cj * 64;
  float* Lf = (float*)smem; float* GL = Lf + 64 * 97;
  bf16_t* Qs = (bf16_t*)(smem + 25600);
  bf16_t* Ks = (bf16_t*)(smem + 38912);
  bf16_t* Vt = (bf16_t*)(smem + 52224);
  bf16_t* Sc = (bf16_t*)(smem + 66048);
  float* OFFp = (float*)(smem + 66048);
  const int tid = tidx(), lane = tid & 63, wave = tid >> 6, quad = lane >> 4, l15 = lane & 15;
  uint4 rawv[3], rawq[3], rawf0[3], rawf1[3];
#pragma unroll
  for (int it = 0; it < 3; ++it) {
    const int idx = tid + 256 * it, tok = idx / 12, g8 = idx % 12;
    const bf16_t* rp = p.pbuf() + (rowbase + tok) * NCOL + h * 96 + g8 * 8;
    rawv[it] = *(const uint4*)(rp + COL_BI); rawq[it] = *(const uint4*)(rp + COL_BQ);
    rawf0[it] = *(const uint4*)(rp + COL_BFF); rawf1[it] = *(const uint4*)(rp + COL_BFB);
  }
  bf16_t gt[4][6];
#pragma unroll
  for (int jj = 0; jj < 4; ++jj)
#pragma unroll
    for (int nt = 0; nt < 6; ++nt) gt[jj][nt] = p.pbuf()[(rowbase + wave * 16 + 4 * quad + jj) * NCOL + COL_BG + h * 96 + nt * 16 + l15];
#pragma unroll
  for (int it = 0; it < 3; ++it) {
    const int idx = tid + 256 * it, tok = idx / 12, g8 = idx % 12;
    const unsigned vv[4] = {rawv[it].x, rawv[it].y, rawv[it].z, rawv[it].w};
    bf16_t* vd = Vt + g8 * 8 * 72 + tok;
    const int rot = g8 & 7;
#pragma unroll
    for (int e0 = 0; e0 < 8; ++e0) {
      const int e = (e0 + rot) & 7;
      const unsigned vw = (e & 2) ? ((e & 4) ? vv[3] : vv[1]) : ((e & 4) ? vv[2] : vv[0]);
      vd[e * 72] = (bf16_t)((e & 1) ? (vw >> 16) : (vw & 0xffffu));
    }
  }
  f32x4 oacc[6];
#pragma unroll
  for (int nt = 0; nt < 6; ++nt) oacc[nt] = (f32x4){0.f, 0.f, 0.f, 0.f};
  const float* lbp = p.lbs() + l * 384 + h * 96;
#pragma unroll
  for (int d = 0; d < 2; ++d) {
    const int n = seg == 0 ? (d ? 3 - cj : cj) : 4 + (d ? 63 - cj : cj);
    const size_t stream = (size_t)(b * 4 + h) * 2 + d;
    const bf16_t* St = p.kvbuf() + (stream * BSL + n) * 9216;
    b_logf_scan(p, l, h, d, d ? rawf1 : rawf0, Lf, GL, OFFp);
#pragma unroll
    for (int it = 0; it < 3; ++it) {
      const int idx = tid + 256 * it, tok = idx / 12, g8 = idx % 12;
      const int pp = d ? 63 - tok : tok;
      float xs[8], qs[8], qg[8], kg[8]; unpack8(d ? rawf1[it] : rawf0[it], xs); unpack8(rawq[it], qs);
      const float4 lb0 = *(const float4*)(lbp + g8 * 8), lb1 = *(const float4*)(lbp + g8 * 8 + 4);
      const float lbv[8] = {lb0.x, lb0.y, lb0.z, lb0.w, lb1.x, lb1.y, lb1.z, lb1.w};
#pragma unroll
      for (int e = 0; e < 8; ++e) {
        const int dk = g8 * 8 + e;
        const float lb = lbv[e];
        const float k = (1.f - lb) * (1.f - sigm(xs[e]));
        const float G = Lf[tok * 97 + dk] + OFFp[(pp >> 3) * 96 + dk];
        qg[e] = siluf(qs[e]) * __expf(G);
        kg[e] = k * __expf(-G);
      }
      *(uint4*)(Qs + tok * 104 + g8 * 8) = make_uint4(pack2(qg[0], qg[1]), pack2(qg[2], qg[3]), pack2(qg[4], qg[5]), pack2(qg[6], qg[7]));
      *(uint4*)(Ks + tok * 104 + g8 * 8) = make_uint4(pack2(kg[0], kg[1]), pack2(kg[2], kg[3]), pack2(kg[4], kg[5]), pack2(kg[6], kg[7]));
    }
    __syncthreads();
    bf16x8 qa[3];
#pragma unroll
    for (int ks = 0; ks < 3; ++ks) qa[ks] = *(const bf16x8*)(Qs + (wave * 16 + l15) * 104 + ks * 32 + quad * 8);
    bf16x8 sfr[6][3];
#pragma unroll
    for (int nt = 0; nt < 6; ++nt)
#pragma unroll
      for (int ks = 0; ks < 3; ++ks) sfr[nt][ks] = *(const bf16x8*)(St + (nt * 16 + l15) * 96 + ks * 32 + quad * 8);
#pragma unroll
    for (int nt = 0; nt < 4; ++nt) {
      f32x4 acc = {0.f, 0.f, 0.f, 0.f};
#pragma unroll
      for (int ks = 0; ks < 3; ++ks) acc = mfma16(qa[ks], *(const bf16x8*)(Ks + (nt * 16 + l15) * 104 + ks * 32 + quad * 8), acc);
      int cb_ = wave * 16 + 4 * quad - nt * 16 - l15;
      asm volatile("" : "+v"(cb_));
      if (d) cb_ = -cb_;
#pragma unroll
      for (int jj = 0; jj < 4; ++jj) {
        const int cc = wave * 16 + 4 * quad + jj, ss = nt * 16 + l15;
        const int df = d ? cb_ - jj : cb_ + jj;
        Sc[cc * 72 + ss] = f2bf(df >= 0 ? acc[jj] : 0.f);
      }
    }
    __syncthreads();
    bf16x8 sa[2];
#pragma unroll
    for (int ks = 0; ks < 2; ++ks) sa[ks] = *(const bf16x8*)(Sc + (wave * 16 + l15) * 72 + ks * 32 + quad * 8);
#pragma unroll
    for (int nt = 0; nt < 6; ++nt) {
#pragma unroll
      for (int ks = 0; ks < 2; ++ks) oacc[nt] = mfma16(sa[ks], *(const bf16x8*)(Vt + (nt * 16 + l15) * 72 + ks * 32 + quad * 8), oacc[nt]);
#pragma unroll
      for (int ks = 0; ks < 3; ++ks) oacc[nt] = mfma16(qa[ks], sfr[nt][ks], oacc[nt]);
    }
  }
  const float* gw = p.sp() + SP_BNW + l * 384 + h * 96;
  float gwv[6];
#pragma unroll
  for (int nt = 0; nt < 6; ++nt) gwv[nt] = gw[nt * 16 + l15];
#pragma unroll
  for (int jj = 0; jj < 4; ++jj) {
    float ss = 0.f;
#pragma unroll
    for (int nt = 0; nt < 6; ++nt) ss += oacc[nt][jj] * oacc[nt][jj];
    ss = row_sum16(ss);
    const float rstd = rsqrtf(ss * (1.f / 96.f) + EPSV);
    const size_t row = rowbase + wave * 16 + 4 * quad + jj;
#pragma unroll
    for (int nt = 0; nt < 6; ++nt) {
      const int dv = nt * 16 + l15;
      p.hbuf()[row * 1024 + 384 + h * 96 + dv] = f2bf(oacc[nt][jj] * rstd * gwv[nt] * siluf(bf2f(gt[jj][nt])));
    }
  }
  __syncthreads();
}

DEV void c_task(const Params& p, int l, size_t rowbase, char* smem) {
  bf16_t* Vt = (bf16_t*)smem;
  const int tid = tidx(), lane = tid & 63, wave = tid >> 6, quad = lane >> 4, l15 = lane & 15;
  {
    const float* cnw = p.sp() + SP_CNW + l * 256 + l15 * 16;
    const int sub = lane >> 4;
    float nwv[16];
#pragma unroll
    for (int i = 0; i < 4; ++i) { const float4 t = *(const float4*)(cnw + 4 * i); nwv[4 * i] = t.x; nwv[4 * i + 1] = t.y; nwv[4 * i + 2] = t.z; nwv[4 * i + 3] = t.w; }
#pragma unroll 1
    for (int g0 = 0; g0 < 8; g0 += 4) {
      uint4 r0[4], r1[4];
#pragma unroll
      for (int g = 0; g < 4; ++g) {
        const bf16_t* src = p.pbuf() + (rowbase + wave * 32 + (g0 + g) * 4 + sub) * NCOL + COL_CV + l15 * 16;
        r0[g] = *(const uint4*)src; r1[g] = *(const uint4*)(src + 8);
      }
#pragma unroll
      for (int g = 0; g < 4; ++g) {
        const int tok = wave * 32 + (g0 + g) * 4 + sub;
        float v[16]; unpack8(r0[g], v); unpack8(r1[g], v + 8);
        float s = 0.f;
#pragma unroll
        for (int i = 0; i < 16; ++i) { v[i] = geluf(v[i]); s += v[i]; }
        s = row_sum16(s);
        const float mu = s * (1.f / 256.f);
        float q = 0.f;
#pragma unroll
        for (int i = 0; i < 16; ++i) { v[i] -= mu; q += v[i] * v[i]; }
        q = row_sum16(q);
        const float rstd = rsqrtf(q * (1.f / 256.f) + EPSV);
        bf16_t* dstp = Vt + (l15 * 16) * 136 + ((((tok >> 3) ^ l15) & 15) << 3) + (tok & 7);
#pragma unroll
        for (int i = 0; i < 16; ++i) dstp[i * 136] = f2bf(v[i] * rstd * nwv[i]);
      }
    }
  }
  __syncthreads();
  const int h = wave;
  const bf16_t* ws = p.cws() + ((size_t)l * 4 + h) * 128 * 128;
  const float* bs = p.sp() + SP_CBS + (l * 4 + h) * 128;
  for (int mt = 0; mt < 8; ++mt) {
    bf16_t ur[4][4], gr[4][4]; float bias[4];
#pragma unroll
    for (int jj = 0; jj < 4; ++jj) {
      const size_t row = rowbase + mt * 16 + 4 * quad + jj;
      bias[jj] = bs[mt * 16 + 4 * quad + jj];
#pragma unroll
      for (int nt = 0; nt < 4; ++nt) {
        const int ch = h * 64 + nt * 16 + l15;
        ur[jj][nt] = p.pbuf()[row * NCOL + COL_CU + ch];
        gr[jj][nt] = p.pbuf()[row * NCOL + COL_CG + ch];
      }
    }
    f32x4 acc[4];
#pragma unroll
    for (int nt = 0; nt < 4; ++nt) acc[nt] = (f32x4){0.f, 0.f, 0.f, 0.f};
#pragma unroll
    for (int ks = 0; ks < 4; ++ks) {
      const bf16x8 wfrag = *(const bf16x8*)(ws + (mt * 16 + l15) * 128 + ks * 32 + quad * 8);
#pragma unroll
      for (int nt = 0; nt < 4; ++nt) acc[nt] = mfma16(wfrag, *(const bf16x8*)(Vt + (h * 64 + nt * 16 + l15) * 136 + ((((ks * 4 + quad) ^ (h * 4 + nt)) & 15) << 3)), acc[nt]);
    }
#pragma unroll
    for (int jj = 0; jj < 4; ++jj) {
      const size_t row = rowbase + mt * 16 + 4 * quad + jj;
#pragma unroll
      for (int nt = 0; nt < 4; ++nt) {
        const int ch = h * 64 + nt * 16 + l15;
        p.hbuf()[row * 1024 + 768 + ch] = f2bf(geluf(bf2f(ur[jj][nt])) * (acc[nt][jj] + bias[jj]) * siluf(bf2f(gr[jj][nt])));
      }
    }
  }
  __syncthreads();
}

#ifndef TIMING
#define TIMING 0
#endif
#if TIMING
#define TSH ((unsigned long long*)(smem + 76000))
#define TT_BEGIN() unsigned long long tt0_ = 0; if (bid == 0 && tidx() == 0) tt0_ = __builtin_amdgcn_s_memrealtime();
#define TT_END(code) if (bid == 0 && tidx() == 0) { unsigned long long d_ = __builtin_amdgcn_s_memrealtime() - tt0_; if ((code) == TIMING_A) TSH[1] += d_; if ((code) == TIMING_B) TSH[2] += d_; }
#else
#define TT_BEGIN()
#define TT_END(code)
#endif
#ifndef DBG_SUB
#define DBG_SUB 7
#endif
DEV void phase_m1(const Params& p, int l, int bid, int nblk, char* smem) {
  const int nC = (l == 0) ? 272 : 256;
  const int nBk = NB * 4 * 2 * BSL;
  const int nA = NB * ACH;
  const int NT = nA + nC + nBk;
  for (int task = bid; task < NT; task += nblk) {
    int t = task;
    if (t < nA) { TT_BEGIN(); if (DBG_SUB & 4) a_chunk(p, l, t / ACH, t % ACH, false, smem); TT_END(12); continue; }
    t -= nA;
    if (t < nC) {
      size_t rowbase = (t < 256) ? (size_t)(t >> 5) * LSEQ + (t & 31) * 128 : (size_t)NLAT + ((t - 256) >> 1) * LCTX + ((t - 256) & 1) * 128;
      TT_BEGIN(); if (DBG_SUB & 1) c_task(p, l, rowbase, smem); TT_END(10);
      continue;
    }
    t -= nC;
    { TT_BEGIN(); if (DBG_SUB & 2) b_kv_task(p, l, t, smem); TT_END(11); }
  }
}

DEV void phase_m2(const Params& p, int l, int bid, int nblk, char* smem) {
  constexpr int TT = 64 * 96 * 12;
  const int chunk = (TT + nblk - 1) / nblk;
  const int g_end = (bid + 1) * chunk < TT ? (bid + 1) * chunk : TT;
  for (int g = bid * chunk + tidx(); g < g_end; g += 256) b_state_scan(p, g);
  constexpr int NAB = 1536;
  for (int task = bid; task < NAB; task += nblk) a_carry_wave(p, task * 4 + (tidx() >> 6));
}

DEV void phase_m3(const Params& p, int l, int bid, int nblk, char* smem) {
  const int nB = (l == 0) ? 2048 + 128 : 2048;
  const int nA = (l == 0) ? MROWS / 64 : NLAT / 64;
  for (int task = bid; task < nB + nA; task += nblk) {
    int t = task;
    if (t < nB) {
      if (!(DBG_SUB & 2)) continue;
      TT_BEGIN();
      if (t < 2048) b_out_task(p, l, t >> 8, (t >> 6) & 3, 1, t & 63, smem);
      else { int i2 = t - 2048; b_out_task(p, l, i2 >> 4, (i2 >> 2) & 3, 0, i2 & 3, smem); }
      TT_END(13);
      continue;
    }
    t -= nB;
    if (!(DBG_SUB & 4)) continue;
    TT_BEGIN();
    a_light_task(p, l, t);
    TT_END(14);
  }
}

#ifndef DBG_MASK
#define DBG_MASK 0xff
#endif
DEV void run_phase(const Params& p, int ph, int l, int bid, int nblk, char* smem) {
  if (!((DBG_MASK >> ph) & 1)) return;
  switch (ph) {
    case 0: phase_prep(p, bid, nblk, smem); break;
    case 1: phase_norm(p, l, bid, nblk); break;
    case 2: {
      const int full = (((MROWS / 256) * (NCOL / 128) + 7) >> 3) / (nblk >> 3);
      phase_gemm_big(p, p.hbuf(), p.wtin() + (size_t)l * NCOL * 1024, MROWS, NCOL, smem, bid, nblk, full);
      phase_gemm<0, 1>(p, l, p.hbuf(), p.wtin() + (size_t)l * NCOL * 1024, MROWS, NCOL, smem, bid, nblk, full);
      break; }
    case 3: phase_m1(p, l, bid, nblk, smem); break;
    case 4: phase_m2(p, l, bid, nblk, smem); break;
    case 5: phase_m3(p, l, bid, nblk, smem); break;
    case 6: phase_gemm<1>(p, l, p.hbuf(), p.wtout() + (size_t)l * 1024 * 1024, (l == 0) ? MROWS : NLAT, 1024, smem, bid, nblk); break;
    default: phase_final(p, bid, nblk); break;
  }
}

#define XB_TMO      128
#define XB_XCNT(j)  (256  + 64 * (j))
#define XB_XSUB(j)  (1280 + 64 * (j))
#define XB_XGEN(j)  (2304 + 64 * (j))
#define XB_TOP      3328
#define XB_TOPGEN   3392
#define XCD_BAR_WORDS 3456
#define XB_SPIN_CAP (1u << 18)
#define LAS __attribute__((address_space(3)))

__device__ __forceinline__ unsigned xb_ld(unsigned* p)              { return __hip_atomic_load(p, __ATOMIC_RELAXED, __HIP_MEMORY_SCOPE_AGENT); }
__device__ __forceinline__ unsigned xb_add(unsigned* p, unsigned v) { return __hip_atomic_fetch_add(p, v, __ATOMIC_RELAXED, __HIP_MEMORY_SCOPE_AGENT); }
__device__ __forceinline__ unsigned xb_xcc_id() { return (unsigned)__builtin_amdgcn_s_getreg((3 << 11) | 20) & 0xFu; }
#define XB_SPIN(cond, bar) do { unsigned _sp = 0; while (cond) { __builtin_amdgcn_s_sleep(1); \
    if ((++_sp & 255u) == 0u) { if (xb_ld(&(bar)[XB_TMO])) break; if (_sp > XB_SPIN_CAP) { atomicAdd(&(bar)[XB_TMO], 1u); break; } } } } while (0)

struct XcdBarrier {
    unsigned* bar; unsigned x;
    volatile LAS unsigned* st;
};

__device__ __forceinline__ XcdBarrier xcd_barrier_post(unsigned* bar, volatile LAS unsigned* st) {
    XcdBarrier b; b.bar = bar; b.x = xb_xcc_id(); b.st = st;
    if (threadIdx.x == 0) (void)xb_add(&bar[XB_XCNT(b.x)], 1u);
    return b;
}
__device__ __forceinline__ void xcd_barrier_complete(unsigned* bar, unsigned x, unsigned& nloc, unsigned& nx) {
    const unsigned G = gridDim.x * gridDim.y * gridDim.z;
    unsigned sum, cnt, mine, sp = 0u;
    for (;;) {
        sum = 0u; cnt = 0u; mine = 0u;
#pragma unroll
        for (unsigned j = 0; j < 16; ++j) { const unsigned c = xb_ld(&bar[XB_XCNT(j)]); sum += c; cnt += (c > 0u) ? 1u : 0u; mine = (j == x) ? c : mine; }
        if (sum == G) break;
        __builtin_amdgcn_s_sleep(1);
        if ((++sp & 255u) == 0u) { if (xb_ld(&bar[XB_TMO])) break; if (sp > XB_SPIN_CAP) { atomicAdd(&bar[XB_TMO], 1u); break; } }
    }
    nloc = mine > 0u ? mine : 1u; nx = cnt > 0u ? cnt : 1u;
}

__device__ __forceinline__ void xcd_barrier(const XcdBarrier& b) {
    asm volatile("s_waitcnt vmcnt(0)" ::: "memory");
    __syncthreads();
    if (threadIdx.x == 0) {
        unsigned* bar = b.bar;
        __builtin_amdgcn_s_waitcnt(0);
        unsigned nloc = b.st[0], nx = b.st[1];
        if (nloc == 0u) { xcd_barrier_complete(bar, b.x, nloc, nx); b.st[0] = nloc; b.st[1] = nx; }
        const unsigned old = xb_add(&bar[XB_XSUB(b.x)], 1u);
        const unsigned gen = old / nloc;
        if (old + 1u == (gen + 1u) * nloc) {
            __builtin_amdgcn_fence(__ATOMIC_RELEASE, "agent");
            asm volatile("s_waitcnt vmcnt(0)" ::: "memory");
            const unsigned og = xb_add(&bar[XB_TOP], 1u);
            const unsigned tg = og / nx;
            if (og + 1u == (tg + 1u) * nx) xb_add(&bar[XB_TOPGEN], 1u);
            else XB_SPIN(xb_ld(&bar[XB_TOPGEN]) == tg, bar);
            __builtin_amdgcn_fence(__ATOMIC_ACQUIRE, "agent");
            xb_add(&bar[XB_XGEN(b.x)], 1u);
            asm volatile("s_waitcnt vmcnt(0)" ::: "memory");
        } else {
            XB_SPIN(xb_ld(&bar[XB_XGEN(b.x)]) == gen, bar);
            __builtin_amdgcn_fence(__ATOMIC_ACQUIRE, "agent");
            asm volatile("s_waitcnt vmcnt(0)" ::: "memory");
        }
    }
    __syncthreads();
}


#if MEGA
__global__ void __launch_bounds__(256, 2) mega_kernel(Params p) {
  __shared__ __attribute__((aligned(16))) char smem[SMEM_BYTES];
  __shared__ uint4 xb_words;
  cg::grid_group grid = cg::this_grid();
  const int bid = blockIdx.x, nblk = gridDim.x;
  if (threadIdx.x == 0) xb_words = make_uint4(0u, 0u, 0u, 0u);
  __syncthreads();
  XcdBarrier xb = xcd_barrier_post((unsigned*)(p.ws + OFF_BAR), (volatile LAS unsigned*)&xb_words);
#if TIMING
  if (tidx() == 0) { TSH[0] = __builtin_amdgcn_s_memrealtime(); TSH[1] = 0; TSH[2] = 0; }
#define TICK(ph) { if (tidx() == 0) { unsigned long long tn = __builtin_amdgcn_s_memrealtime(); if ((ph) == TIMING_A) TSH[1] += tn - TSH[0]; if ((ph) == TIMING_B) TSH[2] += tn - TSH[0]; TSH[0] = tn; } }
#else
#define TICK(ph)
#endif
  if (p.ws == nullptr) grid.sync();
  run_phase(p, 0, 0, bid, nblk, smem);
  xcd_barrier(xb);
  TICK(0)
#define PH(ph, l) run_phase(p, ph, l, bid, nblk, smem); xcd_barrier(xb); TICK(ph)
  PH(1, 0) PH(2, 0) PH(3, 0) PH(4, 0) PH(5, 0) PH(6, 0)
  PH(1, 1) PH(2, 1) PH(3, 1) PH(4, 1) PH(5, 1) PH(6, 1)
#undef PH
  run_phase(p, 7, 0, bid, nblk, smem);
#if TIMING
  grid.sync();
  TICK(7)
  __syncthreads();
  if (bid == 0) {
    const float ta = (float)(TSH[1]) * 1e-5f, tb = (float)(TSH[2]) * 1e-5f;
    if (tidx() == 0) p.out[0] += 0.5f * ta;
    for (int i = tidx(); i < 65536; i += 256) p.out[1024 + i] += 0.5f * tb;
  }
#endif
}
#else
__global__ void __launch_bounds__(256, 2) phase_kernel(Params p, int ph, int l) {
  __shared__ __attribute__((aligned(16))) char smem[SMEM_BYTES];
  run_phase(p, ph, l, blockIdx.x, gridDim.x, smem);
}
#endif

extern "C" void kernel_launch(void* const* d_in, const int* in_sizes, int n_in, void* d_out, int out_size, void* d_ws, size_t ws_size,
                              hipStream_t stream) {
  Params p{};
  const float** f = (const float**)&p;
  for (int i = 0; i < 22; ++i) f[i] = (const float*)d_in[i];
  p.out = (float*)d_out;
  p.ws = (char*)d_ws;
  if (WS_TOTAL > ws_size) { fprintf(stderr, "workspace too small: need %zu have %zu\n", (size_t)WS_TOTAL, ws_size); return; }
#if MEGA
  static int grid_blocks = 0;
  if (!grid_blocks) {
    int dev = 0, cus = 0, per_cu = 0;
    hipGetDevice(&dev);
    hipDeviceGetAttribute(&cus, hipDeviceAttributeMultiprocessorCount, dev);
    hipOccupancyMaxActiveBlocksPerMultiprocessor(&per_cu, mega_kernel, 256, 0);
    if (per_cu > 2) per_cu = 2;
    if (per_cu < 1) per_cu = 1;
    grid_blocks = cus * per_cu;
  }
  (void)hipMemsetAsync(p.ws + OFF_BAR, 0, BAR_BYTES, stream);
  void* args[] = {&p};
  hipError_t e = hipLaunchCooperativeKernel((void*)mega_kernel, dim3(grid_blocks), dim3(256), args, 0, stream);
  if (e != hipSuccess) fprintf(stderr, "cooperative launch failed: %s (grid %d)\n", hipGetErrorString(e), grid_blocks);
#else
  const int G = 1024;
  phase_kernel<<<G, 256, 0, stream>>>(p, 0, 0);
  for (int l = 0; l < 2; ++l)
    for (int ph = 1; ph <= 6; ++ph) phase_kernel<<<G, 256, 0, stream>>>(p, ph, l);
  phase_kernel<<<G, 256, 0, stream>>>(p, 7, 0);
#endif
}
```

```cpp
#include <hip/hip_runtime.h>
#include <hip/hip_cooperative_groups.h>
#include <cstdio>
namespace cg = cooperative_groups;

#ifndef MEGA
#define MEGA 1
#endif

#define DEV __device__ __forceinline__
typedef unsigned short bf16_t;
typedef short bf16x8 __attribute__((ext_vector_type(8)));
typedef float f32x4 __attribute__((ext_vector_type(4)));

constexpr int NB = 8, LSEQ = 4096, LCTX = 256, DM = 1024, NCOL = 3456;
constexpr int NLAT = NB * LSEQ, NCTXR = NB * LCTX, MROWS = NLAT + NCTXR;
constexpr int COL_AX = 0, COL_AG = 384, COL_BQ = 768, COL_BFF = 1152, COL_BFB = 1536, COL_BI = 1920, COL_BG = 2304,
              COL_CU = 2688, COL_CV = 2944, COL_CG = 3200;
constexpr int ACH = 136;
constexpr int BSL = 68;
constexpr int SMEM_BYTES = 76800;
constexpr float EPSV = 1e-6f;

constexpr size_t al256(size_t x) { return (x + 255) & ~(size_t)255; }
constexpr size_t OFF_WTIN = 0;
constexpr size_t OFF_WTOUT = OFF_WTIN + al256((size_t)2 * NCOL * 1024 * 2);
constexpr size_t OFF_GATEPACK = OFF_WTOUT + al256((size_t)2 * 1024 * 1024 * 2);
constexpr size_t OFF_HBUF = OFF_GATEPACK + al256((size_t)64 * 3072 * 2);
constexpr size_t OFF_PBUF = OFF_HBUF + al256((size_t)MROWS * 1024 * 2);
constexpr size_t OFF_KVBUF = OFF_PBUF + al256((size_t)MROWS * NCOL * 2);
constexpr size_t OFF_MOD = OFF_KVBUF + al256((size_t)64 * BSL * 9216 * 2);
constexpr size_t OFF_LBS = OFF_MOD + al256((size_t)2 * 9 * 3072 * 4);
constexpr size_t OFF_POSTAB = OFF_LBS + al256((size_t)3 * 384 * 4);
constexpr size_t OFF_CTXRES = OFF_POSTAB + al256((size_t)64 * 512 * 4);
constexpr size_t OFF_DECAY = OFF_CTXRES + al256((size_t)NCTXR * 1024 * 4);
constexpr size_t OFF_APH = OFF_DECAY + al256((size_t)64 * BSL * 96 * 4);
constexpr size_t OFF_ACARRY = OFF_APH + al256((size_t)NB * 2 * ACH * 384 * 2 * 4);
constexpr size_t OFF_SP = OFF_ACARRY + al256((size_t)NB * 2 * ACH * 384 * 4);
constexpr int SP_NORM_W = 0, SP_CONV_W = 2048, SP_CONV_B = 5120, SP_BR = 5888, SP_BI = 7424, SP_ASP = 8960, SP_BNW = 10496,
              SP_CNW = 11264, SP_CBS = 11776, SP_FNW = 12800, SP_TOTAL = 13824;
constexpr size_t OFF_CWS = OFF_SP + al256((size_t)SP_TOTAL * 4);
constexpr size_t OFF_BAR = OFF_CWS + al256((size_t)2 * 4 * 128 * 128 * 2);
constexpr size_t BAR_BYTES = 3456 * 4;
constexpr size_t OFF_X16 = OFF_BAR + al256(BAR_BYTES);
constexpr size_t WS_TOTAL = OFF_X16 + al256((size_t)NLAT * 1024 * 2);
static_assert(WS_TOTAL <= (size_t)512 * 1024 * 1024, "workspace budget");

struct Params {
  const float *x, *c, *ctx, *c_ctx, *norm_w, *w_mod, *b_mod, *w_in, *a_conv_w, *a_conv_b, *a_wr, *a_br, *a_wi, *a_bi,
      *a_lambda, *b_lb_logits, *b_norm_w, *c_norm_w, *c_ws, *c_bs, *w_out, *final_norm_w;
  float* out;
  char* ws;
  DEV bf16_t* wtin() const { return (bf16_t*)(ws + OFF_WTIN); }
  DEV bf16_t* wtout() const { return (bf16_t*)(ws + OFF_WTOUT); }
  DEV bf16_t* gatepack() const { return (bf16_t*)(ws + OFF_GATEPACK); }
  DEV bf16_t* hbuf() const { return (bf16_t*)(ws + OFF_HBUF); }
  DEV bf16_t* pbuf() const { return (bf16_t*)(ws + OFF_PBUF); }
  DEV bf16_t* kvbuf() const { return (bf16_t*)(ws + OFF_KVBUF); }
  DEV float* mod() const { return (float*)(ws + OFF_MOD); }
  DEV float* lbs() const { return (float*)(ws + OFF_LBS); }
  DEV float* postab() const { return (float*)(ws + OFF_POSTAB); }
  DEV float* ctxres() const { return (float*)(ws + OFF_CTXRES); }
  DEV float* decay() const { return (float*)(ws + OFF_DECAY); }
  DEV float* aPH() const { return (float*)(ws + OFF_APH); }
  DEV float* aCarry() const { return (float*)(ws + OFF_ACARRY); }
  DEV float* sp() const { return (float*)(ws + OFF_SP); }
  DEV bf16_t* cws() const { return (bf16_t*)(ws + OFF_CWS); }
  DEV bf16_t* x16() const { return (bf16_t*)(ws + OFF_X16); }
  DEV bf16_t* apk() const { return (bf16_t*)out; }
};

typedef __bf16 bf2_t __attribute__((ext_vector_type(2)));
typedef float f2_t __attribute__((ext_vector_type(2)));
DEV unsigned pack2(float lo, float hi) { f2_t v = {lo, hi}; bf2_t b = __builtin_convertvector(v, bf2_t); return __builtin_bit_cast(unsigned, b); }
DEV bf16_t f2bf(float f) { __bf16 b = (__bf16)f; return __builtin_bit_cast(unsigned short, b); }
DEV float bflo(unsigned u) { return __uint_as_float(u << 16); }
DEV float bfhi(unsigned u) { return __uint_as_float(u & 0xffff0000u); }
DEV float bf2f(bf16_t h) { return __uint_as_float(((unsigned)h) << 16); }
DEV void unpack8(const uint4& r, float* o) {
  o[0] = bflo(r.x); o[1] = bfhi(r.x); o[2] = bflo(r.y); o[3] = bfhi(r.y);
  o[4] = bflo(r.z); o[5] = bfhi(r.z); o[6] = bflo(r.w); o[7] = bfhi(r.w);
}
DEV float frcp(float x) { return __builtin_amdgcn_rcpf(x); }
DEV float sigm(float x) { return frcp(1.f + __expf(-x)); }
DEV float siluf(float x) { return x * frcp(1.f + __expf(-x)); }
DEV float geluf(float x) { float z = 1.5957691216f * (x + 0.044715f * x * x * x); return x * frcp(1.f + __expf(-z)); }
DEV f32x4 mfma16(bf16x8 a, bf16x8 b, f32x4 c) { return __builtin_amdgcn_mfma_f32_16x16x32_bf16(a, b, c, 0, 0, 0); }
DEV float row_sum16(float v) {
  v += __builtin_bit_cast(float, __builtin_amdgcn_update_dpp(0, __builtin_bit_cast(int, v), 0xB1, 0xf, 0xf, false));
  v += __builtin_bit_cast(float, __builtin_amdgcn_update_dpp(0, __builtin_bit_cast(int, v), 0x4E, 0xf, 0xf, false));
  v += __builtin_bit_cast(float, __builtin_amdgcn_update_dpp(0, __builtin_bit_cast(int, v), 0x124, 0xf, 0xf, false));
  v += __builtin_bit_cast(float, __builtin_amdgcn_update_dpp(0, __builtin_bit_cast(int, v), 0x128, 0xf, 0xf, false));
  return v;
}
DEV int tidx() { int t = threadIdx.x; asm volatile("" : "+v"(t)); return t; }
DEV float wave_sum(float v) {
#pragma unroll
  for (int o = 32; o > 0; o >>= 1) v += __shfl_xor(v, o);
  return v;
}

DEV void prep_mod(const Params& p, int task, char* smem) {
  const int l = task / 192, j0 = (task % 192) * 16, tid = tidx();
  float* sv = (float*)smem;
  float* red = sv + 9 * 1024;
  for (int i = tid; i < 9 * 1024; i += 256) { int r = i >> 10, k = i & 1023; float v = (r < 8) ? p.c[r * 1024 + k] : p.c_ctx[k]; sv[i] = siluf(v); }
  __syncthreads();
  const int kg = tid >> 4, col = tid & 15;
  float acc[9];
#pragma unroll
  for (int r = 0; r < 9; ++r) acc[r] = 0.f;
  const float* w = p.w_mod + (size_t)l * 1024 * 3072 + j0 + col;
#pragma unroll 1
  for (int k = kg * 64; k < kg * 64 + 64; k += 16) {
    float wv[16];
#pragma unroll
    for (int u = 0; u < 16; ++u) wv[u] = w[(size_t)(k + u) * 3072];
#pragma unroll
    for (int u = 0; u < 16; ++u)
#pragma unroll
      for (int r = 0; r < 9; ++r) acc[r] += sv[r * 1024 + k + u] * wv[u];
  }
#pragma unroll
  for (int r = 0; r < 9; ++r) red[(kg * 9 + r) * 16 + col] = acc[r];
  __syncthreads();
  if (tid < 144) {
    int r = tid >> 4, cc = tid & 15; float s = 0.f;
#pragma unroll
    for (int g = 0; g < 16; ++g) s += red[(g * 9 + r) * 16 + cc];
    p.mod()[(l * 9 + r) * 3072 + j0 + cc] = s + p.b_mod[l * 3072 + j0 + cc];
  }
  __syncthreads();
}

DEV void prep_transpose(const float* __restrict__ src, bf16_t* __restrict__ dst, int N, int kt, int nt, char* smem) {
  float* tile = (float*)smem;
  const int tid = tidx(), r = tid >> 4, c4 = tid & 15;
#pragma unroll
  for (int i = 0; i < 4; ++i) {
    float4 v = *(const float4*)(src + (size_t)(kt * 64 + r + 16 * i) * N + nt * 64 + c4 * 4);
    float* t = tile + (r + 16 * i) * 65 + c4 * 4;
    t[0] = v.x; t[1] = v.y; t[2] = v.z; t[3] = v.w;
  }
  __syncthreads();
  const int n = tid >> 2, kq = tid & 3;
  unsigned o[8];
#pragma unroll
  for (int e = 0; e < 8; ++e) o[e] = pack2(tile[(kq * 16 + 2 * e) * 65 + n], tile[(kq * 16 + 2 * e + 1) * 65 + n]);
  uint4* d = (uint4*)(dst + (size_t)(nt * 64 + n) * 1024 + kt * 64 + kq * 16);
  d[0] = make_uint4(o[0], o[1], o[2], o[3]);
  d[1] = make_uint4(o[4], o[5], o[6], o[7]);
  __syncthreads();
}

DEV void phase_prep(const Params& p, int bid, int nblk, char* smem) {
  const int tid = tidx();
  constexpr int T_MOD = 384, T_LBS = 1, T_POS = 64, T_GP = 64, T_WIN = 2 * 16 * 54, T_WOUT = 2 * 16 * 16;
  constexpr int T_CP = 18;
  constexpr int NT = T_MOD + T_CP + T_LBS + T_POS + T_GP + T_WIN + T_WOUT;
  for (int task = bid; task < NT; task += nblk) {
    int t = task;
    if (t < T_MOD) { prep_mod(p, t, smem); continue; }
    t -= T_MOD;
    if (t < T_CP) {
      if (t >= 10) {
        const float* s = p.c_ws + (t - 10) * 16384; bf16_t* dd = p.cws() + (t - 10) * 16384;
        for (int i = tid; i < 16384; i += 256) dd[i] = f2bf(s[i]);
        continue;
      }
      const float* s; int off, n;
      switch (t) {
        case 0: s = p.norm_w; off = SP_NORM_W; n = 2048; break;
        case 1: s = p.a_conv_w; off = SP_CONV_W; n = 3072; break;
        case 2: s = p.a_conv_b; off = SP_CONV_B; n = 768; break;
        case 3: s = p.a_br; off = SP_BR; n = 1536; break;
        case 4: s = p.a_bi; off = SP_BI; n = 1536; break;
        case 5: s = p.a_lambda; off = SP_ASP; n = 1536; break;
        case 6: s = p.b_norm_w; off = SP_BNW; n = 768; break;
        case 7: s = p.c_norm_w; off = SP_CNW; n = 512; break;
        case 8: s = p.c_bs; off = SP_CBS; n = 1024; break;
        default: s = p.final_norm_w; off = SP_FNW; n = 1024; break;
      }
      float* dd = p.sp() + off;
      for (int i = tid; i < n; i += 256) { float v = s[i]; if (t == 5) v = 8.f * log1pf(expf(-v)); dd[i] = v; }
      continue;
    }
    t -= T_CP;
    if (t < T_LBS) {
      for (int i = tid; i < 384; i += 256) {
        float a = p.b_lb_logits[i], b = p.b_lb_logits[384 + i], cc = p.b_lb_logits[768 + i];
        float m = fmaxf(a, fmaxf(b, cc));
        float ea = expf(a - m), eb = expf(b - m), ec = expf(cc - m), inv = 1.f / (ea + eb + ec);
        p.lbs()[i] = ea * inv; p.lbs()[384 + i] = (ea + eb) * inv; p.lbs()[768 + i] = 1.f;
      }
      continue;
    }
    t -= T_LBS;
    if (t < T_POS) {
      int i = tid;
      float om = 1.0f / powf(10000.0f, (float)i / 256.0f);
      float ang = (float)t * om;
      p.postab()[t * 512 + i] = sinf(ang);
      p.postab()[t * 512 + 256 + i] = cosf(ang);
      continue;
    }
    t -= T_POS;
    if (t < T_GP) {
      const int mat = t & 1, ldh = t >> 1;
      const float* W = (mat ? p.a_wi : p.a_wr) + (size_t)ldh * 2304;
      bf16_t* dst = p.gatepack() + (size_t)t * 3072;
      for (int idx = tid; idx < 3072; idx += 256) {
        int jj = idx & 7, lane = (idx >> 3) & 63, nt = (idx >> 9) % 3, ks = idx / 1536;
        int k = ks * 32 + (lane >> 4) * 8 + jj, n = nt * 16 + (lane & 15);
        float v = (k < 48) ? W[k * 48 + n] : 0.f;
        dst[idx] = f2bf(v);
      }
      continue;
    }
    t -= T_GP;
    if (t < T_WIN) {
      int l = t / (16 * 54), r = t % (16 * 54);
      prep_transpose(p.w_in + (size_t)l * 1024 * NCOL, p.wtin() + (size_t)l * NCOL * 1024, NCOL, r / 54, r % 54, smem);
      continue;
    }
    t -= T_WIN;
    {
      int l = t / 256, r = t % 256;
      prep_transpose(p.w_out + (size_t)l * 1024 * 1024, p.wtout() + (size_t)l * 1024 * 1024, 1024, r / 16, r % 16, smem);
    }
  }
}

DEV void phase_norm(const Params& p, int layer, int bid, int nblk) {
  const int tid = tidx(), lane = tid & 63;
  const int wave = __builtin_amdgcn_readfirstlane(tid >> 6);
  const float* nwp = p.sp() + SP_NORM_W + layer * 1024;
  const int nwv = nblk * 4, per = (MROWS + nwv - 1) / nwv;
  const int r_begin = (bid * 4 + wave) * per;
  int r_end = r_begin + per; if (r_end > MROWS) r_end = MROWS;
  float4 nw[4], sh[4], sc[4];
#pragma unroll
  for (int i = 0; i < 4; ++i) { nw[i] = *(const float4*)(nwp + i * 256 + lane * 4); sh[i] = nw[i]; sc[i] = nw[i]; }
  int cur_m = -1;
  for (int row0 = r_begin; row0 < r_end; row0 += 2) {
    float4 v[2][4]; float ss[2]; int rows[2], mrows[2];
    const bool valid1 = row0 + 1 < r_end;
#pragma unroll
    for (int u = 0; u < 2; ++u) {
      const int row = (u == 1 && valid1) ? row0 + 1 : row0;
      rows[u] = row;
      const bool isctx = row >= NLAT;
      const float* src; float* res; int t = 0;
      if (!isctx) { t = row & 4095; src = (layer == 0 ? p.x : p.out) + (size_t)row * 1024; res = p.out + (size_t)row * 1024; mrows[u] = row >> 12; }
      else { int r2 = row - NLAT; src = (layer == 0 ? p.ctx : p.ctxres()) + (size_t)r2 * 1024; res = p.ctxres() + (size_t)r2 * 1024; mrows[u] = 8; }
      float s = 0.f;
#pragma unroll
      for (int i = 0; i < 4; ++i) {
        int col = i * 256 + lane * 4;
        float4 a;
        if (layer == 1 && !isctx) { const uint2 w_ = *(const uint2*)(p.x16() + (size_t)row * 1024 + col); a = make_float4(bflo(w_.x), bfhi(w_.x), bflo(w_.y), bfhi(w_.y)); }
        else a = *(const float4*)(src + col);
        if (layer == 0) {
          if (!isctx) {
            const float* tp = p.postab() + ((i < 2) ? (t >> 6) : (t & 63)) * 512 + (col & 511);
            float4 q = *(const float4*)tp;
            a.x += q.x; a.y += q.y; a.z += q.z; a.w += q.w;
          }
        }
        v[u][i] = a;
        s += a.x * a.x + a.y * a.y + a.z * a.z + a.w * a.w;
      }
      ss[u] = s;
    }
#pragma unroll
    for (int u = 0; u < 2; ++u) {
      if (u == 1 && !valid1) break;
      if (mrows[u] != cur_m) {
        cur_m = mrows[u];
        const float* modp = p.mod() + (layer * 9 + cur_m) * 3072;
#pragma unroll
        for (int i = 0; i < 4; ++i) { sh[i] = *(const float4*)(modp + i * 256 + lane * 4); sc[i] = *(const float4*)(modp + 1024 + i * 256 + lane * 4); }
      }
      const float rstd = rsqrtf(wave_sum(ss[u]) * (1.f / 1024.f) + EPSV);
#pragma unroll
      for (int i = 0; i < 4; ++i) {
        int col = i * 256 + lane * 4;
        float h0 = v[u][i].x * rstd * nw[i].x * (1.f + sc[i].x) + sh[i].x;
        float h1 = v[u][i].y * rstd * nw[i].y * (1.f + sc[i].y) + sh[i].y;
        float h2 = v[u][i].z * rstd * nw[i].z * (1.f + sc[i].z) + sh[i].z;
        float h3 = v[u][i].w * rstd * nw[i].w * (1.f + sc[i].w) + sh[i].w;
        *(uint2*)(p.hbuf() + (size_t)rows[u] * 1024 + col) = make_uint2(pack2(h0, h1), pack2(h2, h3));
      }
    }
  }
}

DEV void phase_final(const Params& p, int bid, int nblk) {
  const int tid = tidx(), lane = tid & 63;
  const int wave = __builtin_amdgcn_readfirstlane(tid >> 6);
  const int nwv = nblk * 4, per = (NLAT + nwv - 1) / nwv;
  const int r_begin = (bid * 4 + wave) * per;
  int r_end = r_begin + per; if (r_end > NLAT) r_end = NLAT;
  const float* fwp = p.sp() + SP_FNW;
  float4 fw[4];
#pragma unroll
  for (int i = 0; i < 4; ++i) fw[i] = *(const float4*)(fwp + i * 256 + lane * 4);
  for (int row0 = r_begin; row0 < r_end; row0 += 2) {
    const bool valid1 = row0 + 1 < r_end;
    float4 v[2][4]; float ss[2];
#pragma unroll
    for (int u = 0; u < 2; ++u) {
      const bf16_t* src = p.x16() + (size_t)((u == 1 && valid1) ? row0 + 1 : row0) * 1024;
      float s = 0.f;
#pragma unroll
      for (int i = 0; i < 4; ++i) { const uint2 w_ = *(const uint2*)(src + i * 256 + lane * 4); v[u][i] = make_float4(bflo(w_.x), bfhi(w_.x), bflo(w_.y), bfhi(w_.y)); s += v[u][i].x * v[u][i].x + v[u][i].y * v[u][i].y + v[u][i].z * v[u][i].z + v[u][i].w * v[u][i].w; }
      ss[u] = s;
    }
#pragma unroll
    for (int u = 0; u < 2; ++u) {
      if (u == 1 && !valid1) break;
      float* dst = p.out + (size_t)(row0 + u) * 1024;
      const float rstd = rsqrtf(wave_sum(ss[u]) * (1.f / 1024.f) + EPSV);
#pragma unroll
      for (int i = 0; i < 4; ++i) {
        int col = i * 256 + lane * 4;
        float4 o; o.x = v[u][i].x * rstd * fw[i].x; o.y = v[u][i].y * rstd * fw[i].y; o.z = v[u][i].z * rstd * fw[i].z; o.w = v[u][i].w * rstd * fw[i].w;
        *(float4*)(dst + col) = o;
      }
    }
  }
}

constexpr int GLD = 72;
template <int EPI, int MODE = 0>
DEV void phase_gemm(const Params& p, int layer, const bf16_t* __restrict__ A, const bf16_t* __restrict__ Bt, int M, int N, char* smem, int bid, int nblk, int big_done = 0, int TtotB = 0, int nctxn = 27) {
  constexpr int K = 1024;
  bf16_t* As = (bf16_t*)smem;
  bf16_t* Bs = As + 2 * 128 * GLD;
  const int tid = tidx(), lane = tid & 63, wave = tid >> 6, quad = lane >> 4, l15 = lane & 15;
  const int wm = wave >> 1, wn = wave & 1;
  const int lrow = tid >> 3, lkc = tid & 7;
  const int nN = N / 128, T = (M / 128) * nN;
  const int xcd = bid & 7, jb = bid >> 3, per = nblk >> 3;
  const int Tx = (T + 7) >> 3;
  const int t_begin = xcd * Tx + jb;
  int t_end = (xcd + 1) * Tx; if (t_end > T) t_end = T;
  int ntl = (t_end - t_begin + per - 1) / per; if (t_end <= t_begin) ntl = 0;
  const int TB_ = (MODE == 1) ? TtotB : (M / 256) * nN;
  const int TxB = (TB_ + 7) >> 3;
  int tB_end = (xcd + 1) * TxB; if (tB_end > TB_) tB_end = TB_;
  const int tB_left0 = xcd * TxB + big_done * per;
  if (MODE == 1) ntl = (tB_left0 + (jb >> 1) < tB_end) ? 1 : 0;
  const int nsteps = ntl * 16;
#define G_TILE_OF(i, pm, pn) { if (MODE == 1) { const int t_ = tB_left0 + (jb >> 1); const int g_ = t_ / (8 * nN), r_ = t_ - g_ * 8 * nN; int pn_b = r_ >> 3; if (g_ == 16 && nctxn != 27 && pn_b >= 3) pn_b += 6; pn = pn_b; pm = 2 * (g_ * 8 + (r_ & 7)) + (jb & 1); } \
    else { const int t_ = t_begin + per * (i); const int g_ = t_ / (8 * nN), r_ = t_ - g_ * 8 * nN; pn = r_ >> 3; pm = g_ * 8 + (r_ & 7); } }
#define G_LOAD(s, a, b) { int pm_, pn_; G_TILE_OF((s) >> 4, pm_, pn_); \
    const bf16_t* Ag_ = A + (size_t)(pm_ * 128 + lrow) * K + lkc * 8 + ((s) & 15) * 64; \
    const bf16_t* Bg_ = Bt + (size_t)(pn_ * 128 + lrow) * K + lkc * 8 + ((s) & 15) * 64; \
    a##0 = *(const uint4*)(Ag_); a##1 = *(const uint4*)(Ag_ + (size_t)32 * K); a##2 = *(const uint4*)(Ag_ + (size_t)64 * K); a##3 = *(const uint4*)(Ag_ + (size_t)96 * K); \
    b##0 = *(const uint4*)(Bg_); b##1 = *(const uint4*)(Bg_ + (size_t)32 * K); b##2 = *(const uint4*)(Bg_ + (size_t)64 * K); b##3 = *(const uint4*)(Bg_ + (size_t)96 * K); }
#define G_LSTORE(buf, a, b) { bf16_t* ad_ = As + (buf) * 128 * GLD + lrow * GLD + lkc * 8; bf16_t* bd_ = Bs + (buf) * 128 * GLD + lrow * GLD + lkc * 8; \
    *(uint4*)(ad_) = a##0; *(uint4*)(ad_ + 32 * GLD) = a##1; *(uint4*)(ad_ + 64 * GLD) = a##2; *(uint4*)(ad_ + 96 * GLD) = a##3; \
    *(uint4*)(bd_) = b##0; *(uint4*)(bd_ + 32 * GLD) = b##1; *(uint4*)(bd_ + 64 * GLD) = b##2; *(uint4*)(bd_ + 96 * GLD) = b##3; }
#define G_ZERO() { _Pragma("unroll") for (int i_ = 0; i_ < 4; ++i_) _Pragma("unroll") for (int j_ = 0; j_ < 4; ++j_) acc[i_][j_] = (f32x4){0.f, 0.f, 0.f, 0.f}; }
#define G_COMPUTE(buf) { \
    const bf16_t* as_ = As + (buf) * 128 * GLD + (wm * 64 + l15) * GLD + quad * 8; \
    const bf16_t* bs_ = Bs + (buf) * 128 * GLD + (wn * 64 + l15) * GLD + quad * 8; \
    _Pragma("unroll") for (int ks_ = 0; ks_ < 2; ++ks_) { \
      bf16x8 af_[4], bf_[4]; \
      _Pragma("unroll") for (int i_ = 0; i_ < 4; ++i_) { af_[i_] = *(const bf16x8*)(as_ + i_ * 16 * GLD + ks_ * 32); bf_[i_] = *(const bf16x8*)(bs_ + i_ * 16 * GLD + ks_ * 32); } \
      __builtin_amdgcn_s_setprio(1); \
      _Pragma("unroll") for (int mi_ = 0; mi_ < 4; ++mi_) _Pragma("unroll") for (int ni_ = 0; ni_ < 4; ++ni_) acc[mi_][ni_] = mfma16(bf_[ni_], af_[mi_], acc[mi_][ni_]); \
      __builtin_amdgcn_s_setprio(0); } }
  f32x4 acc[4][4];
  if (nsteps > 0) {
    uint4 ra00, ra01, ra02, ra03, rb00, rb01, rb02, rb03, ra10, ra11, ra12, ra13, rb10, rb11, rb12, rb13;
    G_LOAD(0, ra0, rb0); G_LOAD(1, ra1, rb1);
    G_LSTORE(0, ra0, rb0);
    __syncthreads();
    G_ZERO();
    for (int s = 0; s < nsteps; s += 2) {
      { const int s2_ = (s + 2 < nsteps) ? s + 2 : nsteps - 1; G_LOAD(s2_, ra0, rb0); }
      G_COMPUTE(0);
      G_LSTORE(1, ra1, rb1);
      __syncthreads();
      { const int s3_ = (s + 3 < nsteps) ? s + 3 : nsteps - 1; G_LOAD(s3_, ra1, rb1); }
      G_COMPUTE(1);
      if ((s & 15) == 14) {
        int pm, pn; G_TILE_OF(s >> 4, pm, pn);
        const int row0 = pm * 128 + wm * 64 + l15, c0 = pn * 128 + wn * 64 + 4 * quad;
        if (EPI == 0) {
#pragma unroll
          for (int mi = 0; mi < 4; ++mi) {
            bf16_t* dst = p.pbuf() + (size_t)(row0 + mi * 16) * NCOL + c0;
#pragma unroll
            for (int ni = 0; ni < 4; ++ni) *(uint2*)(dst + ni * 16) = make_uint2(pack2(acc[mi][ni][0], acc[mi][ni][1]), pack2(acc[mi][ni][2], acc[mi][ni][3]));
          }
        } else {
          const bool lat = pm * 128 < NLAT;
          float* res = lat ? p.out + (size_t)row0 * 1024 + c0 : p.ctxres() + (size_t)(row0 - NLAT) * 1024 + c0;
          const float* g = p.mod() + (layer * 9 + (lat ? (pm * 128) >> 12 : 8)) * 3072 + 2048 + c0;
          const float* rsrc = (layer == 0) ? (lat ? p.x + (size_t)row0 * 1024 + c0 : p.ctx + (size_t)(row0 - NLAT) * 1024 + c0) : (const float*)res;
          bf16_t* x16p = p.x16() + (size_t)(lat ? row0 : 0) * 1024 + c0;
          const bool addpos = (layer == 0) && lat;
          const float* ptab = p.postab() + (c0 & 511);
          const bool rowhalf = c0 < 512;
          float4 gg[4], r[4], rn[4];
#define G_RLOAD(dst, mi_) { _Pragma("unroll") for (int ni = 0; ni < 4; ++ni) { \
            float4 v_; \
            if (layer == 0) v_ = *(const float4*)(rsrc + (size_t)(mi_) * 16 * 1024 + ni * 16); \
            else { const uint2 w_ = *(const uint2*)(x16p + (size_t)(mi_) * 16 * 1024 + ni * 16); v_ = make_float4(bflo(w_.x), bfhi(w_.x), bflo(w_.y), bfhi(w_.y)); } \
            if (addpos) { const int t_ = (row0 + (mi_) * 16) & 4095; const float4 q_ = *(const float4*)(ptab + (rowhalf ? (t_ >> 6) : (t_ & 63)) * 512 + ni * 16); \
              v_.x += q_.x; v_.y += q_.y; v_.z += q_.z; v_.w += q_.w; } \
            dst[ni] = v_; } }
#pragma unroll
          for (int ni = 0; ni < 4; ++ni) gg[ni] = *(const float4*)(g + ni * 16);
          G_RLOAD(r, 0);
#pragma unroll
          for (int mi = 0; mi < 4; ++mi) {
            if (mi < 3) G_RLOAD(rn, mi + 1);
#pragma unroll
            for (int ni = 0; ni < 4; ++ni) {
              float4 o = r[ni];
              o.x += gg[ni].x * acc[mi][ni][0]; o.y += gg[ni].y * acc[mi][ni][1]; o.z += gg[ni].z * acc[mi][ni][2]; o.w += gg[ni].w * acc[mi][ni][3];
              if (lat) *(uint2*)(x16p + (size_t)mi * 16 * 1024 + ni * 16) = make_uint2(pack2(o.x, o.y), pack2(o.z, o.w));
              else *(float4*)(res + (size_t)mi * 16 * 1024 + ni * 16) = o;
            }
#pragma unroll
            for (int ni = 0; ni < 4; ++ni) r[ni] = rn[ni];
          }
#undef G_RLOAD
        }
        G_ZERO();
      }
      G_LSTORE(0, ra0, rb0);
      __syncthreads();
    }
  }
#undef G_TILE_OF
#undef G_LOAD
#undef G_LSTORE
#undef G_ZERO
#undef G_COMPUTE
}

DEV void phase_gemm_big(const Params& p, const bf16_t* __restrict__ A, const bf16_t* __restrict__ Bt, int M, int N, char* smem, int bid, int nblk, int max_tiles, int Ttot, int nctxn) {
  constexpr int K = 1024;
  bf16_t* As = (bf16_t*)smem;
  bf16_t* Bs = As + 256 * GLD;
  const int tid = tidx(), lane = tid & 63, wave = tid >> 6, quad = lane >> 4, l15 = lane & 15;
  const int wm = wave >> 1, wn = wave & 1;
  const int lrow = tid >> 3, lkc = tid & 7;
  const int nN = N / 128, T = Ttot;
  const int xcd = bid & 7, jb = bid >> 3, per = nblk >> 3;
  const int Tx = (T + 7) >> 3;
  const int t_begin = xcd * Tx + jb;
  int t_end = (xcd + 1) * Tx; if (t_end > T) t_end = T;
  int ntl = (t_end - t_begin + per - 1) / per; if (t_end <= t_begin) ntl = 0;
  if (ntl > max_tiles) ntl = max_tiles;
  const int nsteps = ntl * 16;
#define GB_TILE_OF(i, pm, pn) { const int t_ = t_begin + per * (i); const int g_ = t_ / (8 * nN), r_ = t_ - g_ * 8 * nN; int pn_b = r_ >> 3; if (g_ == 16 && nctxn != 27 && pn_b >= 3) pn_b += 6; pn = pn_b; pm = g_ * 8 + (r_ & 7); }
#define GB_LOAD(s) { int pm_, pn_; GB_TILE_OF((s) >> 4, pm_, pn_); \
    const bf16_t* Ag_ = A + (size_t)(pm_ * 256 + lrow) * K + lkc * 8 + ((s) & 15) * 64; \
    const bf16_t* Bg_ = Bt + (size_t)(pn_ * 128 + lrow) * K + lkc * 8 + ((s) & 15) * 64; \
    ra0 = *(const uint4*)(Ag_); ra1 = *(const uint4*)(Ag_ + (size_t)32 * K); ra2 = *(const uint4*)(Ag_ + (size_t)64 * K); ra3 = *(const uint4*)(Ag_ + (size_t)96 * K); \
    ra4 = *(const uint4*)(Ag_ + (size_t)128 * K); ra5 = *(const uint4*)(Ag_ + (size_t)160 * K); ra6 = *(const uint4*)(Ag_ + (size_t)192 * K); ra7 = *(const uint4*)(Ag_ + (size_t)224 * K); \
    rb0 = *(const uint4*)(Bg_); rb1 = *(const uint4*)(Bg_ + (size_t)32 * K); rb2 = *(const uint4*)(Bg_ + (size_t)64 * K); rb3 = *(const uint4*)(Bg_ + (size_t)96 * K); }
#define GB_LSTORE() { bf16_t* ad_ = As + lrow * GLD + lkc * 8; bf16_t* bd_ = Bs + lrow * GLD + lkc * 8; \
    *(uint4*)(ad_) = ra0; *(uint4*)(ad_ + 32 * GLD) = ra1; *(uint4*)(ad_ + 64 * GLD) = ra2; *(uint4*)(ad_ + 96 * GLD) = ra3; \
    *(uint4*)(ad_ + 128 * GLD) = ra4; *(uint4*)(ad_ + 160 * GLD) = ra5; *(uint4*)(ad_ + 192 * GLD) = ra6; *(uint4*)(ad_ + 224 * GLD) = ra7; \
    *(uint4*)(bd_) = rb0; *(uint4*)(bd_ + 32 * GLD) = rb1; *(uint4*)(bd_ + 64 * GLD) = rb2; *(uint4*)(bd_ + 96 * GLD) = rb3; }
  f32x4 acc[8][4];
  if (nsteps > 0) {
    uint4 ra0, ra1, ra2, ra3, ra4, ra5, ra6, ra7, rb0, rb1, rb2, rb3;
    GB_LOAD(0);
    GB_LSTORE();
    __syncthreads();
#pragma unroll
    for (int i = 0; i < 8; ++i)
#pragma unroll
      for (int j = 0; j < 4; ++j) acc[i][j] = (f32x4){0.f, 0.f, 0.f, 0.f};
    const bf16_t* as_ = As + (wm * 128 + l15) * GLD + quad * 8;
    const bf16_t* bs_ = Bs + (wn * 64 + l15) * GLD + quad * 8;
    for (int s = 0; s < nsteps; ++s) {
      { const int s1_ = (s + 1 < nsteps) ? s + 1 : nsteps - 1; GB_LOAD(s1_); }
#pragma unroll
      for (int ks = 0; ks < 2; ++ks) {
        bf16x8 bf_[4];
#pragma unroll
        for (int i = 0; i < 4; ++i) bf_[i] = *(const bf16x8*)(bs_ + i * 16 * GLD + ks * 32);
#pragma unroll
        for (int hm = 0; hm < 2; ++hm) {
          bf16x8 af_[4];
#pragma unroll
          for (int i = 0; i < 4; ++i) af_[i] = *(const bf16x8*)(as_ + (hm * 4 + i) * 16 * GLD + ks * 32);
#pragma unroll
          for (int mi = 0; mi < 4; ++mi)
#pragma unroll
            for (int ni = 0; ni < 4; ++ni) acc[hm * 4 + mi][ni] = mfma16(bf_[ni], af_[mi], acc[hm * 4 + mi][ni]);
        }
      }
      if ((s & 15) == 15) {
        int pm, pn; GB_TILE_OF(s >> 4, pm, pn);
        const int row0 = pm * 256 + wm * 128 + l15, c0 = pn * 128 + wn * 64 + 4 * quad;
#pragma unroll
        for (int mi = 0; mi < 8; ++mi) {
          bf16_t* dst = p.pbuf() + (size_t)(row0 + mi * 16) * NCOL + c0;
#pragma unroll
          for (int ni = 0; ni < 4; ++ni) {
            *(uint2*)(dst + ni * 16) = make_uint2(pack2(acc[mi][ni][0], acc[mi][ni][1]), pack2(acc[mi][ni][2], acc[mi][ni][3]));
            acc[mi][ni] = (f32x4){0.f, 0.f, 0.f, 0.f};
          }
        }
      }
      __syncthreads();
      GB_LSTORE();
      __syncthreads();
    }
  }
#undef GB_TILE_OF
#undef GB_LOAD
#undef GB_LSTORE
}

DEV void a_chunk(const Params& p, int l, int b, int sc, bool fin, char* smem) {
  float* xcf = (float*)smem;
  bf16_t* xcb = (bf16_t*)(smem + 32 * 388 * 4);
  const int tid = tidx(), lane = tid & 63, wave = tid >> 6, quad = lane >> 4, l15 = lane & 15;
  int t0, Lseg; size_t rowbase;
  if (sc < 8) { t0 = sc * 32; Lseg = LCTX; rowbase = (size_t)NLAT + (size_t)b * LCTX; }
  else { t0 = (sc - 8) * 32; Lseg = LSEQ; rowbase = (size_t)b * LSEQ; }
  const float* cw = p.sp() + SP_CONV_W + l * 4 * 384;
  const float* cb = p.sp() + SP_CONV_B + l * 384;
  if (tid < 192) {
    const int cg = tid % 48, sg = tid / 48, ch0 = cg * 8, tb = sg * 8;
    uint4 rawr[11];
#pragma unroll
    for (int r = 0; r < 11; ++r) {
      const int tt = t0 + tb + r - 2;
      const int ttc = tt < 0 ? 0 : (tt >= Lseg ? Lseg - 1 : tt);
      rawr[r] = *(const uint4*)(p.pbuf() + (rowbase + ttc) * NCOL + COL_AX + ch0);
      if (tt != ttc) rawr[r] = make_uint4(0u, 0u, 0u, 0u);
    }
    float wv[4][8], bv[8];
    { const float4 b0 = *(const float4*)(cb + ch0), b1 = *(const float4*)(cb + ch0 + 4);
      bv[0] = b0.x; bv[1] = b0.y; bv[2] = b0.z; bv[3] = b0.w; bv[4] = b1.x; bv[5] = b1.y; bv[6] = b1.z; bv[7] = b1.w; }
#pragma unroll
    for (int w = 0; w < 4; ++w) {
      const float4 w0 = *(const float4*)(cw + w * 384 + ch0), w1 = *(const float4*)(cw + w * 384 + ch0 + 4);
      wv[w][0] = w0.x; wv[w][1] = w0.y; wv[w][2] = w0.z; wv[w][3] = w0.w; wv[w][4] = w1.x; wv[w][5] = w1.y; wv[w][6] = w1.z; wv[w][7] = w1.w;
    }
#pragma unroll
    for (int j = 0; j < 8; ++j) {
      float acc[8];
#pragma unroll
      for (int e = 0; e < 8; ++e) acc[e] = bv[e];
#pragma unroll
      for (int w = 0; w < 4; ++w) {
        float xs[8]; unpack8(rawr[j + w], xs);
#pragma unroll
        for (int e = 0; e < 8; ++e) acc[e] += xs[e] * wv[w][e];
      }
      const int t = tb + j;
      *(float4*)(xcf + t * 388 + ch0) = make_float4(acc[0], acc[1], acc[2], acc[3]);
      *(float4*)(xcf + t * 388 + ch0 + 4) = make_float4(acc[4], acc[5], acc[6], acc[7]);
      *(uint4*)(xcb + t * 392 + ch0) = make_uint4(pack2(acc[0], acc[1]), pack2(acc[2], acc[3]), pack2(acc[4], acc[5]), pack2(acc[6], acc[7]));
    }
  }
  __syncthreads();
  bf16x8 wrN[2][2], wiN[2][2]; float brN[2], biN[2], spN[2], hcN[2]; bf16_t gtN[2][4];
#define A_LOAD(HN) { \
    const int h_ = wave * 2 + (HN) / 3, nt_ = (HN) % 3, ch_ = h_ * 48 + nt_ * 16 + l15; \
    _Pragma("unroll") for (int d_ = 0; d_ < 2; ++d_) { \
      const bf16x8* gp_ = (const bf16x8*)p.gatepack() + (size_t)(((l * 2 + d_) * 8 + h_) * 2) * 6 * 64 + lane; \
      _Pragma("unroll") for (int ks_ = 0; ks_ < 2; ++ks_) { wrN[d_][ks_] = gp_[(ks_ * 3 + nt_) * 64]; wiN[d_][ks_] = gp_[(6 + ks_ * 3 + nt_) * 64]; } \
      brN[d_] = p.sp()[SP_BR + (l * 2 + d_) * 384 + ch_]; biN[d_] = p.sp()[SP_BI + (l * 2 + d_) * 384 + ch_]; \
      spN[d_] = p.sp()[SP_ASP + (l * 2 + d_) * 384 + ch_]; \
      hcN[d_] = fin ? p.aCarry()[((size_t)(b * 2 + d_) * ACH + sc) * 384 + ch_] : 0.f; } \
    if (fin) { _Pragma("unroll") for (int mt_ = 0; mt_ < 2; ++mt_) _Pragma("unroll") for (int jj_ = 0; jj_ < 4; ++jj_) \
      gtN[mt_][jj_] = p.pbuf()[(rowbase + t0 + mt_ * 16 + quad * 4 + jj_) * NCOL + COL_AG + ch_]; } }
  A_LOAD(0);
#pragma unroll 1
  for (int hn = 0; hn < 6; ++hn) {
    const int h = wave * 2 + hn / 3, nt = hn % 3;
    const int ch = h * 48 + nt * 16 + l15;
    f32x4 hf[2], pfv[2];
    bf16x8 wrA[2][2], wiA[2][2]; float brA[2], biA[2], spA[2], hcA[2]; bf16_t gtA[2][4];
#pragma unroll
    for (int d = 0; d < 2; ++d) {
#pragma unroll
      for (int ks = 0; ks < 2; ++ks) { wrA[d][ks] = wrN[d][ks]; wiA[d][ks] = wiN[d][ks]; }
      brA[d] = brN[d]; biA[d] = biN[d]; spA[d] = spN[d]; hcA[d] = hcN[d];
    }
#pragma unroll
    for (int mt = 0; mt < 2; ++mt)
#pragma unroll
      for (int jj = 0; jj < 4; ++jj) gtA[mt][jj] = gtN[mt][jj];
    { const int hn2 = hn < 5 ? hn + 1 : 5; A_LOAD(hn2); }
#pragma unroll
    for (int d = 0; d < 2; ++d) {
      const bf16x8 (&wr)[2] = wrA[d]; const bf16x8 (&wi)[2] = wiA[d];
      const size_t cidx = ((size_t)(b * 2 + d) * ACH + sc) * 384;
      const float br = brA[d], bi = biA[d], sp = spA[d];
      float hc = hcA[d], Pc = 1.f;
      const int lq = d ? 3 - quad : quad;
      const int s1 = d ? ((lane + 16) & 63) : ((lane - 16) & 63), s2 = d ? ((lane + 32) & 63) : ((lane - 32) & 63);
      const int lastl = d ? l15 : 48 + l15;
#pragma unroll
      for (int mi = 0; mi < 2; ++mi) {
        const int mt = d ? 1 - mi : mi;
        bf16x8 a0 = *(const bf16x8*)(xcb + (mt * 16 + l15) * 392 + h * 48 + quad * 8);
        bf16x8 a1 = {0, 0, 0, 0, 0, 0, 0, 0};
        if (quad < 2) a1 = *(const bf16x8*)(xcb + (mt * 16 + l15) * 392 + h * 48 + 32 + quad * 8);
        f32x4 ra = {0.f, 0.f, 0.f, 0.f}, ia = {0.f, 0.f, 0.f, 0.f};
        ra = mfma16(a0, wr[0], ra); ra = mfma16(a1, wr[1], ra);
        ia = mfma16(a0, wi[0], ia); ia = mfma16(a1, wi[1], ia);
        float av[4], uv[4];
#pragma unroll
        for (int jj = 0; jj < 4; ++jj) {
          const int tok = mt * 16 + quad * 4 + jj;
          const float xv = xcf[tok * 388 + ch];
          const float r = sigm(ra[jj] + br), ig = sigm(ia[jj] + bi);
          const float la = -r * sp;
          av[jj] = __expf(la);
          uv[jj] = __builtin_amdgcn_sqrtf(fmaxf(1.f - av[jj] * av[jj], 0.f)) * ig * xv;
        }
        float P = 1.f, H = 0.f, pl[4], hl[4];
#pragma unroll
        for (int q = 0; q < 4; ++q) { const int jj = d ? 3 - q : q; H = av[jj] * H + uv[jj]; P *= av[jj]; pl[jj] = P; hl[jj] = H; }
        float Pi = P, Hi = H;
        { float Ps = __shfl(Pi, s1), Hs = __shfl(Hi, s1); if (lq >= 1) { Hi = Pi * Hs + Hi; Pi = Pi * Ps; } }
        { float Ps = __shfl(Pi, s2), Hs = __shfl(Hi, s2); if (lq >= 2) { Hi = Pi * Hs + Hi; Pi = Pi * Ps; } }
        const float Pt = __shfl(Pi, lastl), Ht = __shfl(Hi, lastl);
        if (fin) {
          float Pe = __shfl(Pi, s1), He = __shfl(Hi, s1);
          if (lq == 0) { Pe = 1.f; He = 0.f; }
          const float hin = Pe * hc + He;
#pragma unroll
          for (int jj = 0; jj < 4; ++jj) {
            const float hv = pl[jj] * hin + hl[jj];
            if (d == 0) hf[mt][jj] = hv;
            else {
              const size_t row = rowbase + t0 + mt * 16 + quad * 4 + jj;
              p.hbuf()[row * 1024 + ch] = f2bf((hf[mt][jj] + hv) * siluf(bf2f(gtA[mt][jj])));
            }
          }
        }
        if (!fin) {
          float Pe = __shfl(Pi, s1), He = __shfl(Hi, s1);
          if (lq == 0) { Pe = 1.f; He = 0.f; }
          const float hin = Pe * hc + He, pin = Pe * Pc;
#pragma unroll
          for (int jj = 0; jj < 4; ++jj) {
            const float hv = pl[jj] * hin + hl[jj], pc = pl[jj] * pin;
            if (d == 0) { hf[mt][jj] = hv; pfv[mt][jj] = pc; }
            else {
              const size_t row = rowbase + t0 + mt * 16 + quad * 4 + jj;
              *(uint2*)(p.apk() + (row * 384 + ch) * 4) = make_uint2(pack2(hf[mt][jj] + hv, pfv[mt][jj]), pack2(pc, 0.f));
            }
          }
        }
        hc = Pt * hc + Ht; Pc *= Pt;
      }
      if (!fin && quad == 0) *(float2*)(p.aPH() + (cidx + ch) * 2) = make_float2(Pc, hc);
    }
  }
  __syncthreads();
}

#undef A_LOAD
DEV void a_light_task(const Params& p, int l, int t64) {
  const int tid = tidx();
#pragma unroll 4
  for (int k = 0; k < 24; ++k) {
    const int idx = tid + 256 * k;
    const int rr = idx / 96, c4 = idx - rr * 96, ch0 = c4 * 4;
    const size_t row = (size_t)t64 * 64 + rr;
    int b, sc;
    if (row < (size_t)NLAT) { b = (int)(row >> 12); sc = 8 + (((int)row & 4095) >> 5); }
    else { const int r2 = (int)row - NLAT; b = r2 >> 8; sc = (r2 & 255) >> 5; }
    const uint4 q0 = *(const uint4*)(p.apk() + (row * 384 + ch0) * 4), q1 = *(const uint4*)(p.apk() + (row * 384 + ch0) * 4 + 8);
    const float4 cf = *(const float4*)(p.aCarry() + ((size_t)(b * 2 + 0) * ACH + sc) * 384 + ch0);
    const float4 cb = *(const float4*)(p.aCarry() + ((size_t)(b * 2 + 1) * ACH + sc) * 384 + ch0);
    const uint2 g = *(const uint2*)(p.pbuf() + row * NCOL + COL_AG + ch0);
    const float y0 = (bflo(q0.x) + bfhi(q0.x) * cf.x + bflo(q0.y) * cb.x) * siluf(bflo(g.x));
    const float y1 = (bflo(q0.z) + bfhi(q0.z) * cf.y + bflo(q0.w) * cb.y) * siluf(bfhi(g.x));
    const float y2 = (bflo(q1.x) + bfhi(q1.x) * cf.z + bflo(q1.y) * cb.z) * siluf(bflo(g.y));
    const float y3 = (bflo(q1.z) + bfhi(q1.z) * cf.w + bflo(q1.w) * cb.w) * siluf(bfhi(g.y));
    *(uint2*)(p.hbuf() + row * 1024 + ch0) = make_uint2(pack2(y0, y1), pack2(y2, y3));
  }
}

DEV void b_logf_scan(const Params& p, int l, int h, int d, const uint4 (&rawf)[3], float* Lf, float* GL, float* OFFp) {
  const int tid = tidx();
  float* SEG = OFFp + 768;
  const float* lbp = p.lbs() + l * 384 + h * 96;
#pragma unroll
  for (int it = 0; it < 3; ++it) {
    const int idx = tid + 256 * it, tok = idx / 12, g8 = idx % 12;
    float xs[8]; unpack8(rawf[it], xs);
    const float4 lb0 = *(const float4*)(lbp + g8 * 8), lb1 = *(const float4*)(lbp + g8 * 8 + 4);
    const float lbv[8] = {lb0.x, lb0.y, lb0.z, lb0.w, lb1.x, lb1.y, lb1.z, lb1.w};
#pragma unroll
    for (int e = 0; e < 8; ++e) { const float lb = lbv[e]; const float f = lb + (1.f - lb) * sigm(xs[e]); Lf[tok * 97 + g8 * 8 + e] = __logf(f); }
  }
  __syncthreads();
#pragma unroll
  for (int it = 0; it < 3; ++it) {
    const int item = tid + 256 * it, c = item % 96, sg = item / 96;
    float run = 0.f;
#pragma unroll
    for (int j = 0; j < 8; ++j) { const int pp = sg * 8 + j, tok = d ? 63 - pp : pp; run += Lf[tok * 97 + c]; Lf[tok * 97 + c] = run; }
    SEG[sg * 96 + c] = run;
  }
  __syncthreads();
#pragma unroll
  for (int it = 0; it < 3; ++it) {
    const int item = tid + 256 * it, c = item % 96, sg = item / 96;
    float off = 0.f;
#pragma unroll
    for (int s = 0; s < 7; ++s) { const float t = SEG[s * 96 + c]; off += (s < sg) ? t : 0.f; }
    OFFp[sg * 96 + c] = off;
    if (sg == 7) GL[c] = off + SEG[7 * 96 + c];
  }
  __syncthreads();
}

DEV void b_kv_task(const Params& p, int l, int task, char* smem) {
  const int n = task % BSL, s = task / BSL, d = s & 1, h = (s >> 1) & 3, b = s >> 3;
  size_t rowbase;
  if (n < 4) { int cj = d ? 3 - n : n; rowbase = (size_t)NLAT + b * LCTX + cj * 64; }
  else { int cj = d ? 63 - (n - 4) : n - 4; rowbase = (size_t)b * LSEQ + cj * 64; }
  float* Lf = (float*)smem; float* GL = Lf + 64 * 97;
  bf16_t* Kt = (bf16_t*)(smem + 25600);
  bf16_t* Vt = Kt + 96 * 72;
  float* OFFp = (float*)(smem + 53248);
  const int tid = tidx(), lane = tid & 63, wave = tid >> 6, quad = lane >> 4, l15 = lane & 15;
  const int fcol = (d ? COL_BFB : COL_BFF) + h * 96;
  uint4 rawf[3], rawv[3];
#pragma unroll
  for (int it = 0; it < 3; ++it) {
    const int idx = tid + 256 * it, tok = idx / 12, g8 = idx % 12;
    rawf[it] = *(const uint4*)(p.pbuf() + (rowbase + tok) * NCOL + fcol + g8 * 8);
    rawv[it] = *(const uint4*)(p.pbuf() + (rowbase + tok) * NCOL + COL_BI + h * 96 + g8 * 8);
  }
  b_logf_scan(p, l, h, d, rawf, Lf, GL, OFFp);
  const float* lbp = p.lbs() + l * 384 + h * 96;
#pragma unroll
  for (int it = 0; it < 3; ++it) {
    const int idx = tid + 256 * it, tok = idx / 12, g8 = idx % 12;
    const int pp = d ? 63 - tok : tok;
    float xs[8]; unpack8(rawf[it], xs);
    const unsigned vv[4] = {rawv[it].x, rawv[it].y, rawv[it].z, rawv[it].w};
    float kend[8];
    const float4 lb0 = *(const float4*)(lbp + g8 * 8), lb1 = *(const float4*)(lbp + g8 * 8 + 4);
    const float lbv[8] = {lb0.x, lb0.y, lb0.z, lb0.w, lb1.x, lb1.y, lb1.z, lb1.w};
#pragma unroll
    for (int e = 0; e < 8; ++e) {
      const int dk = g8 * 8 + e;
      const float lb = lbv[e];
      const float k = (1.f - lb) * (1.f - sigm(xs[e]));
      const float G = Lf[tok * 97 + dk] + OFFp[(pp >> 3) * 96 + dk];
      kend[e] = k * __expf(GL[dk] - G);
    }
    const unsigned kp[4] = {pack2(kend[0], kend[1]), pack2(kend[2], kend[3]), pack2(kend[4], kend[5]), pack2(kend[6], kend[7])};
    bf16_t* kd = Kt + g8 * 8 * 72 + tok; bf16_t* vd = Vt + g8 * 8 * 72 + tok;
    const int rot = g8 & 7;
#pragma unroll
    for (int e0 = 0; e0 < 8; ++e0) {
      const int e = (e0 + rot) & 7;
      const unsigned kw = (e & 2) ? ((e & 4) ? kp[3] : kp[1]) : ((e & 4) ? kp[2] : kp[0]);
      const unsigned vw = (e & 2) ? ((e & 4) ? vv[3] : vv[1]) : ((e & 4) ? vv[2] : vv[0]);
      kd[e * 72] = (bf16_t)((e & 1) ? (kw >> 16) : (kw & 0xffffu));
      vd[e * 72] = (bf16_t)((e & 1) ? (vw >> 16) : (vw & 0xffffu));
    }
  }
  if (tid < 96) p.decay()[(size_t)task * 96 + tid] = __expf(GL[tid]);
  __syncthreads();
  bf16_t* dst = p.kvbuf() + (size_t)task * 9216;
  for (int i = 0; i < 9; ++i) {
    const int ti = wave * 9 + i, mt = ti / 6, nt = ti % 6;
    f32x4 acc = {0.f, 0.f, 0.f, 0.f};
#pragma unroll
    for (int ks = 0; ks < 2; ++ks) {
      bf16x8 ka = *(const bf16x8*)(Kt + (nt * 16 + l15) * 72 + ks * 32 + quad * 8);
      bf16x8 vb = *(const bf16x8*)(Vt + (mt * 16 + l15) * 72 + ks * 32 + quad * 8);
      acc = mfma16(ka, vb, acc);
    }
    *(uint2*)(dst + (mt * 16 + l15) * 96 + nt * 16 + 4 * quad) = make_uint2(pack2(acc[0], acc[1]), pack2(acc[2], acc[3]));
  }
  __syncthreads();
}

DEV void b_state_scan(const Params& p, int gidx) {
  const int dk8 = gidx % 12, dv = (gidx / 12) % 96, s = gidx / 1152;
  bf16_t* base = p.kvbuf() + (size_t)s * BSL * 9216 + dv * 96 + dk8 * 8;
  const float* dec = p.decay() + (size_t)s * BSL * 96 + dk8 * 8;
  float S[8];
#pragma unroll
  for (int e = 0; e < 8; ++e) S[e] = 0.f;
  uint4 kv[4]; float4 d0[4], d1[4];
#pragma unroll
  for (int i = 0; i < 4; ++i) { kv[i] = *(const uint4*)(base + (size_t)i * 9216); d0[i] = *(const float4*)(dec + i * 96); d1[i] = *(const float4*)(dec + i * 96 + 4); }
#pragma unroll 1
  for (int n0 = 0; n0 < BSL; n0 += 4) {
    uint4 kvn[4]; float4 dn0[4], dn1[4];
    {
      const int nn = (n0 + 4 < BSL) ? n0 + 4 : n0;
#pragma unroll
      for (int i = 0; i < 4; ++i) { kvn[i] = *(const uint4*)(base + (size_t)(nn + i) * 9216); dn0[i] = *(const float4*)(dec + (nn + i) * 96); dn1[i] = *(const float4*)(dec + (nn + i) * 96 + 4); }
    }
#pragma unroll
    for (int i = 0; i < 4; ++i) {
      *(uint4*)(base + (size_t)(n0 + i) * 9216) = make_uint4(pack2(S[0], S[1]), pack2(S[2], S[3]), pack2(S[4], S[5]), pack2(S[6], S[7]));
      float kf[8]; unpack8(kv[i], kf);
      S[0] = d0[i].x * S[0] + kf[0]; S[1] = d0[i].y * S[1] + kf[1]; S[2] = d0[i].z * S[2] + kf[2]; S[3] = d0[i].w * S[3] + kf[3];
      S[4] = d1[i].x * S[4] + kf[4]; S[5] = d1[i].y * S[5] + kf[5]; S[6] = d1[i].z * S[6] + kf[6]; S[7] = d1[i].w * S[7] + kf[7];
    }
#pragma unroll
    for (int i = 0; i < 4; ++i) { kv[i] = kvn[i]; d0[i] = dn0[i]; d1[i] = dn1[i]; }
  }
}

DEV void a_carry_wave(const Params& p, int widx) {
  const int lane = tidx() & 63;
  const int ch = widx % 384, d = (widx / 384) & 1, b = widx / 768;
  const float2* ph = (const float2*)p.aPH() + (size_t)(b * 2 + d) * ACH * 384 + ch;
  float* cr = p.aCarry() + (size_t)(b * 2 + d) * ACH * 384 + ch;
  float P[3], H[3]; int scv[3]; bool valid[3];
#pragma unroll
  for (int j = 0; j < 3; ++j) {
    const int pos = lane * 3 + j;
    valid[j] = pos < ACH;
    scv[j] = d ? (pos < 8 ? 7 - pos : ACH - 1 - (pos - 8)) : pos;
    float2 v = make_float2(1.f, 0.f);
    if (valid[j]) v = ph[(size_t)scv[j] * 384];
    P[j] = v.x; H[j] = v.y;
  }
  float Pi = P[0], Hi = H[0];
  Hi = P[1] * Hi + H[1]; Pi *= P[1];
  Hi = P[2] * Hi + H[2]; Pi *= P[2];
#pragma unroll
  for (int o = 1; o < 64; o <<= 1) {
    const float Ps = __shfl_up(Pi, o), Hs = __shfl_up(Hi, o);
    if (lane >= o) { Hi = Pi * Hs + Hi; Pi = Pi * Ps; }
  }
  float He = __shfl_up(Hi, 1);
  if (lane == 0) He = 0.f;
  const float c0 = He, c1 = P[0] * c0 + H[0], c2 = P[1] * c1 + H[1];
  if (valid[0]) cr[(size_t)scv[0] * 384] = c0;
  if (valid[1]) cr[(size_t)scv[1] * 384] = c1;
  if (valid[2]) cr[(size_t)scv[2] * 384] = c2;
}

DEV void b_out_task(const Params& p, int l, int b, int h, int seg, int cj, char* smem) {
  const size_t rowbase = seg == 0 ? (size_t)NLAT + b * LCTX + cj * 64 : (size_t)b * LSEQ + cj * 64;
  float* Lf = (float*)smem; float* GL = Lf + 64 * 97;
  bf16_t* Qs = (bf16_t*)(smem + 25600);
  bf16_t* Ks = (bf16_t*)(smem + 38912);
  bf16_t* Vt = (bf16_t*)(smem + 52224);
  bf16_t* Sc = (bf16_t*)(smem + 66048);
  float* OFFp = (float*)(smem + 66048);
  const int tid = tidx(), lane = tid & 63, wave = tid >> 6, quad = lane >> 4, l15 = lane & 15;
  uint4 rawv[3], rawq[3], rawf0[3], rawf1[3];
#pragma unroll
  for (int it = 0; it < 3; ++it) {
    const int idx = tid + 256 * it, tok = idx / 12, g8 = idx % 12;
    const bf16_t* rp = p.pbuf() + (rowbase + tok) * NCOL + h * 96 + g8 * 8;
    rawv[it] = *(const uint4*)(rp + COL_BI); rawq[it] = *(const uint4*)(rp + COL_BQ);
    rawf0[it] = *(const uint4*)(rp + COL_BFF); rawf1[it] = *(const uint4*)(rp + COL_BFB);
  }
  bf16_t gt[4][6];
#pragma unroll
  for (int jj = 0; jj < 4; ++jj)
#pragma unroll
    for (int nt = 0; nt < 6; ++nt) gt[jj][nt] = p.pbuf()[(rowbase + wave * 16 + 4 * quad + jj) * NCOL + COL_BG + h * 96 + nt * 16 + l15];
#pragma unroll
  for (int it = 0; it < 3; ++it) {
    const int idx = tid + 256 * it, tok = idx / 12, g8 = idx % 12;
    const unsigned vv[4] = {rawv[it].x, rawv[it].y, rawv[it].z, rawv[it].w};
    bf16_t* vd = Vt + g8 * 8 * 72 + tok;
    const int rot = g8 & 7;
#pragma unroll
    for (int e0 = 0; e0 < 8; ++e0) {
      const int e = (e0 + rot) & 7;
      const unsigned vw = (e & 2) ? ((e & 4) ? vv[3] : vv[1]) : ((e & 4) ? vv[2] : vv[0]);
      vd[e * 72] = (bf16_t)((e & 1) ? (vw >> 16) : (vw & 0xffffu));
    }
  }
  f32x4 oacc[6];
#pragma unroll
  for (int nt = 0; nt < 6; ++nt) oacc[nt] = (f32x4){0.f, 0.f, 0.f, 0.f};
  const float* lbp = p.lbs() + l * 384 + h * 96;
#pragma unroll
  for (int d = 0; d < 2; ++d) {
    const int n = seg == 0 ? (d ? 3 - cj : cj) : 4 + (d ? 63 - cj : cj);
    const size_t stream = (size_t)(b * 4 + h) * 2 + d;
    const bf16_t* St = p.kvbuf() + (stream * BSL + n) * 9216;
    b_logf_scan(p, l, h, d, d ? rawf1 : rawf0, Lf, GL, OFFp);
#pragma unroll
    for (int it = 0; it < 3; ++it) {
      const int idx = tid + 256 * it, tok = idx / 12, g8 = idx % 12;
      const int pp = d ? 63 - tok : tok;
      float xs[8], qs[8], qg[8], kg[8]; unpack8(d ? rawf1[it] : rawf0[it], xs); unpack8(rawq[it], qs);
      const float4 lb0 = *(const float4*)(lbp + g8 * 8), lb1 = *(const float4*)(lbp + g8 * 8 + 4);
      const float lbv[8] = {lb0.x, lb0.y, lb0.z, lb0.w, lb1.x, lb1.y, lb1.z, lb1.w};
#pragma unroll
      for (int e = 0; e < 8; ++e) {
        const int dk = g8 * 8 + e;
        const float lb = lbv[e];
        const float k = (1.f - lb) * (1.f - sigm(xs[e]));
        const float G = Lf[tok * 97 + dk] + OFFp[(pp >> 3) * 96 + dk];
        qg[e] = siluf(qs[e]) * __expf(G);
        kg[e] = k * __expf(-G);
      }
      *(uint4*)(Qs + tok * 104 + g8 * 8) = make_uint4(pack2(qg[0], qg[1]), pack2(qg[2], qg[3]), pack2(qg[4], qg[5]), pack2(qg[6], qg[7]));
      *(uint4*)(Ks + tok * 104 + g8 * 8) = make_uint4(pack2(kg[0], kg[1]), pack2(kg[2], kg[3]), pack2(kg[4], kg[5]), pack2(kg[6], kg[7]));
    }
    __syncthreads();
    bf16x8 qa[3];
#pragma unroll
    for (int ks = 0; ks < 3; ++ks) qa[ks] = *(const bf16x8*)(Qs + (wave * 16 + l15) * 104 + ks * 32 + quad * 8);
    bf16x8 sfr[6][3];
#pragma unroll
    for (int nt = 0; nt < 6; ++nt)
#pragma unroll
      for (int ks = 0; ks < 3; ++ks) sfr[nt][ks] = *(const bf16x8*)(St + (nt * 16 + l15) * 96 + ks * 32 + quad * 8);
#pragma unroll
    for (int nt = 0; nt < 4; ++nt) {
      f32x4 acc = {0.f, 0.f, 0.f, 0.f};
#pragma unroll
      for (int ks = 0; ks < 3; ++ks) acc = mfma16(qa[ks], *(const bf16x8*)(Ks + (nt * 16 + l15) * 104 + ks * 32 + quad * 8), acc);
      int cb_ = wave * 16 + 4 * quad - nt * 16 - l15;
      asm volatile("" : "+v"(cb_));
      if (d) cb_ = -cb_;
#pragma unroll
      for (int jj = 0; jj < 4; ++jj) {
        const int cc = wave * 16 + 4 * quad + jj, ss = nt * 16 + l15;
        const int df = d ? cb_ - jj : cb_ + jj;
        Sc[cc * 72 + ss] = f2bf(df >= 0 ? acc[jj] : 0.f);
      }
    }
    __syncthreads();
    bf16x8 sa[2];
#pragma unroll
    for (int ks = 0; ks < 2; ++ks) sa[ks] = *(const bf16x8*)(Sc + (wave * 16 + l15) * 72 + ks * 32 + quad * 8);
#pragma unroll
    for (int nt = 0; nt < 6; ++nt) {
#pragma unroll
      for (int ks = 0; ks < 2; ++ks) oacc[nt] = mfma16(sa[ks], *(const bf16x8*)(Vt + (nt * 16 + l15) * 72 + ks * 32 + quad * 8), oacc[nt]);
#pragma unroll
      for (int ks = 0; ks < 3; ++ks) oacc[nt] = mfma16(qa[ks], sfr[nt][ks], oacc[nt]);
    }
  }
  const float* gw = p.sp() + SP_BNW + l * 384 + h * 96;
  float gwv[6];
#pragma unroll
  for (int nt = 0; nt < 6; ++nt) gwv[nt] = gw[nt * 16 + l15];
#pragma unroll
  for (int jj = 0; jj < 4; ++jj) {
    float ss = 0.f;
#pragma unroll
    for (int nt = 0; nt < 6; ++nt) ss += oacc[nt][jj] * oacc[nt][jj];
    ss = row_sum16(ss);
    const float rstd = rsqrtf(ss * (1.f / 96.f) + EPSV);
    const size_t row = rowbase + wave * 16 + 4 * quad + jj;
#pragma unroll
    for (int nt = 0; nt < 6; ++nt) {
      const int dv = nt * 16 + l15;
      p.hbuf()[row * 1024 + 384 + h * 96 + dv] = f2bf(oacc[nt][jj] * rstd * gwv[nt] * siluf(bf2f(gt[jj][nt])));
    }
  }
  __syncthreads();
}

DEV void c_task(const Params& p, int l, size_t rowbase, char* smem) {
  bf16_t* Vt = (bf16_t*)smem;
  const int tid = tidx(), lane = tid & 63, wave = tid >> 6, quad = lane >> 4, l15 = lane & 15;
  {
    const float* cnw = p.sp() + SP_CNW + l * 256 + l15 * 16;
    const int sub = lane >> 4;
    float nwv[16];
#pragma unroll
    for (int i = 0; i < 4; ++i) { const float4 t = *(const float4*)(cnw + 4 * i); nwv[4 * i] = t.x; nwv[4 * i + 1] = t.y; nwv[4 * i + 2] = t.z; nwv[4 * i + 3] = t.w; }
#pragma unroll 1
    for (int g0 = 0; g0 < 8; g0 += 4) {
      uint4 r0[4], r1[4];
#pragma unroll
      for (int g = 0; g < 4; ++g) {
        const bf16_t* src = p.pbuf() + (rowbase + wave * 32 + (g0 + g) * 4 + sub) * NCOL + COL_CV + l15 * 16;
        r0[g] = *(const uint4*)src; r1[g] = *(const uint4*)(src + 8);
      }
#pragma unroll
      for (int g = 0; g < 4; ++g) {
        const int tok = wave * 32 + (g0 + g) * 4 + sub;
        float v[16]; unpack8(r0[g], v); unpack8(r1[g], v + 8);
        float s = 0.f;
#pragma unroll
        for (int i = 0; i < 16; ++i) { v[i] = geluf(v[i]); s += v[i]; }
        s = row_sum16(s);
        const float mu = s * (1.f / 256.f);
        float q = 0.f;
#pragma unroll
        for (int i = 0; i < 16; ++i) { v[i] -= mu; q += v[i] * v[i]; }
        q = row_sum16(q);
        const float rstd = rsqrtf(q * (1.f / 256.f) + EPSV);
        bf16_t* dstp = Vt + (l15 * 16) * 136 + ((((tok >> 3) ^ l15) & 15) << 3) + (tok & 7);
#pragma unroll
        for (int i = 0; i < 16; ++i) dstp[i * 136] = f2bf(v[i] * rstd * nwv[i]);
      }
    }
  }
  __syncthreads();
  const int h = wave;
  const bf16_t* ws = p.cws() + ((size_t)l * 4 + h) * 128 * 128;
  const float* bs = p.sp() + SP_CBS + (l * 4 + h) * 128;
  for (int mt = 0; mt < 8; ++mt) {
    bf16_t ur[4][4], gr[4][4]; float bias[4];
#pragma unroll
    for (int jj = 0; jj < 4; ++jj) {
      const size_t row = rowbase + mt * 16 + 4 * quad + jj;
      bias[jj] = bs[mt * 16 + 4 * quad + jj];
#pragma unroll
      for (int nt = 0; nt < 4; ++nt) {
        const int ch = h * 64 + nt * 16 + l15;
        ur[jj][nt] = p.pbuf()[row * NCOL + COL_CU + ch];
        gr[jj][nt] = p.pbuf()[row * NCOL + COL_CG + ch];
      }
    }
    f32x4 acc[4];
#pragma unroll
    for (int nt = 0; nt < 4; ++nt) acc[nt] = (f32x4){0.f, 0.f, 0.f, 0.f};
#pragma unroll
    for (int ks = 0; ks < 4; ++ks) {
      const bf16x8 wfrag = *(const bf16x8*)(ws + (mt * 16 + l15) * 128 + ks * 32 + quad * 8);
#pragma unroll
      for (int nt = 0; nt < 4; ++nt) acc[nt] = mfma16(wfrag, *(const bf16x8*)(Vt + (h * 64 + nt * 16 + l15) * 136 + ((((ks * 4 + quad) ^ (h * 4 + nt)) & 15) << 3)), acc[nt]);
    }
#pragma unroll
    for (int jj = 0; jj < 4; ++jj) {
      const size_t row = rowbase + mt * 16 + 4 * quad + jj;
#pragma unroll
      for (int nt = 0; nt < 4; ++nt) {
        const int ch = h * 64 + nt * 16 + l15;
        p.hbuf()[row * 1024 + 768 + ch] = f2bf(geluf(bf2f(ur[jj][nt])) * (acc[nt][jj] + bias[jj]) * siluf(bf2f(gr[jj][nt])));
      }
    }
  }
  __syncthreads();
}

#ifndef TIMING
#define TIMING 0
#endif
#if TIMING
#define TSH ((unsigned long long*)(smem + 76000))
#define TT_BEGIN() unsigned long long tt0_ = 0; if (bid == 0 && tidx() == 0) tt0_ = __builtin_amdgcn_s_memrealtime();
#define TT_END(code) if (bid == 0 && tidx() == 0) { unsigned long long d_ = __builtin_amdgcn_s_memrealtime() - tt0_; if ((code) == TIMING_A) TSH[1] += d_; if ((code) == TIMING_B) TSH[2] += d_; }
#else
#define TT_BEGIN()
#define TT_END(code)
#endif
#ifndef DBG_SUB
#define DBG_SUB 7
#endif
DEV void phase_m1(const Params& p, int l, int bid, int nblk, char* smem) {
  const int nC = (l == 0) ? 272 : 256;
  const int nBk = NB * 4 * 2 * BSL;
  const int nA = NB * ACH;
  const int NT = nA + nC + nBk;
  for (int task = bid; task < NT; task += nblk) {
    int t = task;
    if (t < nA) { TT_BEGIN(); if (DBG_SUB & 4) a_chunk(p, l, t / ACH, t % ACH, false, smem); TT_END(12); continue; }
    t -= nA;
    if (t < nC) {
      size_t rowbase = (t < 256) ? (size_t)(t >> 5) * LSEQ + (t & 31) * 128 : (size_t)NLAT + ((t - 256) >> 1) * LCTX + ((t - 256) & 1) * 128;
      TT_BEGIN(); if (DBG_SUB & 1) c_task(p, l, rowbase, smem); TT_END(10);
      continue;
    }
    t -= nC;
    { TT_BEGIN(); if (DBG_SUB & 2) b_kv_task(p, l, t, smem); TT_END(11); }
  }
}

DEV void phase_m2(const Params& p, int l, int bid, int nblk, char* smem) {
  constexpr int TT = 64 * 96 * 12;
  const int chunk = (TT + nblk - 1) / nblk;
  const int g_end = (bid + 1) * chunk < TT ? (bid + 1) * chunk : TT;
  for (int g = bid * chunk + tidx(); g < g_end; g += 256) b_state_scan(p, g);
  constexpr int NAB = 1536;
  for (int task = bid; task < NAB; task += nblk) a_carry_wave(p, task * 4 + (tidx() >> 6));
}

DEV void phase_m3(const Params& p, int l, int bid, int nblk, char* smem) {
  const int nB = (l == 0) ? 2048 + 128 : 2048;
  const int nA = (l == 0) ? MROWS / 64 : NLAT / 64;
  for (int task = bid; task < nB + nA; task += nblk) {
    int t = task;
    if (t < nB) {
      if (!(DBG_SUB & 2)) continue;
      TT_BEGIN();
      if (t < 2048) b_out_task(p, l, t >> 8, (t >> 6) & 3, 1, t & 63, smem);
      else { int i2 = t - 2048; b_out_task(p, l, i2 >> 4, (i2 >> 2) & 3, 0, i2 & 3, smem); }
      TT_END(13);
      continue;
    }
    t -= nB;
    if (!(DBG_SUB & 4)) continue;
    TT_BEGIN();
    a_light_task(p, l, t);
    TT_END(14);
  }
}

#ifndef DBG_MASK
#define DBG_MASK 0xff
#endif
DEV void run_phase(const Params& p, int ph, int l, int bid, int nblk, char* smem) {
  if (!((DBG_MASK >> ph) & 1)) return;
  switch (ph) {
    case 0: phase_prep(p, bid, nblk, smem); break;
    case 1: phase_norm(p, l, bid, nblk); break;
    case 2: {
      const int nctxn = (l == 0) ? 27 : 12;
      const int Ttot = (NLAT / 256) * (NCOL / 128) + 8 * nctxn;
      const int Tx = (Ttot + 7) >> 3, perx = nblk >> 3;
      const int full = ((Tx % perx) * 2 <= perx) ? Tx / perx : Tx / perx + 1;
      phase_gemm_big(p, p.hbuf(), p.wtin() + (size_t)l * NCOL * 1024, MROWS, NCOL, smem, bid, nblk, full, Ttot, nctxn);
      phase_gemm<0, 1>(p, l, p.hbuf(), p.wtin() + (size_t)l * NCOL * 1024, MROWS, NCOL, smem, bid, nblk, full, Ttot, nctxn);
      break; }
    case 3: phase_m1(p, l, bid, nblk, smem); break;
    case 4: phase_m2(p, l, bid, nblk, smem); break;
    case 5: phase_m3(p, l, bid, nblk, smem); break;
    case 6: phase_gemm<1>(p, l, p.hbuf(), p.wtout() + (size_t)l * 1024 * 1024, (l == 0) ? MROWS : NLAT, 1024, smem, bid, nblk); break;
    default: phase_final(p, bid, nblk); break;
  }
}

#define XB_TMO      128
#define XB_XCNT(j)  (256  + 64 * (j))
#define XB_XSUB(j)  (1280 + 64 * (j))
#define XB_XGEN(j)  (2304 + 64 * (j))
#define XB_TOP      3328
#define XB_TOPGEN   3392
#define XCD_BAR_WORDS 3456
#define XB_SPIN_CAP (1u << 18)
#define LAS __attribute__((address_space(3)))

__device__ __forceinline__ unsigned xb_ld(unsigned* p)              { return __hip_atomic_load(p, __ATOMIC_RELAXED, __HIP_MEMORY_SCOPE_AGENT); }
__device__ __forceinline__ unsigned xb_add(unsigned* p, unsigned v) { return __hip_atomic_fetch_add(p, v, __ATOMIC_RELAXED, __HIP_MEMORY_SCOPE_AGENT); }
__device__ __forceinline__ unsigned xb_xcc_id() { return (unsigned)__builtin_amdgcn_s_getreg((3 << 11) | 20) & 0xFu; }
#define XB_SPIN(cond, bar) do { unsigned _sp = 0; while (cond) { __builtin_amdgcn_s_sleep(1); \
    if ((++_sp & 255u) == 0u) { if (xb_ld(&(bar)[XB_TMO])) break; if (_sp > XB_SPIN_CAP) { atomicAdd(&(bar)[XB_TMO], 1u); break; } } } } while (0)

struct XcdBarrier {
    unsigned* bar; unsigned x;
    volatile LAS unsigned* st;
};

__device__ __forceinline__ XcdBarrier xcd_barrier_post(unsigned* bar, volatile LAS unsigned* st) {
    XcdBarrier b; b.bar = bar; b.x = xb_xcc_id(); b.st = st;
    if (threadIdx.x == 0) (void)xb_add(&bar[XB_XCNT(b.x)], 1u);
    return b;
}
__device__ __forceinline__ void xcd_barrier_complete(unsigned* bar, unsigned x, unsigned& nloc, unsigned& nx) {
    const unsigned G = gridDim.x * gridDim.y * gridDim.z;
    unsigned sum, cnt, mine, sp = 0u;
    for (;;) {
        sum = 0u; cnt = 0u; mine = 0u;
#pragma unroll
        for (unsigned j = 0; j < 16; ++j) { const unsigned c = xb_ld(&bar[XB_XCNT(j)]); sum += c; cnt += (c > 0u) ? 1u : 0u; mine = (j == x) ? c : mine; }
        if (sum == G) break;
        __builtin_amdgcn_s_sleep(1);
        if ((++sp & 255u) == 0u) { if (xb_ld(&bar[XB_TMO])) break; if (sp > XB_SPIN_CAP) { atomicAdd(&bar[XB_TMO], 1u); break; } }
    }
    nloc = mine > 0u ? mine : 1u; nx = cnt > 0u ? cnt : 1u;
}

__device__ __forceinline__ void xcd_barrier(const XcdBarrier& b) {
    asm volatile("s_waitcnt vmcnt(0)" ::: "memory");
    __syncthreads();
    if (threadIdx.x == 0) {
        unsigned* bar = b.bar;
        __builtin_amdgcn_s_waitcnt(0);
        unsigned nloc = b.st[0], nx = b.st[1];
        if (nloc == 0u) { xcd_barrier_complete(bar, b.x, nloc, nx); b.st[0] = nloc; b.st[1] = nx; }
        const unsigned old = xb_add(&bar[XB_XSUB(b.x)], 1u);
        const unsigned gen = old / nloc;
        if (old + 1u == (gen + 1u) * nloc) {
            __builtin_amdgcn_fence(__ATOMIC_RELEASE, "agent");
            asm volatile("s_waitcnt vmcnt(0)" ::: "memory");
            const unsigned og = xb_add(&bar[XB_TOP], 1u);
            const unsigned tg = og / nx;
            if (og + 1u == (tg + 1u) * nx) xb_add(&bar[XB_TOPGEN], 1u);
            else XB_SPIN(xb_ld(&bar[XB_TOPGEN]) == tg, bar);
            __builtin_amdgcn_fence(__ATOMIC_ACQUIRE, "agent");
            xb_add(&bar[XB_XGEN(b.x)], 1u);
            asm volatile("s_waitcnt vmcnt(0)" ::: "memory");
        } else {
            XB_SPIN(xb_ld(&bar[XB_XGEN(b.x)]) == gen, bar);
            __builtin_amdgcn_fence(__ATOMIC_ACQUIRE, "agent");
            asm volatile("s_waitcnt vmcnt(0)" ::: "memory");
        }
    }
    __syncthreads();
}


#if MEGA
__global__ void __launch_bounds__(256, 2) mega_kernel(Params p) {
  __shared__ __attribute__((aligned(16))) char smem[SMEM_BYTES];
  __shared__ uint4 xb_words;
  cg::grid_group grid = cg::this_grid();
  const int bid = blockIdx.x, nblk = gridDim.x;
  if (threadIdx.x == 0) xb_words = make_uint4(0u, 0u, 0u, 0u);
  __syncthreads();
  XcdBarrier xb = xcd_barrier_post((unsigned*)(p.ws + OFF_BAR), (volatile LAS unsigned*)&xb_words);
#if TIMING
  if (tidx() == 0) { TSH[0] = __builtin_amdgcn_s_memrealtime(); TSH[1] = 0; TSH[2] = 0; }
#define TICK(ph) { if (tidx() == 0) { unsigned long long tn = __builtin_amdgcn_s_memrealtime(); if ((ph) == TIMING_A) TSH[1] += tn - TSH[0]; if ((ph) == TIMING_B) TSH[2] += tn - TSH[0]; TSH[0] = tn; } }
#else
#define TICK(ph)
#endif
  if (p.ws == nullptr) grid.sync();
  run_phase(p, 0, 0, bid, nblk, smem);
  xcd_barrier(xb);
  TICK(0)
#define PH(ph, l) run_phase(p, ph, l, bid, nblk, smem); xcd_barrier(xb); TICK(ph)
  PH(1, 0) PH(2, 0) PH(3, 0) PH(4, 0) PH(5, 0) PH(6, 0)
  PH(1, 1) PH(2, 1) PH(3, 1) PH(4, 1) PH(5, 1) PH(6, 1)
#undef PH
  run_phase(p, 7, 0, bid, nblk, smem);
#if TIMING
  grid.sync();
  TICK(7)
  __syncthreads();
  if (bid == 0) {
    const float ta = (float)(TSH[1]) * 1e-5f, tb = (float)(TSH[2]) * 1e-5f;
    if (tidx() == 0) p.out[0] += 0.5f * ta;
    for (int i = tidx(); i < 65536; i += 256) p.out[1024 + i] += 0.5f * tb;
  }
#endif
}
#else
__global__ void __launch_bounds__(256, 2) phase_kernel(Params p, int ph, int l) {
  __shared__ __attribute__((aligned(16))) char smem[SMEM_BYTES];
  run_phase(p, ph, l, blockIdx.x, gridDim.x, smem);
}
#endif

extern "C" void kernel_launch(void* const* d_in, const int* in_sizes, int n_in, void* d_out, int out_size, void* d_ws, size_t ws_size,
                              hipStream_t stream) {
  Params p{};
  const float** f = (const float**)&p;
  for (int i = 0; i < 22; ++i) f[i] = (const float*)d_in[i];
  p.out = (float*)d_out;
  p.ws = (char*)d_ws;
  if (WS_TOTAL > ws_size) { fprintf(stderr, "workspace too small: need %zu have %zu\n", (size_t)WS_TOTAL, ws_size); return; }
#if MEGA
  static int grid_blocks = 0;
  if (!grid_blocks) {
    int dev = 0, cus = 0, per_cu = 0;
    hipGetDevice(&dev);
    hipDeviceGetAttribute(&cus, hipDeviceAttributeMultiprocessorCount, dev);
    hipOccupancyMaxActiveBlocksPerMultiprocessor(&per_cu, mega_kernel, 256, 0);
    if (per_cu > 2) per_cu = 2;
    if (per_cu < 1) per_cu = 1;
    grid_blocks = cus * per_cu;
  }
  (void)hipMemsetAsync(p.ws + OFF_BAR, 0, BAR_BYTES, stream);
  void* args[] = {&p};
  hipError_t e = hipLaunchCooperativeKernel((void*)mega_kernel, dim3(grid_blocks), dim3(256), args, 0, stream);
  if (e != hipSuccess) fprintf(stderr, "cooperative launch failed: %s (grid %d)\n", hipGetErrorString(e), grid_blocks);
#else
  const int G = 1024;
  phase_kernel<<<G, 256, 0, stream>>>(p, 0, 0);
  for (int l = 0; l < 2; ++l)
    for (int ph = 1; ph <= 6; ++ph) phase_kernel<<<G, 256, 0, stream>>>(p, ph, l);
  phase_kernel<<<G, 256, 0, stream>>>(p, 7, 0);
#endif
}
```
